# Optimizing an MI355X kernel written in HIP

```python
import math
import jax, jax.numpy as jnp
from jax import lax
import numpy as np

D_MODEL = 1024
BATCH = 4
SEQ = 8192
DEPTH = 1

POOL_WIDTH = D_MODEL // 2
POOL_GROUPS = 4
POOL_WINDOWS = (2, 4, 8, 16)
POOL_GROUP_IN = POOL_WIDTH // POOL_GROUPS
POOL_GROUP_OUT = D_MODEL // POOL_GROUPS
CONV_WIDTH = D_MODEL // 2
CONV_KERNEL = 31
IN_COLS = POOL_WIDTH + 2 * CONV_WIDTH + 2 * D_MODEL
N_EXPERTS = 256
TOP_K = 8
N_GROUPS = 8
TOPK_GROUPS = 4
EXPERTS_PER_GROUP = N_EXPERTS // N_GROUPS
EXPERT_HIDDEN = D_MODEL // 4
SHARED_HIDDEN = EXPERT_HIDDEN
ROUTED_SCALE = 2.5
EXPERT_BLOCK = 128
LN_EPS = 1e-5
DEEPNORM_ALPHA = (2.0 * DEPTH) ** 0.25
DEEPNORM_BETA = (8.0 * DEPTH) ** -0.25

kernel_name = "hybrid_pool_conformer_moe_deepnorm"


def _layernorm(x, g, b):
    xf = x.astype(jnp.float32)
    mu = jnp.mean(xf, axis=-1, keepdims=True)
    var = jnp.mean(jnp.square(xf - mu), axis=-1, keepdims=True)
    out = (xf - mu) * lax.rsqrt(var + LN_EPS) * g.astype(jnp.float32) + b.astype(jnp.float32)
    return out.astype(x.dtype)


def _causal_pool_residual(u, window):
    uf = u.astype(jnp.float32)
    s = uf.shape[1]
    cs = jnp.cumsum(uf, axis=1)
    prev = jnp.pad(cs, ((0, 0), (window, 0), (0, 0)))[:, :s]
    count = jnp.minimum(jnp.arange(1, s + 1), window).astype(jnp.float32)
    mean = (cs - prev) / count[None, :, None]
    return (mean - uf).astype(u.dtype)


def _token_mixer(x, w_in, pool_w, pool_scale, conv_dw, conv_ln_g, conv_ln_b, conv_w_out, w_out):
    b, s, _ = x.shape
    proj = jnp.einsum('bsd,dc->bsc', x, w_in)
    o_conv = POOL_WIDTH
    o_gate = POOL_WIDTH + 2 * CONV_WIDTH
    u = proj[..., :POOL_WIDTH].reshape(b, s, POOL_GROUPS, POOL_GROUP_IN)
    r = jnp.stack([_causal_pool_residual(u[:, :, g], POOL_WINDOWS[g]) for g in range(POOL_GROUPS)], axis=2)
    y_pool = jnp.einsum('bsgc,gcd->bsgd', r, pool_w).reshape(b, s, D_MODEL) * pool_scale
    a = proj[..., o_conv:o_gate]
    v = a[..., :CONV_WIDTH] * jax.nn.sigmoid(a[..., CONV_WIDTH:])
    v = lax.conv_general_dilated(v, conv_dw[:, None, :], window_strides=(1,),
                                 padding=[(CONV_KERNEL - 1, 0)],
                                 dimension_numbers=('NWC', 'WIO', 'NWC'),
                                 feature_group_count=CONV_WIDTH)
    v = jax.nn.silu(_layernorm(v, conv_ln_g, conv_ln_b))
    y_conv = jnp.einsum('bsc,cd->bsd', v, conv_w_out)
    g_pool = jax.nn.sigmoid(proj[..., o_gate:o_gate + D_MODEL])
    g_conv = jax.nn.sigmoid(proj[..., o_gate + D_MODEL:])
    merged = g_pool * y_pool + g_conv * y_conv
    return jnp.einsum('bsd,de->bse', merged, w_out)


def _route(x2d, w_router, router_bias):
    t = x2d.shape[0]
    scores = jax.nn.sigmoid(jnp.dot(x2d.astype(jnp.float32), w_router.astype(jnp.float32)))
    sel = scores + router_bias.astype(jnp.float32)
    group_score = lax.top_k(sel.reshape(t, N_GROUPS, EXPERTS_PER_GROUP), 2)[0].sum(-1)
    _, top_groups = lax.top_k(group_score, TOPK_GROUPS)
    group_mask = jax.nn.one_hot(top_groups, N_GROUPS, dtype=jnp.bool_).any(axis=1)
    expert_mask = jnp.repeat(group_mask, EXPERTS_PER_GROUP, axis=1)
    _, topk_idx = lax.top_k(jnp.where(expert_mask, sel, -jnp.inf), TOP_K)
    w = jnp.take_along_axis(scores, topk_idx, axis=1)
    w = w / jnp.sum(w, axis=-1, keepdims=True) * ROUTED_SCALE
    return topk_idx, w


def _moe(x, w_router, router_bias, w_gate_e, w_up_e, w_down_e, ws_gate, ws_up, ws_down):
    b, s, d = x.shape
    x2d = x.reshape(b * s, d)
    t = x2d.shape[0]
    topk_idx, w = _route(x2d, w_router, router_bias)
    n = t * TOP_K
    flat_e = topk_idx.reshape(n)
    flat_tok = (jnp.arange(n) // TOP_K).astype(jnp.int32)
    flat_w = w.reshape(n).astype(x.dtype)
    order = jnp.argsort(flat_e)
    counts = jnp.bincount(flat_e, length=N_EXPERTS)
    padded = ((counts + EXPERT_BLOCK - 1) // EXPERT_BLOCK) * EXPERT_BLOCK
    pad_end = jnp.cumsum(padded)
    pad_start = pad_end - padded
    start = jnp.cumsum(counts) - counts
    se = flat_e[order]
    dest = pad_start[se] + jnp.arange(n) - start[se]
    n_blocks = -(-(n + N_EXPERTS * (EXPERT_BLOCK - 1)) // EXPERT_BLOCK)
    n_pad = n_blocks * EXPERT_BLOCK
    slot_tok = jnp.full((n_pad,), t, dtype=jnp.int32).at[dest].set(flat_tok[order])
    slot_w = jnp.zeros((n_pad,), dtype=x.dtype).at[dest].set(flat_w[order])
    block_e = jnp.minimum(jnp.searchsorted(pad_end, jnp.arange(n_blocks) * EXPERT_BLOCK, side='right'),
                          N_EXPERTS - 1)
    x_pad = jnp.concatenate([x2d, jnp.zeros((1, d), x2d.dtype)], axis=0)

    def expert_block(y, inp):
        tok, wt, e = inp
        xb = x_pad[tok]
        h = jax.nn.silu(xb @ w_gate_e[e]) * (xb @ w_up_e[e])
        yb = (h @ w_down_e[e]) * wt[:, None]
        return y.at[tok].add(yb), None

    y_routed, _ = lax.scan(expert_block, jnp.zeros((t + 1, d), x2d.dtype),
                           (slot_tok.reshape(n_blocks, EXPERT_BLOCK),
                            slot_w.reshape(n_blocks, EXPERT_BLOCK), block_e))
    y_shared = (jax.nn.silu(x2d @ ws_gate) * (x2d @ ws_up)) @ ws_down
    return (y_routed[:t] + y_shared).reshape(b, s, d)


def setup_inputs(seed: int = 0) -> dict:
    key = jax.random.key(seed)
    ks = jax.random.split(key, 24)
    f32 = jnp.float32

    def nrm(k, shape, scale):
        return jax.random.normal(k, shape, f32) * scale

    L = DEPTH
    return {
        "x": nrm(ks[0], (BATCH, SEQ, D_MODEL), 1.0),
        "w_in": nrm(ks[1], (L, D_MODEL, IN_COLS), D_MODEL ** -0.5),
        "pool_w": nrm(ks[2], (L, POOL_GROUPS, POOL_GROUP_IN, POOL_GROUP_OUT), POOL_GROUP_IN ** -0.5),
        "pool_scale": 1.0 + nrm(ks[3], (L, D_MODEL), 0.1),
        "conv_dw": nrm(ks[4], (L, CONV_KERNEL, CONV_WIDTH), CONV_KERNEL ** -0.5),
        "conv_ln_g": 1.0 + nrm(ks[5], (L, CONV_WIDTH), 0.02),
        "conv_ln_b": nrm(ks[6], (L, CONV_WIDTH), 0.02),
        "conv_w_out": nrm(ks[7], (L, CONV_WIDTH, D_MODEL), CONV_WIDTH ** -0.5),
        "w_out": nrm(ks[8], (L, D_MODEL, D_MODEL), D_MODEL ** -0.5 * DEEPNORM_BETA),
        "ln1_g": 1.0 + nrm(ks[9], (L, D_MODEL), 0.02),
        "ln1_b": nrm(ks[10], (L, D_MODEL), 0.02),
        "w_router": nrm(ks[11], (L, D_MODEL, N_EXPERTS), D_MODEL ** -0.5),
        "router_bias": nrm(ks[12], (L, N_EXPERTS), 0.01),
        "w_gate_e": nrm(ks[13], (L, N_EXPERTS, D_MODEL, EXPERT_HIDDEN), D_MODEL ** -0.5),
        "w_up_e": nrm(ks[14], (L, N_EXPERTS, D_MODEL, EXPERT_HIDDEN), D_MODEL ** -0.5),
        "w_down_e": nrm(ks[15], (L, N_EXPERTS, EXPERT_HIDDEN, D_MODEL), EXPERT_HIDDEN ** -0.5 * DEEPNORM_BETA),
        "ws_gate": nrm(ks[16], (L, D_MODEL, SHARED_HIDDEN), D_MODEL ** -0.5),
        "ws_up": nrm(ks[17], (L, D_MODEL, SHARED_HIDDEN), D_MODEL ** -0.5),
        "ws_down": nrm(ks[18], (L, SHARED_HIDDEN, D_MODEL), SHARED_HIDDEN ** -0.5 * DEEPNORM_BETA),
        "ln2_g": 1.0 + nrm(ks[19], (L, D_MODEL), 0.02),
        "ln2_b": nrm(ks[20], (L, D_MODEL), 0.02),
    }


def reference(x, w_in, pool_w, pool_scale, conv_dw, conv_ln_g, conv_ln_b, conv_w_out, w_out,
              ln1_g, ln1_b, w_router, router_bias, w_gate_e, w_up_e, w_down_e,
              ws_gate, ws_up, ws_down, ln2_g, ln2_b):
    for l in range(DEPTH):
        m = _token_mixer(x, w_in[l], pool_w[l], pool_scale[l], conv_dw[l], conv_ln_g[l],
                         conv_ln_b[l], conv_w_out[l], w_out[l])
        x = _layernorm(DEEPNORM_ALPHA * x + m, ln1_g[l], ln1_b[l])
        f = _moe(x, w_router[l], router_bias[l], w_gate_e[l], w_up_e[l], w_down_e[l],
                 ws_gate[l], ws_up[l], ws_down[l])
        x = _layernorm(DEEPNORM_ALPHA * x + f, ln2_g[l], ln2_b[l])
    return x
```

```cpp
#define MK_N_LAUNCHES 12

#include <hip/hip_runtime.h>
#include <cstdio>
#include <cstdint>

namespace pg8 {
#define PG8_LAS __attribute__((address_space(3)))
typedef unsigned short bf16_t;
typedef short bf16x8 __attribute__((ext_vector_type(8)));
typedef float f32x4 __attribute__((ext_vector_type(4)));
typedef float f32x2 __attribute__((ext_vector_type(2)));
typedef unsigned u32x4 __attribute__((ext_vector_type(4)));
typedef unsigned u32x2 __attribute__((ext_vector_type(2)));
constexpr int BM = 256, BK = 64, HALF = 128, HTB = HALF * BK * 2  , STAGE_BYTES = 8 * HTB, NXCD = 8, WGM = 8;

__host__ __device__ __forceinline__ int lds_byte(int r, int c) { const int st = (r >> 4) * 2 + (c >> 5), rr = r & 15, cc = c & 31, ob = rr * 64 + cc * 2; return st * 1024 + (ob ^ (((ob >> 9) & 1) << 5)); }
__host__ __device__ __forceinline__ void stage_rc(int b, int& R, int& C) { const int st = b / 1024, sb = b % 1024, swz = sb ^ (((sb >> 9) & 1) << 5); R = (st >> 1) * 16 + swz / 64; C = (st & 1) * 32 + (swz % 64) / 2; }
__host__ __device__ __forceinline__ int perm32(int rho) { const int n = rho >> 4, i = rho & 15; return 8 * (i >> 2) + 4 * n + (i & 3); }

struct Unit { int pm, pn, e, r0, nrow; };

typedef __bf16 bf16x2_t __attribute__((ext_vector_type(2)));
__device__ __forceinline__ unsigned cvt_pk_bf16(float lo, float hi) { f32x2 v = {lo, hi}; bf16x2_t b = __builtin_convertvector(v, bf16x2_t); return __builtin_bit_cast(unsigned, b); }
__device__ __forceinline__ u32x4 pack8(const f32x4 a, const f32x4 b) { u32x4 w; w.x = cvt_pk_bf16(a[0], a[1]); w.y = cvt_pk_bf16(a[2], a[3]); w.z = cvt_pk_bf16(b[0], b[1]); w.w = cvt_pk_bf16(b[2], b[3]); return w; }
__device__ __forceinline__ float bf_lo(unsigned w) { return __uint_as_float(w << 16); }
__device__ __forceinline__ float bf_hi(unsigned w) { return __uint_as_float(w & 0xffff0000u); }
__device__ __forceinline__ void unpack8(const u32x4 w, f32x4& a, f32x4& b) { a = (f32x4){bf_lo(w.x), bf_hi(w.x), bf_lo(w.y), bf_hi(w.y)}; b = (f32x4){bf_lo(w.z), bf_hi(w.z), bf_lo(w.w), bf_hi(w.w)}; }
__device__ __forceinline__ float sigmoidf_(float x) { return __builtin_amdgcn_rcpf(1.0f + __expf(-x)); }
__device__ __forceinline__ f32x4 sigmoid4(const f32x4 x) { return (f32x4){sigmoidf_(x[0]), sigmoidf_(x[1]), sigmoidf_(x[2]), sigmoidf_(x[3])}; }

template <class Epi, class Sched>
__device__ __forceinline__ void gemm_phase(PG8_LAS unsigned char* lds, const Sched& S, const Epi& E) {
    const int tid = threadIdx.x, wid = __builtin_amdgcn_readfirstlane(tid >> 6), lane = tid & 63, wr = wid >> 2, wc = wid & 3, fr = lane & 15, fq = lane >> 4;
    int nt_ = S.nt; asm volatile("" : "+s"(nt_));
    const int nt = nt_;
    int sR[2], sC[2]; unsigned voffB[2];
#pragma unroll
    for (int i = 0; i < 2; ++i) { int R, C; stage_rc(tid * 16 + i * 8192, R, C); const int Rb = Epi::PERM ? ((R & ~31) + perm32(R & 31)) : R;
        sR[i] = R; sC[i] = C; voffB[i] = (unsigned)(Rb * S.ldb + C) * 2u; }
    const size_t kstep = (size_t)(BK * 2);
    const size_t hstepB = (size_t)HALF * S.ldb * 2;
    const unsigned ldsw = (unsigned)wid * 1024u;
    const int aoff = lds_byte(wr * 64 + fr, fq * 8), boff = lds_byte(wc * 32 + fr, fq * 8);
#define PG8_SA(b, h) (((b) * 2 + (h)) * HTB)
#define PG8_SB(b, h) ((4 + (b) * 2 + (h)) * HTB)
#define PG8_STAGE(bufoff, gbase, voff) do { _Pragma("unroll") for (int _i = 0; _i < 2; ++_i) \
        __builtin_amdgcn_global_load_lds((const unsigned*)((const char*)(gbase) + (voff)[_i]), (PG8_LAS unsigned*)(lds + (bufoff) + ldsw + _i * 8192), 16, 0, 0); } while (0)
#define PG8_LDA(dst, b, h) do { _Pragma("unroll") for (int m = 0; m < 4; ++m) _Pragma("unroll") for (int k = 0; k < 2; ++k) dst[m][k] = *(const PG8_LAS bf16x8*)(lds + PG8_SA(b, h) + aoff + m * 2048 + k * 1024); } while (0)
#define PG8_LDB(dst, b, h) do { _Pragma("unroll") for (int n = 0; n < 2; ++n) _Pragma("unroll") for (int k = 0; k < 2; ++k) dst[n][k] = *(const PG8_LAS bf16x8*)(lds + PG8_SB(b, h) + boff + n * 2048 + k * 1024); } while (0)
#define PG8_MMA(ai, bj, At, Bt) do { __builtin_amdgcn_s_setprio(1); _Pragma("unroll") for (int m = 0; m < 4; ++m) _Pragma("unroll") for (int n = 0; n < 2; ++n) _Pragma("unroll") for (int k = 0; k < 2; ++k) \
        acc[ai][bj][m][n] = __builtin_amdgcn_mfma_f32_16x16x32_bf16(Bt[n][k], At[m][k], acc[ai][bj][m][n], 0, 0, 0); __builtin_amdgcn_s_setprio(0); } while (0)
#define PG8_WAIT_V(n) asm volatile("s_waitcnt vmcnt(" #n ")" ::: "memory")
#define PG8_WAIT_L(n) asm volatile("s_waitcnt lgkmcnt(" #n ")" ::: "memory")
#define PG8_BAR __builtin_amdgcn_s_barrier()
#define PG8_SCHED __builtin_amdgcn_sched_barrier(0)
    Unit cur, nxt; int ui = 0;
    if (!S.next(0, cur)) return;
    f32x4 acc[2][2][4][2];
#pragma unroll
    for (int a = 0; a < 2; ++a)
#pragma unroll
        for (int b = 0; b < 2; ++b)
#pragma unroll
            for (int m = 0; m < 4; ++m)
#pragma unroll
                for (int n = 0; n < 2; ++n) acc[a][b][m][n] = (f32x4){0.f, 0.f, 0.f, 0.f};
    bf16x8 At[4][2], B0[2][2], B1[2][2];
    unsigned cvo[2][2], nvo[2][2];
    const char* cA = S.a_ptr(cur); const char* cB = S.b_ptr(cur);
    S.a_off(cur, sR, sC, cvo);
    PG8_STAGE(PG8_SB(0, 0), cB, voffB); PG8_STAGE(PG8_SB(0, 1), cB + hstepB, voffB); PG8_STAGE(PG8_SA(0, 0), cA, cvo[0]); PG8_STAGE(PG8_SA(0, 1), cA, cvo[1]);
    if (wr == 1) PG8_BAR;
    PG8_WAIT_V(2); PG8_BAR;
    PG8_STAGE(PG8_SB(1, 0), cB + kstep, voffB); PG8_STAGE(PG8_SA(1, 0), cA + kstep, cvo[0]); PG8_STAGE(PG8_SB(1, 1), cB + hstepB + kstep, voffB);
    PG8_WAIT_V(6); PG8_BAR;
    for (;;) {
        const bool has_next = S.next(ui + 1, nxt);
        const char* nA = cA; const char* nB = cB;
#pragma unroll
        for (int h = 0; h < 2; ++h)
#pragma unroll
            for (int i = 0; i < 2; ++i) nvo[h][i] = cvo[h][i];
        if (has_next) { nA = S.a_ptr(nxt); nB = S.b_ptr(nxt); S.a_off(nxt, sR, sC, nvo); }
        for (int t = 0; t < nt; t += 2) {
            const bool last = (t == nt - 2);
            const char* a1 = cA + (size_t)(t + 1) * kstep;
            const char* a2 = last ? nA : cA + (size_t)(t + 2) * kstep; const char* b2 = last ? nB : cB + (size_t)(t + 2) * kstep;
            const char* a3 = a2 + kstep; const char* b3 = b2 + kstep;
            unsigned xvo[2][2];
#pragma unroll
            for (int h = 0; h < 2; ++h)
#pragma unroll
                for (int i = 0; i < 2; ++i) xvo[h][i] = last ? nvo[h][i] : cvo[h][i];
            PG8_LDB(B0, 0, 0); PG8_LDB(B1, 0, 1); PG8_SCHED; PG8_LDA(At, 0, 0); PG8_STAGE(PG8_SA(1, 1), a1, cvo[1]);
            PG8_WAIT_V(8); PG8_WAIT_L(0); PG8_BAR; PG8_MMA(0, 0, At, B0); PG8_MMA(0, 1, At, B1); PG8_BAR; PG8_SCHED;
            PG8_LDA(At, 0, 1); PG8_STAGE(PG8_SB(0, 0), b2, voffB); PG8_STAGE(PG8_SB(0, 1), b2 + hstepB, voffB); PG8_STAGE(PG8_SA(0, 0), a2, xvo[0]);
            PG8_WAIT_V(8); PG8_WAIT_L(0); PG8_BAR; PG8_MMA(1, 0, At, B0); PG8_MMA(1, 1, At, B1); PG8_BAR; PG8_SCHED;
            PG8_LDB(B0, 1, 0); PG8_LDB(B1, 1, 1); PG8_SCHED; PG8_LDA(At, 1, 0); PG8_STAGE(PG8_SA(0, 1), a2, xvo[1]);
            PG8_WAIT_V(8); PG8_WAIT_L(0); PG8_BAR; PG8_MMA(0, 0, At, B0); PG8_MMA(0, 1, At, B1); PG8_BAR; PG8_SCHED;
            PG8_LDA(At, 1, 1); PG8_STAGE(PG8_SB(1, 0), b3, voffB); PG8_STAGE(PG8_SB(1, 1), b3 + hstepB, voffB); PG8_STAGE(PG8_SA(1, 0), a3, xvo[0]);
            PG8_WAIT_V(8); PG8_WAIT_L(0); PG8_BAR; PG8_MMA(1, 0, At, B0); PG8_MMA(1, 1, At, B1); PG8_BAR; PG8_SCHED;
        }
        if (wr == 0) PG8_BAR;
        E(acc, cur, wr, wc, fr, fq);
        if (!has_next) break;
#pragma unroll
        for (int a = 0; a < 2; ++a)
#pragma unroll
            for (int b = 0; b < 2; ++b)
#pragma unroll
                for (int m = 0; m < 4; ++m)
#pragma unroll
                    for (int n = 0; n < 2; ++n) acc[a][b][m][n] = (f32x4){0.f, 0.f, 0.f, 0.f};
        cur = nxt; cA = nA; cB = nB; ++ui;
#pragma unroll
        for (int h = 0; h < 2; ++h)
#pragma unroll
            for (int i = 0; i < 2; ++i) cvo[h][i] = nvo[h][i];
        if (wr == 1) PG8_BAR;
    }
    PG8_WAIT_V(0);
    PG8_BAR;
#undef PG8_SA
#undef PG8_SB
#undef PG8_STAGE
#undef PG8_LDA
#undef PG8_LDB
#undef PG8_MMA
#undef PG8_WAIT_V
#undef PG8_WAIT_L
#undef PG8_BAR
#undef PG8_SCHED
}
}

constexpr int NWAVES = 8, NTHR = NWAVES * 64;
constexpr int D = 1024, BATCH = 4, SEQ = 8192, M = BATCH * SEQ;
constexpr int PW = 512, CW = 512, CK = 31, INC = 3584;
constexpr int NE = 256, TOPK = 8, NG = 8, EH = 256;
constexpr int ECAP = M;
constexpr int MAXT = (M * TOPK) / 256 + NE;
constexpr float LN_EPS = 1e-5f, ALPHA = 1.189207115002721f  , RSCALE = 2.5f;

constexpr size_t MiB = 1u << 20;
constexpr size_t WS_CTL = 0, CTL_ZERO_BYTES = 1 * MiB;
constexpr size_t WS_WIN = 1 * MiB;
constexpr size_t WS_POOL = 8 * MiB;
constexpr size_t WS_CVO = 8 * MiB + 512 * 1024;
constexpr size_t WS_WOUT = 10 * MiB;
constexpr size_t WS_RSH = 12 * MiB;
constexpr size_t WS_SDN = 14 * MiB;
constexpr size_t WS_EDN = 16 * MiB;
constexpr size_t WS_X1 = 144 * MiB;
constexpr size_t WS_HS = 208 * MiB;
constexpr size_t WS_LIST = 224 * MiB;
constexpr size_t WS_HE = 288 * MiB;
constexpr size_t WS_EGU = 448 * MiB;
constexpr size_t WS_PH = 704 * MiB;
constexpr size_t WS_XB = WS_PH;
constexpr size_t WS_U = WS_PH + 64 * MiB, WS_V = WS_PH + 96 * MiB;
constexpr size_t WS_GP = WS_PH + 128 * MiB, WS_GC = WS_PH + 192 * MiB;
constexpr size_t WS_R = WS_PH + 256 * MiB, WS_C = WS_PH + 288 * MiB;
constexpr size_t WS_T1 = WS_XB;
constexpr size_t WS_MG = WS_U;
constexpr size_t WS_Z = WS_GP;
constexpr size_t WS_LOG = WS_R;
constexpr size_t WS_END = 1024 * MiB;
constexpr size_t WS_Y = WS_EGU;
static_assert(WS_Y + (size_t)M * 8 * D * 2 <= WS_R, "Y slots end before R");
constexpr size_t WS_YSH = WS_R;
static_assert(WS_YSH + (size_t)M * D * 2 <= WS_END, "ws map");
static_assert(WS_HE + (size_t)MAXT * 256 * EH * 2 <= WS_EGU, "HE fits");
static_assert(WS_LIST + (size_t)NE * ECAP * 8 <= WS_HE, "LIST fits");

constexpr int CW_CNT = 1024;
constexpr int CW_BAR = 4096;

constexpr int RING_OFF = 0, RING_BYTES = 131072;
constexpr int TAB_OFF = RING_BYTES;
constexpr int MISC_OFF = TAB_OFF + 4096;
constexpr int LDS_BYTES = 147456;
static_assert(MISC_OFF + 128 <= LDS_BYTES, "LDS map");

#define GAS __attribute__((address_space(1)))
#define LAS __attribute__((address_space(3)))
typedef unsigned short bf16;
typedef unsigned v4u __attribute__((ext_vector_type(4)));
typedef unsigned v2u __attribute__((ext_vector_type(2)));
typedef float f32x4 __attribute__((ext_vector_type(4)));
typedef GAS unsigned gu32;
#define RLX_AGENT __ATOMIC_RELAXED, __HIP_MEMORY_SCOPE_AGENT
#define LDS_WAIT() asm volatile("s_waitcnt lgkmcnt(0)" ::: "memory")
#define VM_WAIT() asm volatile("s_waitcnt vmcnt(0)" ::: "memory")
__device__ __forceinline__ unsigned f2bf(float f) { unsigned u = __builtin_bit_cast(unsigned, f); return (u + 0x7fffu + ((u >> 16) & 1u)) >> 16; }
__device__ __forceinline__ unsigned pk2(float lo, float hi) { return pg8::cvt_pk_bf16(lo, hi); }

#define XB_TMO      128
#define XB_XCNT(j)  (256  + 64 * (j))
#define XB_XSUB(j)  (1280 + 64 * (j))
#define XB_XGEN(j)  (2304 + 64 * (j))
#define XB_TOP      3328
#define XB_TOPGEN   3392
#define XCD_BAR_WORDS 3456
#define XB_SPIN_CAP (1u << 20)
__device__ __forceinline__ unsigned xb_ld(unsigned* p)              { return __hip_atomic_load(p, __ATOMIC_RELAXED, __HIP_MEMORY_SCOPE_AGENT); }
__device__ __forceinline__ unsigned xb_add(unsigned* p, unsigned v) { return __hip_atomic_fetch_add(p, v, __ATOMIC_RELAXED, __HIP_MEMORY_SCOPE_AGENT); }
__device__ __forceinline__ unsigned xb_xcc_id() { return (unsigned)__builtin_amdgcn_s_getreg((3 << 11) | 20) & 0xFu; }
#define XB_SPIN(cond, bar) do { unsigned _sp = 0; while (cond) { __builtin_amdgcn_s_sleep(1); \
    if ((++_sp & 255u) == 0u) { if (xb_ld(&(bar)[XB_TMO])) break; if (_sp > XB_SPIN_CAP) { atomicAdd(&(bar)[XB_TMO], 1u); break; } } } } while (0)
struct XcdBarrier { unsigned* bar; unsigned x; volatile LAS unsigned* st; };
__device__ __forceinline__ XcdBarrier xcd_barrier_post(unsigned* bar, volatile LAS unsigned* st) {
    XcdBarrier b; b.bar = bar; b.x = xb_xcc_id(); b.st = st;
    if (threadIdx.x == 0) (void)xb_add(&bar[XB_XCNT(b.x)], 1u);
    return b;
}
__device__ __forceinline__ void xcd_barrier_complete(unsigned* bar, unsigned x, unsigned& nloc, unsigned& nx) {
    const unsigned G = gridDim.x * gridDim.y * gridDim.z;
    unsigned sum, cnt, mine, sp = 0u;
    for (;;) {
        sum = 0u; cnt = 0u; mine = 0u;
#pragma unroll
        for (unsigned j = 0; j < 16; ++j) { const unsigned c = xb_ld(&bar[XB_XCNT(j)]); sum += c; cnt += (c > 0u) ? 1u : 0u; mine = (j == x) ? c : mine; }
        if (sum == G) break;
        __builtin_amdgcn_s_sleep(1);
        if ((++sp & 255u) == 0u) { if (xb_ld(&bar[XB_TMO])) break; if (sp > XB_SPIN_CAP) { atomicAdd(&bar[XB_TMO], 1u); break; } }
    }
    nloc = mine > 0u ? mine : 1u; nx = cnt > 0u ? cnt : 1u;
}
__device__ __forceinline__ void xcd_barrier(const XcdBarrier& b) {
    asm volatile("s_waitcnt vmcnt(0)" ::: "memory");
    __syncthreads();
    if (threadIdx.x == 0) {
        unsigned* bar = b.bar;
        __builtin_amdgcn_s_waitcnt(0);
        unsigned nloc = b.st[0], nx = b.st[1];
        if (nloc == 0u) { xcd_barrier_complete(bar, b.x, nloc, nx); b.st[0] = nloc; b.st[1] = nx; }
        const unsigned old = xb_add(&bar[XB_XSUB(b.x)], 1u);
        const unsigned gen = old / nloc;
        if (old + 1u == (gen + 1u) * nloc) {
            __builtin_amdgcn_fence(__ATOMIC_RELEASE, "agent");
            asm volatile("s_waitcnt vmcnt(0)" ::: "memory");
            const unsigned og = xb_add(&bar[XB_TOP], 1u);
            const unsigned tg = og / nx;
            if (og + 1u == (tg + 1u) * nx) xb_add(&bar[XB_TOPGEN], 1u);
            else XB_SPIN(xb_ld(&bar[XB_TOPGEN]) == tg, bar);
            __builtin_amdgcn_fence(__ATOMIC_ACQUIRE, "agent");
            xb_add(&bar[XB_XGEN(b.x)], 1u);
            asm volatile("s_waitcnt vmcnt(0)" ::: "memory");
        } else {
            XB_SPIN(xb_ld(&bar[XB_XGEN(b.x)]) == gen, bar);
            __builtin_amdgcn_fence(__ATOMIC_ACQUIRE, "agent");
            asm volatile("s_waitcnt vmcnt(0)" ::: "memory");
        }
    }
    __syncthreads();
}

struct Frame {
    LAS unsigned char* lds;
    volatile LAS unsigned* MISC;
    gu32* ctl;
    int tid, lane, wave;
    int vcu, G;
    const float* in[21]; float* out; unsigned char* ws;
};
__device__ __forceinline__ float wave_sum(float v) {
#pragma unroll
    for (int o = 1; o < 64; o <<= 1) v += __shfl_xor(v, o);
    return v;
}

__host__ __device__ __forceinline__ int xcd_chunk(int L, int nwg) {
    const int q = nwg / 8, r = nwg % 8, xcd = L % 8, off = L / 8;
    return (xcd < r ? xcd * (q + 1) : r * (q + 1) + (xcd - r) * q) + off;
}
struct DenseOrder {
    const bf16* A; const bf16* Bt; int lda, ldb, nt, acol_pn;
    int nM, nN, nwg, G, c;
    __device__ __forceinline__ void init(const bf16* A_, const bf16* Bt_, int Mr, int N, int K, int lda_, int ldb_, int acol_pn_, int G_, int c_) {
        A = A_; Bt = Bt_; lda = lda_; ldb = ldb_; nt = K / 64; acol_pn = acol_pn_; nM = Mr / 256; nN = N / 256; nwg = nM * nN; G = G_; c = c_; }
    __device__ __forceinline__ bool next(int i, pg8::Unit& u) const {
        const int L = i * G + c; if (L >= nwg) return false;
        const int wgid = xcd_chunk(L, nwg);
        const int nig = 8 * nN, gid = wgid / nig, fm = gid * 8, gsz = (nM - fm) < 8 ? (nM - fm) : 8;
        u.pm = fm + ((wgid % nig) % gsz); u.pn = (wgid % nig) / gsz; u.e = 0; u.r0 = 0; u.nrow = 256; return true;
    }
    __device__ __forceinline__ const char* a_ptr(const pg8::Unit& u) const { return (const char*)(A + (size_t)u.pm * 256 * lda + u.pn * acol_pn); }
    __device__ __forceinline__ const char* b_ptr(const pg8::Unit& u) const { return (const char*)(Bt + (size_t)u.pn * 256 * ldb); }
    __device__ __forceinline__ void a_off(const pg8::Unit&, const int (&R)[2], const int (&C)[2], unsigned (&o)[2][2]) const {
#pragma unroll
        for (int h = 0; h < 2; ++h)
#pragma unroll
            for (int i = 0; i < 2; ++i) o[h][i] = (unsigned)((h * 128 + R[i]) * lda + C[i]) * 2u;
    }
};
template <bool GATHER> struct ExpertOrder {
    const bf16* A; const bf16* Bt; int lda, ldb, nt; size_t bstride;
    const LAS int* tstart; const LAS int* cntl; const int* list;
    int nN, nwg, G, c;
    __device__ __forceinline__ bool next(int i, pg8::Unit& u) const {
        const int L = i * G + c; if (L >= nwg) return false;
        const int wgid = xcd_chunk(L, nwg);
        const int t = wgid / nN; u.pn = wgid % nN; u.pm = t;
        int lo = 0, hi = NE;
#pragma unroll
        for (int s = 0; s < 8; ++s) { const int mid = (lo + hi) >> 1; if (tstart[mid] <= t) lo = mid; else hi = mid; }
        u.e = lo; u.r0 = (t - tstart[lo]) * 256; u.nrow = cntl[lo] - u.r0; return true;
    }
    __device__ __forceinline__ const char* a_ptr(const pg8::Unit& u) const { return GATHER ? (const char*)A : (const char*)(A + (size_t)u.pm * 256 * lda); }
    __device__ __forceinline__ const char* b_ptr(const pg8::Unit& u) const { return (const char*)(Bt + (size_t)u.e * bstride + (size_t)u.pn * 256 * ldb); }
    __device__ __forceinline__ void a_off(const pg8::Unit& u, const int (&R)[2], const int (&C)[2], unsigned (&o)[2][2]) const {
#pragma unroll
        for (int h = 0; h < 2; ++h)
#pragma unroll
            for (int i = 0; i < 2; ++i) {
                const int rl = h * 128 + R[i];
                if (GATHER) { int slot = 0; if (rl < u.nrow) slot = list[((size_t)u.e * ECAP + u.r0 + rl) * 2]; o[h][i] = (unsigned)((slot >> 3) * lda + C[i]) * 2u; }
                else o[h][i] = (unsigned)(rl * lda + C[i]) * 2u;
            }
    }
};

using pg8::f32x4; using pg8::u32x4; using pg8::pack8; using pg8::unpack8; using pg8::sigmoid4;
#define EPI_ROWS_BEGIN _Pragma("unroll") for (int ai = 0; ai < 2; ++ai) _Pragma("unroll") for (int m = 0; m < 4; ++m) { const int row = u.pm * 256 + ai * 128 + wr * 64 + m * 16 + fr;
#define EPI_ROWS_END }
#define UNROLL _Pragma("unroll")
typedef const pg8::f32x4 (&AccRef)[2][2][4][2];
struct EpiProj { static constexpr bool PERM = true; bf16 *U, *V, *GP, *GC;
    __device__ __forceinline__ void operator()(AccRef acc, const pg8::Unit& u, int wr, int wc, int fr, int fq) const {
        const int cb = wc * 32 + 8 * fq;
        if (u.pn < 2) {
            EPI_ROWS_BEGIN
                bf16* p = U + (size_t)row * PW + u.pn * 256 + cb;
                UNROLL for (int bj = 0; bj < 2; ++bj) *(u32x4*)(p + bj * 128) = pack8(acc[ai][bj][m][0], acc[ai][bj][m][1]);
            EPI_ROWS_END
        } else if (u.pn < 6) {
            const int j = u.pn - 2;
            EPI_ROWS_BEGIN
                bf16* p = V + (size_t)row * CW + j * 128 + cb;
                *(u32x4*)p = pack8(acc[ai][0][m][0] * sigmoid4(acc[ai][1][m][0]), acc[ai][0][m][1] * sigmoid4(acc[ai][1][m][1]));
            EPI_ROWS_END
        } else {
            bf16* Gt = (u.pn < 10) ? GP : GC; const int t = (u.pn - 6) & 3;
            EPI_ROWS_BEGIN
                bf16* p = Gt + (size_t)row * D + t * 256 + cb;
                UNROLL for (int bj = 0; bj < 2; ++bj) *(u32x4*)(p + bj * 128) = pack8(sigmoid4(acc[ai][bj][m][0]), sigmoid4(acc[ai][bj][m][1]));
            EPI_ROWS_END
        }
    }
};
struct EpiPool { static constexpr bool PERM = true; const float* scale; const bf16* GP; bf16* T1;
    __device__ __forceinline__ void operator()(AccRef acc, const pg8::Unit& u, int wr, int wc, int fr, int fq) const {
        const int c0 = u.pn * 256 + wc * 32 + 8 * fq;
        UNROLL for (int bj = 0; bj < 2; ++bj) {
            const f32x4 sc0 = *(const f32x4*)(scale + c0 + bj * 128), sc1 = *(const f32x4*)(scale + c0 + bj * 128 + 4);
            EPI_ROWS_BEGIN
                const size_t o = (size_t)row * D + c0 + bj * 128;
                f32x4 g0, g1; unpack8(*(const u32x4*)(GP + o), g0, g1);
                *(u32x4*)(T1 + o) = pack8(acc[ai][bj][m][0] * sc0 * g0, acc[ai][bj][m][1] * sc1 * g1);
            EPI_ROWS_END
        }
    }
};
struct EpiConvOut { static constexpr bool PERM = true; const bf16* T1; const bf16* GC; bf16* MG;
    __device__ __forceinline__ void operator()(AccRef acc, const pg8::Unit& u, int wr, int wc, int fr, int fq) const {
        const int c0 = u.pn * 256 + wc * 32 + 8 * fq;
        EPI_ROWS_BEGIN
            const size_t o = (size_t)row * D + c0;
            UNROLL for (int bj = 0; bj < 2; ++bj) { f32x4 g0, g1, t0, t1; unpack8(*(const u32x4*)(GC + o + bj * 128), g0, g1); unpack8(*(const u32x4*)(T1 + o + bj * 128), t0, t1);
                *(u32x4*)(MG + o + bj * 128) = pack8(t0 + acc[ai][bj][m][0] * g0, t1 + acc[ai][bj][m][1] * g1); }
        EPI_ROWS_END
    }
};
struct EpiWout { static constexpr bool PERM = true; const float* X; float* Z;
    __device__ __forceinline__ void operator()(AccRef acc, const pg8::Unit& u, int wr, int wc, int fr, int fq) const {
        const int c0 = u.pn * 256 + wc * 32 + 8 * fq;
        EPI_ROWS_BEGIN
            const size_t o = (size_t)row * D + c0;
            UNROLL for (int bj = 0; bj < 2; ++bj) { const f32x4 x0 = *(const f32x4*)(X + o + bj * 128), x1 = *(const f32x4*)(X + o + bj * 128 + 4);
                *(f32x4*)(Z + o + bj * 128) = x0 * ALPHA + acc[ai][bj][m][0]; *(f32x4*)(Z + o + bj * 128 + 4) = x1 * ALPHA + acc[ai][bj][m][1]; }
        EPI_ROWS_END
    }
};
__device__ __forceinline__ f32x4 silu_mul4(const f32x4 g, const f32x4 v) { return g * sigmoid4(g) * v; }
struct EpiRSh { static constexpr bool PERM = true; float* LOG; bf16* HS;
    __device__ __forceinline__ void operator()(AccRef acc, const pg8::Unit& u, int wr, int wc, int fr, int fq) const {
        const int cb = wc * 32 + 8 * fq;
        if (u.pn == 0) {
            EPI_ROWS_BEGIN
                float* p = LOG + (size_t)row * NE + cb;
                UNROLL for (int bj = 0; bj < 2; ++bj) { *(f32x4*)(p + bj * 128) = acc[ai][bj][m][0]; *(f32x4*)(p + bj * 128 + 4) = acc[ai][bj][m][1]; }
            EPI_ROWS_END
        } else {
            const int j = u.pn - 1;
            EPI_ROWS_BEGIN
                bf16* p = HS + (size_t)row * EH + j * 128 + cb;
                *(u32x4*)p = pack8(silu_mul4(acc[ai][0][m][0], acc[ai][1][m][0]), silu_mul4(acc[ai][0][m][1], acc[ai][1][m][1]));
            EPI_ROWS_END
        }
    }
};
struct EpiEGU { static constexpr bool PERM = true; bf16* HE;
    __device__ __forceinline__ void operator()(AccRef acc, const pg8::Unit& u, int wr, int wc, int fr, int fq) const {
        const int cb = wc * 32 + 8 * fq;
        EPI_ROWS_BEGIN
            bf16* p = HE + (size_t)row * EH + u.pn * 128 + cb;
            *(u32x4*)p = pack8(silu_mul4(acc[ai][0][m][0], acc[ai][1][m][0]), silu_mul4(acc[ai][0][m][1], acc[ai][1][m][1]));
        EPI_ROWS_END
    }
};
struct EpiEDown { static constexpr bool PERM = true; const int* list; bf16* Y;
    __device__ __forceinline__ void operator()(AccRef acc, const pg8::Unit& u, int wr, int wc, int fr, int fq) const {
        const int c0 = u.pn * 256 + wc * 32 + 8 * fq;
        UNROLL for (int ai = 0; ai < 2; ++ai)
            UNROLL for (int m = 0; m < 4; ++m) { const int rl = ai * 128 + wr * 64 + m * 16 + fr;
                if (rl < u.nrow) { const v2u ent = *(const v2u*)(list + ((size_t)u.e * ECAP + u.r0 + rl) * 2); const float w = __uint_as_float(ent.y);
                    bf16* p = Y + (size_t)ent.x * D + c0;
                    UNROLL for (int bj = 0; bj < 2; ++bj) *(u32x4*)(p + bj * 128) = pack8(acc[ai][bj][m][0] * w, acc[ai][bj][m][1] * w); } }
    }
};
struct EpiSDown { static constexpr bool PERM = true; bf16* YS;
    __device__ __forceinline__ void operator()(AccRef acc, const pg8::Unit& u, int wr, int wc, int fr, int fq) const {
        const int c0 = u.pn * 256 + wc * 32 + 8 * fq;
        EPI_ROWS_BEGIN
            bf16* p = YS + (size_t)row * D + c0;
            UNROLL for (int bj = 0; bj < 2; ++bj) *(u32x4*)(p + bj * 128) = pack8(acc[ai][bj][m][0], acc[ai][bj][m][1]);
        EPI_ROWS_END
    }
};

__device__ __forceinline__ void p0_item(const float* W, int N, bf16* WT, int ldw, int k0, int n0, int drow0, LAS float* scr, int lane) {
#pragma unroll 8
    for (int i = 0; i < 32; ++i) { const int kk = 2 * i + (lane >> 5); scr[kk * 33 + (lane & 31)] = W[(size_t)(k0 + kk) * N + n0 + (lane & 31)]; }
    LDS_WAIT(); asm volatile("" ::: "memory");
    const int c = lane & 7;
#pragma unroll
    for (int j = 0; j < 4; ++j) { const int n = (lane >> 3) + 8 * j; const LAS float* s = scr + (8 * c) * 33 + n;
        v4u o; o.x = pk2(s[0 * 33], s[1 * 33]); o.y = pk2(s[2 * 33], s[3 * 33]); o.z = pk2(s[4 * 33], s[5 * 33]); o.w = pk2(s[6 * 33], s[7 * 33]);
        *(GAS v4u*)(WT + (size_t)(drow0 + n) * ldw + k0 + 8 * c) = o; }
    LDS_WAIT(); asm volatile("" ::: "memory");
}
__device__ __forceinline__ int win_row(int n0) {
    if (n0 < 512) return n0;
    if (n0 < 1024) { const int q = n0 - 512; return 512 + (q >> 7) * 256 + (q & 127); }
    if (n0 < 1536) { const int q = n0 - 1024; return 512 + (q >> 7) * 256 + 128 + (q & 127); }
    return n0;
}
__device__ __forceinline__ int gu_row(int n0, int up) { return (n0 >> 7) * 256 + up * 128 + (n0 & 127); }
__device__ __forceinline__ void p0_prologue(Frame& F) {
    LAS float* scr = (LAS float*)(F.lds + RING_OFF + F.wave * 16384);
    const int gw = F.vcu * NWAVES + F.wave, NGW = F.G * NWAVES, lane = F.lane;
    unsigned char* ws = F.ws;
    constexpr int I_WIN = 16 * 112, I_POOL = 4 * 16, I_CVO = 8 * 32, I_WOUT = 16 * 32, I_RT = 16 * 8, I_SG = 128, I_SU = 128, I_SD = 4 * 32, I_EG = NE * 128, I_EU = NE * 128, I_ED = NE * 128;
    constexpr int NITEMS = I_WIN + I_POOL + I_CVO + I_WOUT + I_RT + I_SG + I_SU + I_SD + I_EG + I_EU + I_ED;
    for (int it = gw; it < NITEMS; it += NGW) {
        int r = it;
        if (r < I_EG) { const int e = r >> 7, rr = r & 127, kb = rr >> 3, nb = rr & 7;
            p0_item(F.in[13] + (size_t)e * D * EH, EH, (bf16*)(ws + WS_EGU) + (size_t)e * 512 * D, D, 64 * kb, 32 * nb, gu_row(32 * nb, 0), scr, lane); continue; } r -= I_EG;
        if (r < I_EU) { const int e = r >> 7, rr = r & 127, kb = rr >> 3, nb = rr & 7;
            p0_item(F.in[14] + (size_t)e * D * EH, EH, (bf16*)(ws + WS_EGU) + (size_t)e * 512 * D, D, 64 * kb, 32 * nb, gu_row(32 * nb, 1), scr, lane); continue; } r -= I_EU;
        if (r < I_ED) { const int e = r >> 7, rr = r & 127, kb = rr >> 5, nb = rr & 31;
            p0_item(F.in[15] + (size_t)e * EH * D, D, (bf16*)(ws + WS_EDN) + (size_t)e * D * EH, EH, 64 * kb, 32 * nb, 32 * nb, scr, lane); continue; } r -= I_ED;
        if (r < I_WIN) { const int kb = r / 112, nb = r % 112; p0_item(F.in[1], INC, (bf16*)(ws + WS_WIN), D, 64 * kb, 32 * nb, win_row(32 * nb), scr, lane); continue; } r -= I_WIN;
        if (r < I_POOL) { const int g = r >> 4, rr = r & 15, kb = rr >> 3, nb = rr & 7;
            p0_item(F.in[2] + (size_t)g * 128 * 256, 256, (bf16*)(ws + WS_POOL) + (size_t)g * 256 * 128, 128, 64 * kb, 32 * nb, 32 * nb, scr, lane); continue; } r -= I_POOL;
        if (r < I_CVO) { const int kb = r >> 5, nb = r & 31; p0_item(F.in[7], D, (bf16*)(ws + WS_CVO), CW, 64 * kb, 32 * nb, 32 * nb, scr, lane); continue; } r -= I_CVO;
        if (r < I_WOUT) { const int kb = r >> 5, nb = r & 31; p0_item(F.in[8], D, (bf16*)(ws + WS_WOUT), D, 64 * kb, 32 * nb, 32 * nb, scr, lane); continue; } r -= I_WOUT;
        if (r < I_RT) { const int kb = r >> 3, nb = r & 7; p0_item(F.in[11], NE, (bf16*)(ws + WS_RSH), D, 64 * kb, 32 * nb, 32 * nb, scr, lane); continue; } r -= I_RT;
        if (r < I_SG) { const int kb = r >> 3, nb = r & 7; p0_item(F.in[16], EH, (bf16*)(ws + WS_RSH), D, 64 * kb, 32 * nb, 256 + gu_row(32 * nb, 0), scr, lane); continue; } r -= I_SG;
        if (r < I_SU) { const int kb = r >> 3, nb = r & 7; p0_item(F.in[17], EH, (bf16*)(ws + WS_RSH), D, 64 * kb, 32 * nb, 256 + gu_row(32 * nb, 1), scr, lane); continue; } r -= I_SU;
        { const int kb = r >> 5, nb = r & 31; p0_item(F.in[18], D, (bf16*)(ws + WS_SDN), EH, 64 * kb, 32 * nb, 32 * nb, scr, lane); }
    }
    const GAS f32x4* x4 = (const GAS f32x4*)F.in[0]; GAS v4u* xb = (GAS v4u*)(ws + WS_XB);
    for (int i = (int)blockIdx.x * NTHR + F.tid; i < M * D / 8; i += F.G * NTHR) { const f32x4 a = x4[2 * i], b = x4[2 * i + 1];
        v4u o; o.x = pk2(a.x, a.y); o.y = pk2(a.z, a.w); o.z = pk2(b.x, b.y); o.w = pk2(b.z, b.w); xb[i] = o; }
}

__device__ __forceinline__ void ld8(const LAS unsigned char* p, float (&v)[8]) { const v4u w = *(const LAS v4u*)p;
    v[0] = pg8::bf_lo(w.x); v[1] = pg8::bf_hi(w.x); v[2] = pg8::bf_lo(w.y); v[3] = pg8::bf_hi(w.y); v[4] = pg8::bf_lo(w.z); v[5] = pg8::bf_hi(w.z); v[6] = pg8::bf_lo(w.w); v[7] = pg8::bf_hi(w.w); }
__device__ __forceinline__ void p2_mixer(Frame& F) {
    constexpr int TT = 32, VR = TT + CK - 1  , UR = TT + 15  , DW_BYTES = CK * CW * 4  ;
    LAS unsigned char* ldw = F.lds; LAS unsigned char* lrow = F.lds + DW_BYTES;
    const bf16* U = (const bf16*)(F.ws + WS_U); const bf16* V = (const bf16*)(F.ws + WS_V); bf16* Rb = (bf16*)(F.ws + WS_R); bf16* Cb = (bf16*)(F.ws + WS_C);
    const int lane = F.lane, w = F.wave;
    for (int i = F.tid; i < CK * CW / 4; i += NTHR) *(LAS f32x4*)(ldw + 16 * i) = *(const GAS f32x4*)(F.in[4] + 4 * i);
    for (int i = F.tid; i < 128; i += NTHR) *(LAS v4u*)(lrow + 62 * 1024 + 16 * i) = (v4u){0u, 0u, 0u, 0u};
    float lg[8], lb[8];
#pragma unroll
    for (int k = 0; k < 8; ++k) { lg[k] = F.in[5][lane * 8 + k]; lb[k] = F.in[6][lane * 8 + k]; }
    const int W = 2 << (lane >> 4);
    for (int unit = F.vcu; unit < M / TT; unit += F.G) {
        const int t0 = unit * TT, s0 = t0 % SEQ;
        __syncthreads();
        for (int c = F.tid; c < VR * 64; c += NTHR) { const int row = c >> 6, q = c & 63; const int s = s0 - (CK - 1) + row;
            v4u val = (v4u){0u, 0u, 0u, 0u}; if (s >= 0) val = *(const GAS v4u*)(V + (size_t)(t0 - (CK - 1) + row) * CW + q * 8);
            *(LAS v4u*)(lrow + row * 1024 + q * 16) = val; }
        __syncthreads();
        {
            float acc[4][8], wr_[4][8];
#pragma unroll
            for (int q = 0; q < 4; ++q)
#pragma unroll
                for (int k = 0; k < 8; ++k) { acc[q][k] = 0.f; wr_[q][k] = 0.f; }
#pragma unroll 1
            for (int i4 = 0; i4 < 9; ++i4) {
#pragma unroll
                for (int ii = 0; ii < 4; ++ii) { const int i = 4 * i4 + ii;
                    f32x4 a = (f32x4){0.f, 0.f, 0.f, 0.f}, b = a;
                    if (i <= 30) { a = *(const LAS f32x4*)(ldw + i * 2048 + lane * 32); b = *(const LAS f32x4*)(ldw + i * 2048 + lane * 32 + 16); }
                    wr_[ii][0] = a.x; wr_[ii][1] = a.y; wr_[ii][2] = a.z; wr_[ii][3] = a.w; wr_[ii][4] = b.x; wr_[ii][5] = b.y; wr_[ii][6] = b.z; wr_[ii][7] = b.w;
                    float v[8]; ld8(lrow + (4 * w + i) * 1024 + lane * 16, v);
#pragma unroll
                    for (int q = 0; q < 4; ++q) {
#pragma unroll
                        for (int k = 0; k < 8; ++k) acc[q][k] = fmaf(v[k], wr_[(ii - q) & 3][k], acc[q][k]); }
                }
            }
#pragma unroll
            for (int q = 0; q < 4; ++q) {
                float s = 0.f;
#pragma unroll
                for (int k = 0; k < 8; ++k) s += acc[q][k];
                const float mean = wave_sum(s) * (1.f / CW); float s2 = 0.f;
#pragma unroll
                for (int k = 0; k < 8; ++k) { acc[q][k] -= mean; s2 += acc[q][k] * acc[q][k]; }
                const float rstd = 1.f / sqrtf(wave_sum(s2) * (1.f / CW) + LN_EPS);
                float y[8];
#pragma unroll
                for (int k = 0; k < 8; ++k) { const float z = acc[q][k] * rstd * lg[k] + lb[k]; y[k] = z * pg8::sigmoidf_(z); }
                v4u o; o.x = pk2(y[0], y[1]); o.y = pk2(y[2], y[3]); o.z = pk2(y[4], y[5]); o.w = pk2(y[6], y[7]);
                *(GAS v4u*)(Cb + (size_t)(t0 + 4 * w + q) * CW + lane * 8) = o;
            }
        }
        __syncthreads();
        for (int c = F.tid; c < UR * 64; c += NTHR) { const int row = c >> 6, q = c & 63; const int s = s0 - 15 + row;
            v4u val = (v4u){0u, 0u, 0u, 0u}; if (s >= 0) val = *(const GAS v4u*)(U + (size_t)(t0 - 15 + row) * PW + q * 8);
            *(LAS v4u*)(lrow + row * 1024 + q * 16) = val; }
        __syncthreads();
        {
            float acc[4][8], own[4][8];
#pragma unroll
            for (int q = 0; q < 4; ++q)
#pragma unroll
                for (int k = 0; k < 8; ++k) { acc[q][k] = 0.f; own[q][k] = 0.f; }
#pragma unroll
            for (int i = 0; i < 19; ++i) {
                float v[8]; ld8(lrow + (4 * w + i) * 1024 + lane * 16, v);
#pragma unroll
                for (int q = 0; q < 4; ++q) { const int d = q + 15 - i; if (d >= 0 && d <= 15) { const bool in = d < W;
#pragma unroll
                    for (int k = 0; k < 8; ++k) { acc[q][k] += in ? v[k] : 0.f; if (d == 0) own[q][k] = v[k]; } } }
            }
#pragma unroll
            for (int q = 0; q < 4; ++q) { const int s = s0 + 4 * w + q; const int cnt = (s + 1) < W ? (s + 1) : W; const float inv = 1.f / (float)cnt;
                float y[8];
#pragma unroll
                for (int k = 0; k < 8; ++k) y[k] = acc[q][k] * inv - own[q][k];
                v4u o; o.x = pk2(y[0], y[1]); o.y = pk2(y[2], y[3]); o.z = pk2(y[4], y[5]); o.w = pk2(y[6], y[7]);
                *(GAS v4u*)(Rb + (size_t)(t0 + 4 * w + q) * PW + lane * 8) = o; }
        }
    }
    __syncthreads();
}

__device__ __forceinline__ void p6_ln1(Frame& F) {
    const int gw = F.vcu * NWAVES + F.wave, NGW = F.G * NWAVES, lane = F.lane;
    const float* Z = (const float*)(F.ws + WS_Z); bf16* X1 = (bf16*)(F.ws + WS_X1);
    f32x4 g[4], b[4];
#pragma unroll
    for (int j = 0; j < 4; ++j) { g[j] = *(const GAS f32x4*)(F.in[9] + 4 * lane + 256 * j); b[j] = *(const GAS f32x4*)(F.in[10] + 4 * lane + 256 * j); }
    for (int m = gw; m < M; m += NGW) {
        const GAS f32x4* zr = (const GAS f32x4*)(Z + (size_t)m * D) + lane;
        f32x4 v[4]; float s = 0.f;
#pragma unroll
        for (int j = 0; j < 4; ++j) { v[j] = zr[64 * j]; s += (v[j].x + v[j].y) + (v[j].z + v[j].w); }
        const float mean = wave_sum(s) * (1.f / D); float s2 = 0.f;
#pragma unroll
        for (int j = 0; j < 4; ++j) { v[j] = v[j] - mean; s2 += (v[j].x * v[j].x + v[j].y * v[j].y) + (v[j].z * v[j].z + v[j].w * v[j].w); }
        const float rstd = 1.f / sqrtf(wave_sum(s2) * (1.f / D) + LN_EPS);
        GAS v2u* o8 = (GAS v2u*)(X1 + (size_t)m * D) + lane;
#pragma unroll
        for (int j = 0; j < 4; ++j) { const f32x4 y = v[j] * rstd * g[j] + b[j]; v2u o; o.x = pk2(y.x, y.y); o.y = pk2(y.z, y.w); o8[64 * j] = o; }
    }
}

__device__ __forceinline__ void p8_route(Frame& F) {
    const int gw = F.vcu * NWAVES + F.wave, NGW = F.G * NWAVES, lane = F.lane;
    const float* LOG = (const float*)(F.ws + WS_LOG); int* list = (int*)(F.ws + WS_LIST); unsigned* cnt = (unsigned*)F.ctl + CW_CNT;
    const f32x4 bias = *(const GAS f32x4*)(F.in[12] + 4 * lane);
    const float NEG = -__builtin_inff();
    for (int tok = gw; tok < M; tok += NGW) {
        const f32x4 lg = *(const GAS f32x4*)(LOG + (size_t)tok * NE + 4 * lane);
        float sc0 = 1.f / (1.f + __expf(-lg.x)), sc1 = 1.f / (1.f + __expf(-lg.y)), sc2 = 1.f / (1.f + __expf(-lg.z)), sc3 = 1.f / (1.f + __expf(-lg.w));
        float c0 = sc0 + bias.x, c1 = sc1 + bias.y, c2 = sc2 + bias.z, c3 = sc3 + bias.w;
        const float h01 = fmaxf(c0, c1), l01 = fminf(c0, c1), h23 = fmaxf(c2, c3), l23 = fminf(c2, c3);
        float m1 = fmaxf(h01, h23), m2 = fmaxf(fminf(h01, h23), fmaxf(l01, l23));
#pragma unroll
        for (int o = 1; o < 8; o <<= 1) { const float b1 = __shfl_xor(m1, o), b2 = __shfl_xor(m2, o); const float n1 = fmaxf(m1, b1), n2 = fmaxf(fminf(m1, b1), fmaxf(m2, b2)); m1 = n1; m2 = n2; }
        const float gs = m1 + m2; const int mygrp = lane >> 3; int rank = 0;
#pragma unroll
        for (int g = 0; g < NG; ++g) { const float og = __shfl(gs, g * 8); rank += (og > gs || (og == gs && g < mygrp)) ? 1 : 0; }
        if (rank >= 4) { c0 = NEG; c1 = NEG; c2 = NEG; c3 = NEG; }
        float sumw = 0.f, mysc = 0.f; int myidx = 0;
#pragma unroll
        for (int r = 0; r < TOPK; ++r) {
            float bv = c0, bs = sc0; int gi = 4 * lane;
            if (c1 > bv) { bv = c1; bs = sc1; gi = 4 * lane + 1; }
            if (c2 > bv) { bv = c2; bs = sc2; gi = 4 * lane + 2; }
            if (c3 > bv) { bv = c3; bs = sc3; gi = 4 * lane + 3; }
#pragma unroll
            for (int o = 32; o >= 1; o >>= 1) { const float ov = __shfl_xor(bv, o), os = __shfl_xor(bs, o); const int oi = __shfl_xor(gi, o);
                const bool take = (ov > bv) || (ov == bv && oi < gi); if (take) { bv = ov; bs = os; gi = oi; } }
            if (lane == r) { myidx = gi; mysc = bs; }
            sumw += bs;
            if (gi == 4 * lane) c0 = NEG; if (gi == 4 * lane + 1) c1 = NEG; if (gi == 4 * lane + 2) c2 = NEG; if (gi == 4 * lane + 3) c3 = NEG;
        }
        if (lane < TOPK) { const float wgt = mysc / sumw * RSCALE; const unsigned pos = atomicAdd(&cnt[myidx], 1u);
            v2u ent; ent.x = (unsigned)(tok * TOPK + lane); ent.y = __float_as_uint(wgt); *(GAS v2u*)(list + ((size_t)myidx * ECAP + pos) * 2) = ent; }
    }
}

__device__ __forceinline__ int expert_table(Frame& F) {
    LAS int* tstart = (LAS int*)(F.lds + TAB_OFF); LAS int* cntl = tstart + 260; LAS int* wtot = tstart + 520;
    const unsigned* cnt = (const unsigned*)F.ctl + CW_CNT;
    __syncthreads();
    int c = 0, incl = 0;
    if (F.tid < NE) { c = (int)__hip_atomic_load(cnt + F.tid, RLX_AGENT); incl = (c + 255) >> 8;
#pragma unroll
        for (int o = 1; o < 64; o <<= 1) { const int up = __shfl_up(incl, o); if (F.lane >= o) incl += up; }
        if (F.lane == 63) wtot[F.wave] = incl; cntl[F.tid] = c; }
    __syncthreads();
    if (F.tid < NE) { int base = 0;
#pragma unroll
        for (int k = 0; k < 4; ++k) if (k < F.wave) base += wtot[k];
        tstart[F.tid + 1] = base + incl; if (F.tid == 0) tstart[0] = 0; }
    __syncthreads();
    return tstart[NE];
}

__device__ __forceinline__ void p11_combine(Frame& F) {
    const int gw = F.vcu * NWAVES + F.wave, NGW = F.G * NWAVES, lane = F.lane;
    const bf16* Y = (const bf16*)(F.ws + WS_Y); const bf16* YS = (const bf16*)(F.ws + WS_YSH); const bf16* X1 = (const bf16*)(F.ws + WS_X1);
    for (int tok = gw; tok < M; tok += NGW) {
        f32x4 a[4];
#pragma unroll
        for (int j = 0; j < 2; ++j) { f32x4 x0, x1; unpack8(*(const GAS v4u*)(X1 + (size_t)tok * D + lane * 8 + 512 * j), x0, x1); a[2 * j] = x0 * ALPHA; a[2 * j + 1] = x1 * ALPHA;
#if !(defined(DBG_COMBINE) && (DBG_COMBINE & 2))
            f32x4 s0, s1; unpack8(*(const GAS v4u*)(YS + (size_t)tok * D + lane * 8 + 512 * j), s0, s1); a[2 * j] += s0; a[2 * j + 1] += s1;
#endif
        }
#if !(defined(DBG_COMBINE) && (DBG_COMBINE & 1))
#pragma unroll
        for (int k = 0; k < TOPK; ++k)
#pragma unroll
            for (int j = 0; j < 2; ++j) { f32x4 y0, y1; unpack8(*(const GAS v4u*)(Y + ((size_t)tok * TOPK + k) * D + lane * 8 + 512 * j), y0, y1); a[2 * j] += y0; a[2 * j + 1] += y1; }
#endif
        float s = 0.f;
#pragma unroll
        for (int j = 0; j < 4; ++j) s += (a[j].x + a[j].y) + (a[j].z + a[j].w);
        const float mean = wave_sum(s) * (1.f / D); float s2 = 0.f;
#pragma unroll
        for (int j = 0; j < 4; ++j) { a[j] = a[j] - mean; s2 += (a[j].x * a[j].x + a[j].y * a[j].y) + (a[j].z * a[j].z + a[j].w * a[j].w); }
        const float rstd = 1.f / sqrtf(wave_sum(s2) * (1.f / D) + LN_EPS);
#pragma unroll
        for (int j = 0; j < 4; ++j) { const int col = lane * 8 + 512 * (j >> 1) + 4 * (j & 1);
            const f32x4 g = *(const GAS f32x4*)(F.in[19] + col), b = *(const GAS f32x4*)(F.in[20] + col);
            *(GAS f32x4*)(F.out + (size_t)tok * D + col) = a[j] * rstd * g + b; }
    }
}
#ifdef DBG_CHECK
constexpr int NT = 512;
constexpr size_t DBG_OFF = 448 * MiB;
__device__ __forceinline__ float dsig(float x) { return 1.f / (1.f + expf(-x)); }
__device__ __forceinline__ float bf2f(unsigned short h) { return __uint_as_float((unsigned)h << 16); }
__global__ void dbg_proj(const float* x, const float* w_in, float* PN) {
    for (int i = blockIdx.x * blockDim.x + threadIdx.x; i < NT * INC; i += gridDim.x * blockDim.x) { const int tok = i / INC, col = i % INC; float a = 0.f;
        for (int k = 0; k < D; ++k) a = fmaf(x[(size_t)tok * D + k], w_in[(size_t)k * INC + col], a); PN[i] = a; }
}
__global__ void dbg_mix1(const float* PN, const float* dw, float* RN, float* CVN) {
    for (int i = blockIdx.x * blockDim.x + threadIdx.x; i < NT * 512; i += gridDim.x * blockDim.x) { const int tok = i / 512, ch = i % 512; const int g = ch / 128, W = 2 << g;
        float s = 0.f; int cnt = 0; for (int j = 0; j < W; ++j) if (tok - j >= 0) { s += PN[(size_t)(tok - j) * INC + ch]; ++cnt; }
        RN[i] = s / (float)cnt - PN[(size_t)tok * INC + ch];
        float c = 0.f; for (int j = 0; j < CK; ++j) { const int t = tok - (CK - 1) + j; if (t >= 0) c += PN[(size_t)t * INC + 512 + ch] * dsig(PN[(size_t)t * INC + 1024 + ch]) * dw[j * 512 + ch]; }
        CVN[i] = c; }
}
__global__ void dbg_ln(const float* IN, int n, const float* g, const float* b, float* OUT, int act) {
    const int tok = blockIdx.x * blockDim.x + threadIdx.x; if (tok >= NT) return;
    float m = 0.f; for (int k = 0; k < n; ++k) m += IN[(size_t)tok * n + k]; m /= n; float v = 0.f; for (int k = 0; k < n; ++k) { const float d = IN[(size_t)tok * n + k] - m; v += d * d; } v /= n;
    const float r = 1.f / sqrtf(v + LN_EPS); for (int k = 0; k < n; ++k) { float y = (IN[(size_t)tok * n + k] - m) * r * g[k] + b[k]; if (act) y = y * dsig(y); OUT[(size_t)tok * n + k] = y; }
}
__global__ void dbg_mix3(const float* PN, const float* RN, const float* CN, const float* pool_w, const float* scale, const float* cwo, float* MGN) {
    for (int i = blockIdx.x * blockDim.x + threadIdx.x; i < NT * D; i += gridDim.x * blockDim.x) { const int tok = i / D, d = i % D, g = d / 256, dd = d % 256;
        float yp = 0.f; for (int c = 0; c < 128; ++c) yp = fmaf(RN[(size_t)tok * 512 + g * 128 + c], pool_w[((size_t)g * 128 + c) * 256 + dd], yp); yp *= scale[d];
        float yc = 0.f; for (int c = 0; c < 512; ++c) yc = fmaf(CN[(size_t)tok * 512 + c], cwo[(size_t)c * D + d], yc);
        MGN[i] = dsig(PN[(size_t)tok * INC + 1536 + d]) * yp + dsig(PN[(size_t)tok * INC + 2560 + d]) * yc; }
}
__global__ void dbg_mix4(const float* MGN, const float* w_out, const float* x, float* ZN) {
    for (int i = blockIdx.x * blockDim.x + threadIdx.x; i < NT * D; i += gridDim.x * blockDim.x) { const int tok = i / D, e = i % D; float a = 0.f;
        for (int d = 0; d < D; ++d) a = fmaf(MGN[(size_t)tok * D + d], w_out[(size_t)d * D + e], a); ZN[i] = ALPHA * x[(size_t)tok * D + e] + a; }
}
__global__ void dbg_cmp(int k, const void* buf, int kind, int ld, int n, const float* NV, int nld, int ncol0, int fn, const float* PN, float* acc) {
    float e2 = 0.f, r2 = 0.f;
    for (int i = blockIdx.x * blockDim.x + threadIdx.x; i < NT * n; i += gridDim.x * blockDim.x) { const int tok = i / n, c = i % n;
        const float a = kind ? ((const float*)buf)[(size_t)tok * ld + c] : bf2f(((const unsigned short*)buf)[(size_t)tok * ld + c]);
        float b = NV[(size_t)tok * nld + ncol0 + c];
        if (fn == 1) b = dsig(b);
        if (fn == 2) b = b * dsig(PN[(size_t)tok * INC + 1024 + c]);
        e2 += (a - b) * (a - b); r2 += b * b; }
    atomicAdd(acc + 2 * k, e2); atomicAdd(acc + 2 * k + 1, r2);
}
__global__ void dbg_cmp_tile(int k, const void* buf, int ld, int r0, int c0, const float* NV, int nld, int ncol0, float* acc) {
    float e2 = 0.f, r2 = 0.f;
    for (int i = blockIdx.x * blockDim.x + threadIdx.x; i < 256 * 256; i += gridDim.x * blockDim.x) { const int tok = r0 + i / 256, c = c0 + i % 256;
        const float a = bf2f(((const unsigned short*)buf)[(size_t)tok * ld + c]); const float b = dsig(NV[(size_t)tok * nld + ncol0 + c]);
        e2 += (a - b) * (a - b); r2 += b * b; }
    atomicAdd(acc + 2 * k, e2); atomicAdd(acc + 2 * k + 1, r2);
}
__global__ void dbg_cmp_wt(int k, const unsigned short* WT, const float* W, int n0, float* acc) {
    float e2 = 0.f, r2 = 0.f;
    for (int i = blockIdx.x * blockDim.x + threadIdx.x; i < 256 * 1024; i += gridDim.x * blockDim.x) { const int n = n0 + i / 1024, kk = i % 1024;
        const float a = bf2f(WT[(size_t)n * 1024 + kk]); const float b = W[(size_t)kk * INC + n];
        e2 += (a - b) * (a - b); r2 += b * b; }
    atomicAdd(acc + 2 * k, e2); atomicAdd(acc + 2 * k + 1, r2);
}
__global__ void dbg_code(const float* acc, int nchk, float* out, int n) {
    int code = 0; for (int k = nchk - 1; k >= 0; --k) if (!(acc[2 * k] <= 1e-3f * acc[2 * k + 1])) code = k + 1;
#ifdef DBG_TILES
    code = 0; for (int k = 0; k < 4; ++k) if (!(acc[2 * (16 + k)] <= 1e-3f * acc[2 * (16 + k) + 1])) code |= 1 << k;
#endif
#ifdef DBG_SHOW
    const float val = sqrtf(1000.f * acc[2 * DBG_SHOW] / acc[2 * DBG_SHOW + 1]);
    for (int i = blockIdx.x * blockDim.x + threadIdx.x; i < n; i += gridDim.x * blockDim.x) out[i] = val;
#else
    for (int i = blockIdx.x * blockDim.x + threadIdx.x; i < n; i += gridDim.x * blockDim.x) out[i] = (float)code;
#endif
}
static void dbg_run(void* const* d_in, float* d_out, unsigned char* ws, hipStream_t st, int stop) {
    float* PN = d_out; float* RN = PN + (size_t)NT * INC; float* CVN = RN + NT * 512; float* CN = CVN + NT * 512; float* MGN = CN + NT * 512; float* ZN = MGN + (size_t)NT * D; float* X1N = ZN + (size_t)NT * D; float* acc = X1N + (size_t)NT * D;
    const float* x = (const float*)d_in[0];
    hipMemsetAsync(acc, 0, 64 * 4, st);
    dbg_proj<<<2048, 256, 0, st>>>(x, (const float*)d_in[1], PN);
    dbg_mix1<<<1024, 256, 0, st>>>(PN, (const float*)d_in[4], RN, CVN);
    dbg_ln<<<NT / 64, 64, 0, st>>>(CVN, 512, (const float*)d_in[5], (const float*)d_in[6], CN, 1);
    dbg_mix3<<<2048, 256, 0, st>>>(PN, RN, CN, (const float*)d_in[2], (const float*)d_in[3], (const float*)d_in[7], MGN);
    dbg_mix4<<<2048, 256, 0, st>>>(MGN, (const float*)d_in[8], x, ZN);
    dbg_ln<<<NT / 64, 64, 0, st>>>(ZN, D, (const float*)d_in[9], (const float*)d_in[10], X1N, 0);
    if (stop <= 4) {
    dbg_cmp<<<256, 256, 0, st>>>(0, ws + WS_U, 0, 512, 512, PN, INC, 0, 0, PN, acc);
    dbg_cmp<<<256, 256, 0, st>>>(1, ws + WS_V, 0, 512, 512, PN, INC, 512, 2, PN, acc);
    dbg_cmp<<<256, 256, 0, st>>>(2, ws + WS_GP, 0, D, D, PN, INC, 1536, 1, PN, acc);
    dbg_cmp<<<256, 256, 0, st>>>(3, ws + WS_GC, 0, D, D, PN, INC, 2560, 1, PN, acc);
    }
    dbg_cmp<<<256, 256, 0, st>>>(4, ws + WS_R, 0, 512, 512, RN, 512, 0, 0, PN, acc);
    dbg_cmp<<<256, 256, 0, st>>>(5, ws + WS_C, 0, 512, 512, CN, 512, 0, 0, PN, acc);
    if (stop >= 7) {
    dbg_cmp<<<256, 256, 0, st>>>(6, ws + WS_MG, 0, D, D, MGN, D, 0, 0, PN, acc);
    dbg_cmp<<<256, 256, 0, st>>>(7, ws + WS_Z, 1, D, D, ZN, D, 0, 0, PN, acc);
    dbg_cmp<<<256, 256, 0, st>>>(8, ws + WS_X1, 0, D, D, X1N, D, 0, 0, PN, acc);
    }
#ifdef DBG_WT
    dbg_cmp_wt<<<256, 256, 0, st>>>(DBG_SHOW, (const unsigned short*)(ws + WS_WIN), (const float*)d_in[1], DBG_WT, acc);
#endif
#ifdef DBG_TILES
    for (int t = 0; t < 4; ++t) dbg_cmp_tile<<<64, 256, 0, st>>>(16 + t, ws + ((DBG_TILES & 2) ? WS_GC : WS_GP), D, (DBG_TILES & 1) * 256, t * 256, PN, INC, ((DBG_TILES & 2) ? 2560 : 1536), acc);
#endif
    hipMemcpyAsync(ws + WS_CTL + 65536, acc, 64 * 4, hipMemcpyDeviceToDevice, st);
    dbg_code<<<1024, 256, 0, st>>>((const float*)(ws + WS_CTL + 65536), 9, d_out, M * D);
}
#endif

#ifndef MK_N_LAUNCHES
#define MK_N_LAUNCHES 1
#endif
constexpr int N_PHASES = 12;
struct Args { const float* in[21]; float* out; unsigned char* ws; int ph_lo, ph_hi; };
__global__ void __launch_bounds__(NTHR, 2) mk_fwd(Args args) {
    extern __shared__ __attribute__((aligned(16))) unsigned char lds[];
    Frame F;
    F.lds = (LAS unsigned char*)lds;
    F.MISC = (volatile LAS unsigned*)(F.lds + MISC_OFF);
    F.tid = threadIdx.x; F.lane = F.tid & 63; F.wave = __builtin_amdgcn_readfirstlane(F.tid >> 6);
    F.G = gridDim.x; { const int bx = blockIdx.x; F.vcu = (F.G % 8 == 0) ? (bx % 8) * (F.G / 8) + bx / 8 : bx; }
    F.ws = args.ws; F.ctl = (gu32*)(args.ws + WS_CTL); F.out = args.out;
#pragma unroll
    for (int i = 0; i < 21; ++i) F.in[i] = args.in[i];
    for (int u = F.tid; u < (LDS_BYTES - TAB_OFF) / 4; u += NTHR) ((LAS unsigned*)(F.lds + TAB_OFF))[u] = 0u;
    __syncthreads();
    const int lo = args.ph_lo, hi = args.ph_hi;
    const bool multi = (hi - lo) > 1;
    XcdBarrier bar; bar.bar = (unsigned*)(F.ctl + CW_BAR); bar.x = 0; bar.st = nullptr;
    if (multi) bar = xcd_barrier_post((unsigned*)(F.ctl + CW_BAR), F.MISC + 8);
#ifndef PH_MASK
#define PH_MASK 0xFFF
#endif
#define IN(k) ((((PH_MASK) >> (k)) & 1) && lo <= (k) && (k) < hi)
#define SEAM(k) do { if (IN(k) && IN((k) + 1)) xcd_barrier(bar); } while (0)
    unsigned char* ws = args.ws;
    LAS unsigned char* ring = F.lds + RING_OFF;
    const int bx = (int)blockIdx.x;

    if (IN(0)) { p0_prologue(F); } SEAM(0);
    if (IN(1)) { DenseOrder S; S.init((const bf16*)(ws + WS_XB), (const bf16*)(ws + WS_WIN), M, INC, D, D, D, 0, F.G, bx);
        EpiProj E{(bf16*)(ws + WS_U), (bf16*)(ws + WS_V), (bf16*)(ws + WS_GP), (bf16*)(ws + WS_GC)};
        pg8::gemm_phase<EpiProj, DenseOrder>(ring, S, E); } SEAM(1);
    if (IN(2)) { p2_mixer(F); } SEAM(2);
    if (IN(3)) { DenseOrder S; S.init((const bf16*)(ws + WS_R), (const bf16*)(ws + WS_POOL), M, D, 128, PW, 128, 128, F.G, bx);
        EpiPool E{F.in[3], (const bf16*)(ws + WS_GP), (bf16*)(ws + WS_T1)};
        pg8::gemm_phase<EpiPool, DenseOrder>(ring, S, E); } SEAM(3);
    if (IN(4)) { DenseOrder S; S.init((const bf16*)(ws + WS_C), (const bf16*)(ws + WS_CVO), M, D, CW, CW, CW, 0, F.G, bx);
        EpiConvOut E{(const bf16*)(ws + WS_T1), (const bf16*)(ws + WS_GC), (bf16*)(ws + WS_MG)};
        pg8::gemm_phase<EpiConvOut, DenseOrder>(ring, S, E); } SEAM(4);
    if (IN(5)) { DenseOrder S; S.init((const bf16*)(ws + WS_MG), (const bf16*)(ws + WS_WOUT), M, D, D, D, D, 0, F.G, bx);
        EpiWout E{F.in[0], (float*)(ws + WS_Z)};
        pg8::gemm_phase<EpiWout, DenseOrder>(ring, S, E); } SEAM(5);
    if (IN(6)) { p6_ln1(F); } SEAM(6);
    if (IN(7)) { DenseOrder S; S.init((const bf16*)(ws + WS_X1), (const bf16*)(ws + WS_RSH), M, 768, D, D, D, 0, F.G, bx);
        EpiRSh E{(float*)(ws + WS_LOG), (bf16*)(ws + WS_HS)};
        pg8::gemm_phase<EpiRSh, DenseOrder>(ring, S, E); } SEAM(7);
    if (IN(8)) { p8_route(F); } SEAM(8);
    if (IN(9)) { const int tt = expert_table(F);
        ExpertOrder<true> S; S.A = (const bf16*)(ws + WS_X1); S.Bt = (const bf16*)(ws + WS_EGU); S.lda = D; S.ldb = D; S.nt = D / 64; S.bstride = (size_t)512 * D;
        S.tstart = (const LAS int*)(F.lds + TAB_OFF); S.cntl = S.tstart + 260; S.list = (const int*)(ws + WS_LIST); S.nN = 2; S.nwg = tt * 2; S.G = F.G; S.c = bx;
        EpiEGU E{(bf16*)(ws + WS_HE)};
        pg8::gemm_phase<EpiEGU, ExpertOrder<true>>(ring, S, E); } SEAM(9);
    if (IN(10)) { const int tt = expert_table(F);
        { ExpertOrder<false> S; S.A = (const bf16*)(ws + WS_HE); S.Bt = (const bf16*)(ws + WS_EDN); S.lda = EH; S.ldb = EH; S.nt = EH / 64; S.bstride = (size_t)D * EH;
          S.tstart = (const LAS int*)(F.lds + TAB_OFF); S.cntl = S.tstart + 260; S.list = (const int*)(ws + WS_LIST); S.nN = 4; S.nwg = tt * 4; S.G = F.G; S.c = bx;
          EpiEDown E{(const int*)(ws + WS_LIST), (bf16*)(ws + WS_Y)};
          pg8::gemm_phase<EpiEDown, ExpertOrder<false>>(ring, S, E); }
        { DenseOrder S; S.init((const bf16*)(ws + WS_HS), (const bf16*)(ws + WS_SDN), M, D, EH, EH, EH, 0, F.G, bx);
          EpiSDown E{(bf16*)(ws + WS_YSH)};
          pg8::gemm_phase<EpiSDown, DenseOrder>(ring, S, E); } } SEAM(10);
    if (IN(11)) { p11_combine(F); }
#undef IN
#undef SEAM
}

extern "C" void kernel_launch(void* const* d_in, const int* in_sizes, int n_in, void* d_out, int out_size, void* d_ws, size_t ws_size, hipStream_t stream) {
    static int grid = 0;
    if (grid == 0) {
        if (n_in != 21 || in_sizes[0] != M * D || out_size != M * D || ws_size < WS_END) { fprintf(stderr, "kernel_launch: unexpected shapes (n_in %d, in0 %d, out %d, ws %zu)\n", n_in, n_in > 0 ? in_sizes[0] : -1, out_size, ws_size); grid = -1; return; }
        int dev = 0, cus = 0;
        if (hipGetDevice(&dev) != hipSuccess || hipDeviceGetAttribute(&cus, hipDeviceAttributeMultiprocessorCount, dev) != hipSuccess) { grid = -1; return; }
        if (hipFuncSetAttribute((const void*)mk_fwd, hipFuncAttributeMaxDynamicSharedMemorySize, LDS_BYTES) != hipSuccess) { fprintf(stderr, "kernel_launch: hipFuncSetAttribute failed\n"); grid = -1; return; }
        (void)hipGetLastError();
        grid = cus;
    }
    if (grid < 0) return;
    (void)hipMemsetAsync((char*)d_ws + WS_CTL, 0, CTL_ZERO_BYTES, stream);
    Args a{};
    for (int i = 0; i < 21; ++i) a.in[i] = (const float*)d_in[i];
    a.out = (float*)d_out; a.ws = (unsigned char*)d_ws;
    constexpr int NL = MK_N_LAUNCHES;
    for (int li = 0; li < NL; ++li) {
        a.ph_lo = (NL == 1) ? 0 : li; a.ph_hi = (NL == 1) ? N_PHASES : li + 1;
        hipLaunchKernelGGL(mk_fwd, dim3(grid), dim3(NTHR), LDS_BYTES, stream, a);
#ifdef DBG_CHECK
        if (a.ph_hi == DBG_CHECK) { dbg_run(d_in, (float*)d_out, (unsigned char*)d_ws, stream, DBG_CHECK); return; }
#endif
    }
}
```

```cpp
#define MK_N_LAUNCHES 1

#include <hip/hip_runtime.h>
#include <cstdio>
#include <cstdint>

namespace pg8 {
#define PG8_LAS __attribute__((address_space(3)))
typedef unsigned short bf16_t;
typedef short bf16x8 __attribute__((ext_vector_type(8)));
typedef float f32x4 __attribute__((ext_vector_type(4)));
typedef float f32x2 __attribute__((ext_vector_type(2)));
typedef unsigned u32x4 __attribute__((ext_vector_type(4)));
typedef unsigned u32x2 __attribute__((ext_vector_type(2)));
constexpr int BM = 256, BK = 64, HALF = 128, HTB = HALF * BK * 2  , STAGE_BYTES = 8 * HTB, NXCD = 8, WGM = 8;

__host__ __device__ __forceinline__ int lds_byte(int r, int c) { const int st = (r >> 4) * 2 + (c >> 5), rr = r & 15, cc = c & 31, ob = rr * 64 + cc * 2; return st * 1024 + (ob ^ (((ob >> 9) & 1) << 5)); }
__host__ __device__ __forceinline__ void stage_rc(int b, int& R, int& C) { const int st = b / 1024, sb = b % 1024, swz = sb ^ (((sb >> 9) & 1) << 5); R = (st >> 1) * 16 + swz / 64; C = (st & 1) * 32 + (swz % 64) / 2; }
__host__ __device__ __forceinline__ int perm32(int rho) { const int n = rho >> 4, i = rho & 15; return 8 * (i >> 2) + 4 * n + (i & 3); }

struct Unit { int pm, pn, e, r0, nrow; };

typedef __bf16 bf16x2_t __attribute__((ext_vector_type(2)));
__device__ __forceinline__ unsigned cvt_pk_bf16(float lo, float hi) { f32x2 v = {lo, hi}; bf16x2_t b = __builtin_convertvector(v, bf16x2_t); return __builtin_bit_cast(unsigned, b); }
__device__ __forceinline__ u32x4 pack8(const f32x4 a, const f32x4 b) { u32x4 w; w.x = cvt_pk_bf16(a[0], a[1]); w.y = cvt_pk_bf16(a[2], a[3]); w.z = cvt_pk_bf16(b[0], b[1]); w.w = cvt_pk_bf16(b[2], b[3]); return w; }
__device__ __forceinline__ float bf_lo(unsigned w) { return __uint_as_float(w << 16); }
__device__ __forceinline__ float bf_hi(unsigned w) { return __uint_as_float(w & 0xffff0000u); }
__device__ __forceinline__ void unpack8(const u32x4 w, f32x4& a, f32x4& b) { a = (f32x4){bf_lo(w.x), bf_hi(w.x), bf_lo(w.y), bf_hi(w.y)}; b = (f32x4){bf_lo(w.z), bf_hi(w.z), bf_lo(w.w), bf_hi(w.w)}; }
__device__ __forceinline__ float sigmoidf_(float x) { return __builtin_amdgcn_rcpf(1.0f + __expf(-x)); }
__device__ __forceinline__ f32x4 sigmoid4(const f32x4 x) { return (f32x4){sigmoidf_(x[0]), sigmoidf_(x[1]), sigmoidf_(x[2]), sigmoidf_(x[3])}; }

template <class Epi, class Sched>
__device__ __forceinline__ void gemm_phase(PG8_LAS unsigned char* lds, const Sched& S, const Epi& E) {
    const int tid = threadIdx.x, wid = __builtin_amdgcn_readfirstlane(tid >> 6), lane = tid & 63, wr = wid >> 2, wc = wid & 3, fr = lane & 15, fq = lane >> 4;
    int nt_ = S.nt; asm volatile("" : "+s"(nt_));
    const int nt = nt_;
    int sR[2], sC[2]; unsigned voffB[2];
#pragma unroll
    for (int i = 0; i < 2; ++i) { int R, C; stage_rc(tid * 16 + i * 8192, R, C); const int Rb = Epi::PERM ? ((R & ~31) + perm32(R & 31)) : R;
        sR[i] = R; sC[i] = C; voffB[i] = (unsigned)(Rb * S.ldb + C) * 2u; }
    const size_t kstep = (size_t)(BK * 2);
    const size_t hstepB = (size_t)HALF * S.ldb * 2;
    const unsigned ldsw = (unsigned)wid * 1024u;
    const int aoff = lds_byte(wr * 64 + fr, fq * 8), boff = lds_byte(wc * 32 + fr, fq * 8);
#define PG8_SA(b, h) (((b) * 2 + (h)) * HTB)
#define PG8_SB(b, h) ((4 + (b) * 2 + (h)) * HTB)
#define PG8_STAGE(bufoff, gbase, voff) do { _Pragma("unroll") for (int _i = 0; _i < 2; ++_i) \
        __builtin_amdgcn_global_load_lds((const unsigned*)((const char*)(gbase) + (voff)[_i]), (PG8_LAS unsigned*)(lds + (bufoff) + ldsw + _i * 8192), 16, 0, 0); } while (0)
#define PG8_LDA(dst, b, h) do { _Pragma("unroll") for (int m = 0; m < 4; ++m) _Pragma("unroll") for (int k = 0; k < 2; ++k) dst[m][k] = *(const PG8_LAS bf16x8*)(lds + PG8_SA(b, h) + aoff + m * 2048 + k * 1024); } while (0)
#define PG8_LDB(dst, b, h) do { _Pragma("unroll") for (int n = 0; n < 2; ++n) _Pragma("unroll") for (int k = 0; k < 2; ++k) dst[n][k] = *(const PG8_LAS bf16x8*)(lds + PG8_SB(b, h) + boff + n * 2048 + k * 1024); } while (0)
#define PG8_MMA(ai, bj, At, Bt) do { __builtin_amdgcn_s_setprio(1); _Pragma("unroll") for (int m = 0; m < 4; ++m) _Pragma("unroll") for (int n = 0; n < 2; ++n) _Pragma("unroll") for (int k = 0; k < 2; ++k) \
        acc[ai][bj][m][n] = __builtin_amdgcn_mfma_f32_16x16x32_bf16(Bt[n][k], At[m][k], acc[ai][bj][m][n], 0, 0, 0); __builtin_amdgcn_s_setprio(0); } while (0)
#define PG8_WAIT_V(n) asm volatile("s_waitcnt vmcnt(" #n ")" ::: "memory")
#define PG8_WAIT_L(n) asm volatile("s_waitcnt lgkmcnt(" #n ")" ::: "memory")
#define PG8_BAR __builtin_amdgcn_s_barrier()
#define PG8_SCHED __builtin_amdgcn_sched_barrier(0)
    Unit cur, nxt; int ui = 0;
    if (!S.next(0, cur)) return;
    f32x4 acc[2][2][4][2];
#pragma unroll
    for (int a = 0; a < 2; ++a)
#pragma unroll
        for (int b = 0; b < 2; ++b)
#pragma unroll
            for (int m = 0; m < 4; ++m)
#pragma unroll
                for (int n = 0; n < 2; ++n) acc[a][b][m][n] = (f32x4){0.f, 0.f, 0.f, 0.f};
    bf16x8 At[4][2], B0[2][2], B1[2][2];
    unsigned cvo[2][2], nvo[2][2];
    const char* cA = S.a_ptr(cur); const char* cB = S.b_ptr(cur);
    S.a_off(cur, sR, sC, cvo);
    PG8_STAGE(PG8_SB(0, 0), cB, voffB); PG8_STAGE(PG8_SB(0, 1), cB + hstepB, voffB); PG8_STAGE(PG8_SA(0, 0), cA, cvo[0]); PG8_STAGE(PG8_SA(0, 1), cA, cvo[1]);
    if (wr == 1) PG8_BAR;
    PG8_WAIT_V(2); PG8_BAR;
    PG8_STAGE(PG8_SB(1, 0), cB + kstep, voffB); PG8_STAGE(PG8_SA(1, 0), cA + kstep, cvo[0]); PG8_STAGE(PG8_SB(1, 1), cB + hstepB + kstep, voffB);
    PG8_WAIT_V(6); PG8_BAR;
    for (;;) {
        const bool has_next = S.next(ui + 1, nxt);
        const char* nA = cA; const char* nB = cB;
#pragma unroll
        for (int h = 0; h < 2; ++h)
#pragma unroll
            for (int i = 0; i < 2; ++i) nvo[h][i] = cvo[h][i];
        if (has_next) { nA = S.a_ptr(nxt); nB = S.b_ptr(nxt); S.a_off(nxt, sR, sC, nvo); }
        for (int t = 0; t < nt; t += 2) {
            const bool last = (t == nt - 2);
            const char* a1 = cA + (size_t)(t + 1) * kstep;
            const char* a2 = last ? nA : cA + (size_t)(t + 2) * kstep; const char* b2 = last ? nB : cB + (size_t)(t + 2) * kstep;
            const char* a3 = a2 + kstep; const char* b3 = b2 + kstep;
            unsigned xvo[2][2];
#pragma unroll
            for (int h = 0; h < 2; ++h)
#pragma unroll
                for (int i = 0; i < 2; ++i) xvo[h][i] = last ? nvo[h][i] : cvo[h][i];
            PG8_LDB(B0, 0, 0); PG8_LDB(B1, 0, 1); PG8_SCHED; PG8_LDA(At, 0, 0); PG8_STAGE(PG8_SA(1, 1), a1, cvo[1]);
            PG8_WAIT_V(8); PG8_WAIT_L(0); PG8_BAR; PG8_MMA(0, 0, At, B0); PG8_MMA(0, 1, At, B1); PG8_BAR; PG8_SCHED;
            PG8_LDA(At, 0, 1); PG8_STAGE(PG8_SB(0, 0), b2, voffB); PG8_STAGE(PG8_SB(0, 1), b2 + hstepB, voffB); PG8_STAGE(PG8_SA(0, 0), a2, xvo[0]);
            PG8_WAIT_V(8); PG8_WAIT_L(0); PG8_BAR; PG8_MMA(1, 0, At, B0); PG8_MMA(1, 1, At, B1); PG8_BAR; PG8_SCHED;
            PG8_LDB(B0, 1, 0); PG8_LDB(B1, 1, 1); PG8_SCHED; PG8_LDA(At, 1, 0); PG8_STAGE(PG8_SA(0, 1), a2, xvo[1]);
            PG8_WAIT_V(8); PG8_WAIT_L(0); PG8_BAR; PG8_MMA(0, 0, At, B0); PG8_MMA(0, 1, At, B1); PG8_BAR; PG8_SCHED;
            PG8_LDA(At, 1, 1); PG8_STAGE(PG8_SB(1, 0), b3, voffB); PG8_STAGE(PG8_SB(1, 1), b3 + hstepB, voffB); PG8_STAGE(PG8_SA(1, 0), a3, xvo[0]);
            PG8_WAIT_V(8); PG8_WAIT_L(0); PG8_BAR; PG8_MMA(1, 0, At, B0); PG8_MMA(1, 1, At, B1); PG8_BAR; PG8_SCHED;
        }
        if (wr == 0) PG8_BAR;
        E(acc, cur, wr, wc, fr, fq);
        if (!has_next) break;
#pragma unroll
        for (int a = 0; a < 2; ++a)
#pragma unroll
            for (int b = 0; b < 2; ++b)
#pragma unroll
                for (int m = 0; m < 4; ++m)
#pragma unroll
                    for (int n = 0; n < 2; ++n) acc[a][b][m][n] = (f32x4){0.f, 0.f, 0.f, 0.f};
        cur = nxt; cA = nA; cB = nB; ++ui;
#pragma unroll
        for (int h = 0; h < 2; ++h)
#pragma unroll
            for (int i = 0; i < 2; ++i) cvo[h][i] = nvo[h][i];
        if (wr == 1) PG8_BAR;
    }
    PG8_WAIT_V(0);
    PG8_BAR;
#undef PG8_SA
#undef PG8_SB
#undef PG8_STAGE
#undef PG8_LDA
#undef PG8_LDB
#undef PG8_MMA
#undef PG8_WAIT_V
#undef PG8_WAIT_L
#undef PG8_BAR
#undef PG8_SCHED
}
}

constexpr int NWAVES = 8, NTHR = NWAVES * 64;
constexpr int D = 1024, BATCH = 4, SEQ = 8192, M = BATCH * SEQ;
constexpr int PW = 512, CW = 512, CK = 31, INC = 3584;
constexpr int NE = 256, TOPK = 8, NG = 8, EH = 256;
constexpr int ECAP = M;
constexpr int MAXT = (M * TOPK) / 256 + NE;
constexpr float LN_EPS = 1e-5f, ALPHA = 1.189207115002721f  , RSCALE = 2.5f;

constexpr size_t MiB = 1u << 20;
constexpr size_t WS_CTL = 0, CTL_ZERO_BYTES = 1 * MiB;
constexpr size_t WS_WIN = 1 * MiB;
constexpr size_t WS_POOL = 8 * MiB;
constexpr size_t WS_CVO = 8 * MiB + 512 * 1024;
constexpr size_t WS_WOUT = 10 * MiB;
constexpr size_t WS_RSH = 12 * MiB;
constexpr size_t WS_SDN = 14 * MiB;
constexpr size_t WS_EDN = 16 * MiB;
constexpr size_t WS_X1 = 144 * MiB;
constexpr size_t WS_HS = 208 * MiB;
constexpr size_t WS_LIST = 224 * MiB;
constexpr size_t WS_HE = 288 * MiB;
constexpr size_t WS_EGU = 448 * MiB;
constexpr size_t WS_PH = 704 * MiB;
constexpr size_t WS_XB = WS_PH;
constexpr size_t WS_U = WS_PH + 64 * MiB, WS_V = WS_PH + 96 * MiB;
constexpr size_t WS_GP = WS_PH + 128 * MiB, WS_GC = WS_PH + 192 * MiB;
constexpr size_t WS_R = WS_PH + 256 * MiB, WS_C = WS_PH + 288 * MiB;
constexpr size_t WS_T1 = WS_XB;
constexpr size_t WS_MG = WS_U;
constexpr size_t WS_Z = WS_GP;
constexpr size_t WS_LOG = WS_R;
constexpr size_t WS_END = 1024 * MiB;
constexpr size_t WS_Y = WS_EGU;
static_assert(WS_Y + (size_t)M * 8 * D * 2 <= WS_R, "Y slots end before R");
constexpr size_t WS_YSH = WS_R;
static_assert(WS_YSH + (size_t)M * D * 2 <= WS_END, "ws map");
static_assert(WS_HE + (size_t)MAXT * 256 * EH * 2 <= WS_EGU, "HE fits");
static_assert(WS_LIST + (size_t)NE * ECAP * 8 <= WS_HE, "LIST fits");

constexpr int CW_CNT = 1024;
constexpr int CW_BAR = 4096;

constexpr int RING_OFF = 0, RING_BYTES = 131072;
constexpr int TAB_OFF = RING_BYTES;
constexpr int MISC_OFF = TAB_OFF + 4096;
constexpr int LDS_BYTES = 147456;
static_assert(MISC_OFF + 128 <= LDS_BYTES, "LDS map");

#define GAS __attribute__((address_space(1)))
#define LAS __attribute__((address_space(3)))
typedef unsigned short bf16;
typedef unsigned v4u __attribute__((ext_vector_type(4)));
typedef unsigned v2u __attribute__((ext_vector_type(2)));
typedef float f32x4 __attribute__((ext_vector_type(4)));
typedef GAS unsigned gu32;
#define RLX_AGENT __ATOMIC_RELAXED, __HIP_MEMORY_SCOPE_AGENT
#define LDS_WAIT() asm volatile("s_waitcnt lgkmcnt(0)" ::: "memory")
#define VM_WAIT() asm volatile("s_waitcnt vmcnt(0)" ::: "memory")
__device__ __forceinline__ unsigned f2bf(float f) { unsigned u = __builtin_bit_cast(unsigned, f); return (u + 0x7fffu + ((u >> 16) & 1u)) >> 16; }
__device__ __forceinline__ unsigned pk2(float lo, float hi) { return pg8::cvt_pk_bf16(lo, hi); }

#define XB_TMO      128
#define XB_XCNT(j)  (256  + 64 * (j))
#define XB_XSUB(j)  (1280 + 64 * (j))
#define XB_XGEN(j)  (2304 + 64 * (j))
#define XB_TOP      3328
#define XB_TOPGEN   3392
#define XCD_BAR_WORDS 3456
#define XB_SPIN_CAP (1u << 20)
__device__ __forceinline__ unsigned xb_ld(unsigned* p)              { return __hip_atomic_load(p, __ATOMIC_RELAXED, __HIP_MEMORY_SCOPE_AGENT); }
__device__ __forceinline__ unsigned xb_add(unsigned* p, unsigned v) { return __hip_atomic_fetch_add(p, v, __ATOMIC_RELAXED, __HIP_MEMORY_SCOPE_AGENT); }
__device__ __forceinline__ unsigned xb_xcc_id() { return (unsigned)__builtin_amdgcn_s_getreg((3 << 11) | 20) & 0xFu; }
#define XB_SPIN(cond, bar) do { unsigned _sp = 0; while (cond) { __builtin_amdgcn_s_sleep(1); \
    if ((++_sp & 255u) == 0u) { if (xb_ld(&(bar)[XB_TMO])) break; if (_sp > XB_SPIN_CAP) { atomicAdd(&(bar)[XB_TMO], 1u); break; } } } } while (0)
struct XcdBarrier { unsigned* bar; unsigned x; volatile LAS unsigned* st; };
__device__ __forceinline__ XcdBarrier xcd_barrier_post(unsigned* bar, volatile LAS unsigned* st) {
    XcdBarrier b; b.bar = bar; b.x = xb_xcc_id(); b.st = st;
    if (threadIdx.x == 0) (void)xb_add(&bar[XB_XCNT(b.x)], 1u);
    return b;
}
__device__ __forceinline__ void xcd_barrier_complete(unsigned* bar, unsigned x, unsigned& nloc, unsigned& nx) {
    const unsigned G = gridDim.x * gridDim.y * gridDim.z;
    unsigned sum, cnt, mine, sp = 0u;
    for (;;) {
        sum = 0u; cnt = 0u; mine = 0u;
#pragma unroll
        for (unsigned j = 0; j < 16; ++j) { const unsigned c = xb_ld(&bar[XB_XCNT(j)]); sum += c; cnt += (c > 0u) ? 1u : 0u; mine = (j == x) ? c : mine; }
        if (sum == G) break;
        __builtin_amdgcn_s_sleep(1);
        if ((++sp & 255u) == 0u) { if (xb_ld(&bar[XB_TMO])) break; if (sp > XB_SPIN_CAP) { atomicAdd(&bar[XB_TMO], 1u); break; } }
    }
    nloc = mine > 0u ? mine : 1u; nx = cnt > 0u ? cnt : 1u;
}
__device__ __forceinline__ void xcd_barrier(const XcdBarrier& b) {
    asm volatile("s_waitcnt vmcnt(0)" ::: "memory");
    __syncthreads();
    if (threadIdx.x == 0) {
        unsigned* bar = b.bar;
        __builtin_amdgcn_s_waitcnt(0);
        unsigned nloc = b.st[0], nx = b.st[1];
        if (nloc == 0u) { xcd_barrier_complete(bar, b.x, nloc, nx); b.st[0] = nloc; b.st[1] = nx; }
        const unsigned old = xb_add(&bar[XB_XSUB(b.x)], 1u);
        const unsigned gen = old / nloc;
        if (old + 1u == (gen + 1u) * nloc) {
            __builtin_amdgcn_fence(__ATOMIC_RELEASE, "agent");
            asm volatile("s_waitcnt vmcnt(0)" ::: "memory");
            const unsigned og = xb_add(&bar[XB_TOP], 1u);
            const unsigned tg = og / nx;
            if (og + 1u == (tg + 1u) * nx) xb_add(&bar[XB_TOPGEN], 1u);
            else XB_SPIN(xb_ld(&bar[XB_TOPGEN]) == tg, bar);
            __builtin_amdgcn_fence(__ATOMIC_ACQUIRE, "agent");
            xb_add(&bar[XB_XGEN(b.x)], 1u);
            asm volatile("s_waitcnt vmcnt(0)" ::: "memory");
        } else {
            XB_SPIN(xb_ld(&bar[XB_XGEN(b.x)]) == gen, bar);
            __builtin_amdgcn_fence(__ATOMIC_ACQUIRE, "agent");
            asm volatile("s_waitcnt vmcnt(0)" ::: "memory");
        }
    }
    __syncthreads();
}

struct Frame {
    LAS unsigned char* lds;
    volatile LAS unsigned* MISC;
    gu32* ctl;
    int tid, lane, wave;
    int vcu, G;
    const float* in[21]; float* out; unsigned char* ws;
};
__device__ __forceinline__ float wave_sum(float v) {
#pragma unroll
    for (int o = 1; o < 64; o <<= 1) v += __shfl_xor(v, o);
    return v;
}

__host__ __device__ __forceinline__ int xcd_chunk(int L, int nwg) {
    const int q = nwg / 8, r = nwg % 8, xcd = L % 8, off = L / 8;
    return (xcd < r ? xcd * (q + 1) : r * (q + 1) + (xcd - r) * q) + off;
}
struct DenseOrder {
    const bf16* A; const bf16* Bt; int lda, ldb, nt, acol_pn;
    int nM, nN, nwg, G, c;
    __device__ __forceinline__ void init(const bf16* A_, const bf16* Bt_, int Mr, int N, int K, int lda_, int ldb_, int acol_pn_, int G_, int c_) {
        A = A_; Bt = Bt_; lda = lda_; ldb = ldb_; nt = K / 64; acol_pn = acol_pn_; nM = Mr / 256; nN = N / 256; nwg = nM * nN; G = G_; c = c_; }
    __device__ __forceinline__ bool next(int i, pg8::Unit& u) const {
        const int L = i * G + c; if (L >= nwg) return false;
        const int wgid = xcd_chunk(L, nwg);
        const int nig = 8 * nN, gid = wgid / nig, fm = gid * 8, gsz = (nM - fm) < 8 ? (nM - fm) : 8;
        u.pm = fm + ((wgid % nig) % gsz); u.pn = (wgid % nig) / gsz; u.e = 0; u.r0 = 0; u.nrow = 256; return true;
    }
    __device__ __forceinline__ const char* a_ptr(const pg8::Unit& u) const { return (const char*)(A + (size_t)u.pm * 256 * lda + u.pn * acol_pn); }
    __device__ __forceinline__ const char* b_ptr(const pg8::Unit& u) const { return (const char*)(Bt + (size_t)u.pn * 256 * ldb); }
    __device__ __forceinline__ void a_off(const pg8::Unit&, const int (&R)[2], const int (&C)[2], unsigned (&o)[2][2]) const {
#pragma unroll
        for (int h = 0; h < 2; ++h)
#pragma unroll
            for (int i = 0; i < 2; ++i) o[h][i] = (unsigned)((h * 128 + R[i]) * lda + C[i]) * 2u;
    }
};
template <bool GATHER> struct ExpertOrder {
    const bf16* A; const bf16* Bt; int lda, ldb, nt; size_t bstride;
    const LAS int* tstart; const LAS int* cntl; const int* list;
    int nN, nwg, G, c;
    __device__ __forceinline__ bool next(int i, pg8::Unit& u) const {
        const int L = i * G + c; if (L >= nwg) return false;
        const int wgid = xcd_chunk(L, nwg);
        const int t = wgid / nN; u.pn = wgid % nN; u.pm = t;
        int lo = 0, hi = NE;
#pragma unroll
        for (int s = 0; s < 8; ++s) { const int mid = (lo + hi) >> 1; if (tstart[mid] <= t) lo = mid; else hi = mid; }
        u.e = lo; u.r0 = (t - tstart[lo]) * 256; u.nrow = cntl[lo] - u.r0; return true;
    }
    __device__ __forceinline__ const char* a_ptr(const pg8::Unit& u) const { return GATHER ? (const char*)A : (const char*)(A + (size_t)u.pm * 256 * lda); }
    __device__ __forceinline__ const char* b_ptr(const pg8::Unit& u) const { return (const char*)(Bt + (size_t)u.e * bstride + (size_t)u.pn * 256 * ldb); }
    __device__ __forceinline__ void a_off(const pg8::Unit& u, const int (&R)[2], const int (&C)[2], unsigned (&o)[2][2]) const {
#pragma unroll
        for (int h = 0; h < 2; ++h)
#pragma unroll
            for (int i = 0; i < 2; ++i) {
                const int rl = h * 128 + R[i];
                if (GATHER) { int slot = 0; if (rl < u.nrow) slot = list[((size_t)u.e * ECAP + u.r0 + rl) * 2]; o[h][i] = (unsigned)((slot >> 3) * lda + C[i]) * 2u; }
                else o[h][i] = (unsigned)(rl * lda + C[i]) * 2u;
            }
    }
};

using pg8::f32x4; using pg8::u32x4; using pg8::pack8; using pg8::unpack8; using pg8::sigmoid4;
#define EPI_ROWS_BEGIN _Pragma("unroll") for (int ai = 0; ai < 2; ++ai) _Pragma("unroll") for (int m = 0; m < 4; ++m) { const int row = u.pm * 256 + ai * 128 + wr * 64 + m * 16 + fr;
#define EPI_ROWS_END }
#define UNROLL _Pragma("unroll")
typedef const pg8::f32x4 (&AccRef)[2][2][4][2];
struct EpiProj { static constexpr bool PERM = true; bf16 *U, *V, *GP, *GC;
    __device__ __forceinline__ void operator()(AccRef acc, const pg8::Unit& u, int wr, int wc, int fr, int fq) const {
        const int cb = wc * 32 + 8 * fq;
        if (u.pn < 2) {
            EPI_ROWS_BEGIN
                bf16* p = U + (size_t)row * PW + u.pn * 256 + cb;
                UNROLL for (int bj = 0; bj < 2; ++bj) *(u32x4*)(p + bj * 128) = pack8(acc[ai][bj][m][0], acc[ai][bj][m][1]);
            EPI_ROWS_END
        } else if (u.pn < 6) {
            const int j = u.pn - 2;
            EPI_ROWS_BEGIN
                bf16* p = V + (size_t)row * CW + j * 128 + cb;
                *(u32x4*)p = pack8(acc[ai][0][m][0] * sigmoid4(acc[ai][1][m][0]), acc[ai][0][m][1] * sigmoid4(acc[ai][1][m][1]));
            EPI_ROWS_END
        } else {
            bf16* Gt = (u.pn < 10) ? GP : GC; const int t = (u.pn - 6) & 3;
            EPI_ROWS_BEGIN
                bf16* p = Gt + (size_t)row * D + t * 256 + cb;
                UNROLL for (int bj = 0; bj < 2; ++bj) *(u32x4*)(p + bj * 128) = pack8(sigmoid4(acc[ai][bj][m][0]), sigmoid4(acc[ai][bj][m][1]));
            EPI_ROWS_END
        }
    }
};
struct EpiPool { static constexpr bool PERM = true; const float* scale; const bf16* GP; bf16* T1;
    __device__ __forceinline__ void operator()(AccRef acc, const pg8::Unit& u, int wr, int wc, int fr, int fq) const {
        const int c0 = u.pn * 256 + wc * 32 + 8 * fq;
        UNROLL for (int bj = 0; bj < 2; ++bj) {
            const f32x4 sc0 = *(const f32x4*)(scale + c0 + bj * 128), sc1 = *(const f32x4*)(scale + c0 + bj * 128 + 4);
            EPI_ROWS_BEGIN
                const size_t o = (size_t)row * D + c0 + bj * 128;
                f32x4 g0, g1; unpack8(*(const u32x4*)(GP + o), g0, g1);
                *(u32x4*)(T1 + o) = pack8(acc[ai][bj][m][0] * sc0 * g0, acc[ai][bj][m][1] * sc1 * g1);
            EPI_ROWS_END
        }
    }
};
struct EpiConvOut { static constexpr bool PERM = true; const bf16* T1; const bf16* GC; bf16* MG;
    __device__ __forceinline__ void operator()(AccRef acc, const pg8::Unit& u, int wr, int wc, int fr, int fq) const {
        const int c0 = u.pn * 256 + wc * 32 + 8 * fq;
        EPI_ROWS_BEGIN
            const size_t o = (size_t)row * D + c0;
            UNROLL for (int bj = 0; bj < 2; ++bj) { f32x4 g0, g1, t0, t1; unpack8(*(const u32x4*)(GC + o + bj * 128), g0, g1); unpack8(*(const u32x4*)(T1 + o + bj * 128), t0, t1);
                *(u32x4*)(MG + o + bj * 128) = pack8(t0 + acc[ai][bj][m][0] * g0, t1 + acc[ai][bj][m][1] * g1); }
        EPI_ROWS_END
    }
};
struct EpiWout { static constexpr bool PERM = true; const float* X; float* Z;
    __device__ __forceinline__ void operator()(AccRef acc, const pg8::Unit& u, int wr, int wc, int fr, int fq) const {
        const int c0 = u.pn * 256 + wc * 32 + 8 * fq;
        EPI_ROWS_BEGIN
            const size_t o = (size_t)row * D + c0;
            UNROLL for (int bj = 0; bj < 2; ++bj) { const f32x4 x0 = *(const f32x4*)(X + o + bj * 128), x1 = *(const f32x4*)(X + o + bj * 128 + 4);
                *(f32x4*)(Z + o + bj * 128) = x0 * ALPHA + acc[ai][bj][m][0]; *(f32x4*)(Z + o + bj * 128 + 4) = x1 * ALPHA + acc[ai][bj][m][1]; }
        EPI_ROWS_END
    }
};
__device__ __forceinline__ f32x4 silu_mul4(const f32x4 g, const f32x4 v) { return g * sigmoid4(g) * v; }
struct EpiRSh { static constexpr bool PERM = true; float* LOG; bf16* HS;
    __device__ __forceinline__ void operator()(AccRef acc, const pg8::Unit& u, int wr, int wc, int fr, int fq) const {
        const int cb = wc * 32 + 8 * fq;
        if (u.pn == 0) {
            EPI_ROWS_BEGIN
                float* p = LOG + (size_t)row * NE + cb;
                UNROLL for (int bj = 0; bj < 2; ++bj) { *(f32x4*)(p + bj * 128) = acc[ai][bj][m][0]; *(f32x4*)(p + bj * 128 + 4) = acc[ai][bj][m][1]; }
            EPI_ROWS_END
        } else {
            const int j = u.pn - 1;
            EPI_ROWS_BEGIN
                bf16* p = HS + (size_t)row * EH + j * 128 + cb;
                *(u32x4*)p = pack8(silu_mul4(acc[ai][0][m][0], acc[ai][1][m][0]), silu_mul4(acc[ai][0][m][1], acc[ai][1][m][1]));
            EPI_ROWS_END
        }
    }
};
struct EpiEGU { static constexpr bool PERM = true; bf16* HE;
    __device__ __forceinline__ void operator()(AccRef acc, const pg8::Unit& u, int wr, int wc, int fr, int fq) const {
        const int cb = wc * 32 + 8 * fq;
        EPI_ROWS_BEGIN
            bf16* p = HE + (size_t)row * EH + u.pn * 128 + cb;
            *(u32x4*)p = pack8(silu_mul4(acc[ai][0][m][0], acc[ai][1][m][0]), silu_mul4(acc[ai][0][m][1], acc[ai][1][m][1]));
        EPI_ROWS_END
    }
};
struct EpiEDown { static constexpr bool PERM = true; const int* list; bf16* Y;
    __device__ __forceinline__ void operator()(AccRef acc, const pg8::Unit& u, int wr, int wc, int fr, int fq) const {
        const int c0 = u.pn * 256 + wc * 32 + 8 * fq;
        UNROLL for (int ai = 0; ai < 2; ++ai)
            UNROLL for (int m = 0; m < 4; ++m) { const int rl = ai * 128 + wr * 64 + m * 16 + fr;
                if (rl < u.nrow) { const v2u ent = *(const v2u*)(list + ((size_t)u.e * ECAP + u.r0 + rl) * 2); const float w = __uint_as_float(ent.y);
                    bf16* p = Y + (size_t)ent.x * D + c0;
                    UNROLL for (int bj = 0; bj < 2; ++bj) *(u32x4*)(p + bj * 128) = pack8(acc[ai][bj][m][0] * w, acc[ai][bj][m][1] * w); } }
    }
};
struct EpiSDown { static constexpr bool PERM = true; bf16* YS;
    __device__ __forceinline__ void operator()(AccRef acc, const pg8::Unit& u, int wr, int wc, int fr, int fq) const {
        const int c0 = u.pn * 256 + wc * 32 + 8 * fq;
        EPI_ROWS_BEGIN
            bf16* p = YS + (size_t)row * D + c0;
            UNROLL for (int bj = 0; bj < 2; ++bj) *(u32x4*)(p + bj * 128) = pack8(acc[ai][bj][m][0], acc[ai][bj][m][1]);
        EPI_ROWS_END
    }
};

__device__ __forceinline__ void p0_item(const float* W, int N, bf16* WT, int ldw, int k0, int n0, int drow0, LAS float* scr, int lane) {
#pragma unroll 8
    for (int i = 0; i < 32; ++i) { const int kk = 2 * i + (lane >> 5); scr[kk * 33 + (lane & 31)] = W[(size_t)(k0 + kk) * N + n0 + (lane & 31)]; }
    LDS_WAIT(); asm volatile("" ::: "memory");
    const int c = lane & 7;
#pragma unroll
    for (int j = 0; j < 4; ++j) { const int n = (lane >> 3) + 8 * j; const LAS float* s = scr + (8 * c) * 33 + n;
        v4u o; o.x = pk2(s[0 * 33], s[1 * 33]); o.y = pk2(s[2 * 33], s[3 * 33]); o.z = pk2(s[4 * 33], s[5 * 33]); o.w = pk2(s[6 * 33], s[7 * 33]);
        *(GAS v4u*)(WT + (size_t)(drow0 + n) * ldw + k0 + 8 * c) = o; }
    LDS_WAIT(); asm volatile("" ::: "memory");
}
__device__ __forceinline__ int win_row(int n0) {
    if (n0 < 512) return n0;
    if (n0 < 1024) { const int q = n0 - 512; return 512 + (q >> 7) * 256 + (q & 127); }
    if (n0 < 1536) { const int q = n0 - 1024; return 512 + (q >> 7) * 256 + 128 + (q & 127); }
    return n0;
}
__device__ __forceinline__ int gu_row(int n0, int up) { return (n0 >> 7) * 256 + up * 128 + (n0 & 127); }
__device__ __forceinline__ void p0_prologue(Frame& F) {
    LAS float* scr = (LAS float*)(F.lds + RING_OFF + F.wave * 16384);
    const int gw = F.vcu * NWAVES + F.wave, NGW = F.G * NWAVES, lane = F.lane;
    unsigned char* ws = F.ws;
    constexpr int I_WIN = 16 * 112, I_POOL = 4 * 16, I_CVO = 8 * 32, I_WOUT = 16 * 32, I_RT = 16 * 8, I_SG = 128, I_SU = 128, I_SD = 4 * 32, I_EG = NE * 128, I_EU = NE * 128, I_ED = NE * 128;
    constexpr int NITEMS = I_WIN + I_POOL + I_CVO + I_WOUT + I_RT + I_SG + I_SU + I_SD + I_EG + I_EU + I_ED;
    for (int it = gw; it < NITEMS; it += NGW) {
        int r = it;
        if (r < I_EG) { const int e = r >> 7, rr = r & 127, kb = rr >> 3, nb = rr & 7;
            p0_item(F.in[13] + (size_t)e * D * EH, EH, (bf16*)(ws + WS_EGU) + (size_t)e * 512 * D, D, 64 * kb, 32 * nb, gu_row(32 * nb, 0), scr, lane); continue; } r -= I_EG;
        if (r < I_EU) { const int e = r >> 7, rr = r & 127, kb = rr >> 3, nb = rr & 7;
            p0_item(F.in[14] + (size_t)e * D * EH, EH, (bf16*)(ws + WS_EGU) + (size_t)e * 512 * D, D, 64 * kb, 32 * nb, gu_row(32 * nb, 1), scr, lane); continue; } r -= I_EU;
        if (r < I_ED) { const int e = r >> 7, rr = r & 127, kb = rr >> 5, nb = rr & 31;
            p0_item(F.in[15] + (size_t)e * EH * D, D, (bf16*)(ws + WS_EDN) + (size_t)e * D * EH, EH, 64 * kb, 32 * nb, 32 * nb, scr, lane); continue; } r -= I_ED;
        if (r < I_WIN) { const int kb = r / 112, nb = r % 112; p0_item(F.in[1], INC, (bf16*)(ws + WS_WIN), D, 64 * kb, 32 * nb, win_row(32 * nb), scr, lane); continue; } r -= I_WIN;
        if (r < I_POOL) { const int g = r >> 4, rr = r & 15, kb = rr >> 3, nb = rr & 7;
            p0_item(F.in[2] + (size_t)g * 128 * 256, 256, (bf16*)(ws + WS_POOL) + (size_t)g * 256 * 128, 128, 64 * kb, 32 * nb, 32 * nb, scr, lane); continue; } r -= I_POOL;
        if (r < I_CVO) { const int kb = r >> 5, nb = r & 31; p0_item(F.in[7], D, (bf16*)(ws + WS_CVO), CW, 64 * kb, 32 * nb, 32 * nb, scr, lane); continue; } r -= I_CVO;
        if (r < I_WOUT) { const int kb = r >> 5, nb = r & 31; p0_item(F.in[8], D, (bf16*)(ws + WS_WOUT), D, 64 * kb, 32 * nb, 32 * nb, scr, lane); continue; } r -= I_WOUT;
        if (r < I_RT) { const int kb = r >> 3, nb = r & 7; p0_item(F.in[11], NE, (bf16*)(ws + WS_RSH), D, 64 * kb, 32 * nb, 32 * nb, scr, lane); continue; } r -= I_RT;
        if (r < I_SG) { const int kb = r >> 3, nb = r & 7; p0_item(F.in[16], EH, (bf16*)(ws + WS_RSH), D, 64 * kb, 32 * nb, 256 + gu_row(32 * nb, 0), scr, lane); continue; } r -= I_SG;
        if (r < I_SU) { const int kb = r >> 3, nb = r & 7; p0_item(F.in[17], EH, (bf16*)(ws + WS_RSH), D, 64 * kb, 32 * nb, 256 + gu_row(32 * nb, 1), scr, lane); continue; } r -= I_SU;
        { const int kb = r >> 5, nb = r & 31; p0_item(F.in[18], D, (bf16*)(ws + WS_SDN), EH, 64 * kb, 32 * nb, 32 * nb, scr, lane); }
    }
    const GAS f32x4* x4 = (const GAS f32x4*)F.in[0]; GAS v4u* xb = (GAS v4u*)(ws + WS_XB);
    for (int i = (int)blockIdx.x * NTHR + F.tid; i < M * D / 8; i += F.G * NTHR) { const f32x4 a = x4[2 * i], b = x4[2 * i + 1];
        v4u o; o.x = pk2(a.x, a.y); o.y = pk2(a.z, a.w); o.z = pk2(b.x, b.y); o.w = pk2(b.z, b.w); xb[i] = o; }
}

__device__ __forceinline__ void ld8(const LAS unsigned char* p, float (&v)[8]) { const v4u w = *(const LAS v4u*)p;
    v[0] = pg8::bf_lo(w.x); v[1] = pg8::bf_hi(w.x); v[2] = pg8::bf_lo(w.y); v[3] = pg8::bf_hi(w.y); v[4] = pg8::bf_lo(w.z); v[5] = pg8::bf_hi(w.z); v[6] = pg8::bf_lo(w.w); v[7] = pg8::bf_hi(w.w); }
__device__ __forceinline__ void p2_mixer(Frame& F) {
    constexpr int TT = 32, VR = TT + CK - 1  , UR = TT + 15  , DW_BYTES = CK * CW * 4  ;
    LAS unsigned char* ldw = F.lds; LAS unsigned char* lrow = F.lds + DW_BYTES;
    const bf16* U = (const bf16*)(F.ws + WS_U); const bf16* V = (const bf16*)(F.ws + WS_V); bf16* Rb = (bf16*)(F.ws + WS_R); bf16* Cb = (bf16*)(F.ws + WS_C);
    const int lane = F.lane, w = F.wave;
    for (int i = F.tid; i < CK * CW / 4; i += NTHR) *(LAS f32x4*)(ldw + 16 * i) = *(const GAS f32x4*)(F.in[4] + 4 * i);
    for (int i = F.tid; i < 128; i += NTHR) *(LAS v4u*)(lrow + 62 * 1024 + 16 * i) = (v4u){0u, 0u, 0u, 0u};
    float lg[8], lb[8];
#pragma unroll
    for (int k = 0; k < 8; ++k) { lg[k] = F.in[5][lane * 8 + k]; lb[k] = F.in[6][lane * 8 + k]; }
    const int W = 2 << (lane >> 4);
    for (int unit = F.vcu; unit < M / TT; unit += F.G) {
        const int t0 = unit * TT, s0 = t0 % SEQ;
        __syncthreads();
        for (int c = F.tid; c < VR * 64; c += NTHR) { const int row = c >> 6, q = c & 63; const int s = s0 - (CK - 1) + row;
            v4u val = (v4u){0u, 0u, 0u, 0u}; if (s >= 0) val = *(const GAS v4u*)(V + (size_t)(t0 - (CK - 1) + row) * CW + q * 8);
            *(LAS v4u*)(lrow + row * 1024 + q * 16) = val; }
        __syncthreads();
        {
            float acc[4][8], wr_[4][8];
#pragma unroll
            for (int q = 0; q < 4; ++q)
#pragma unroll
                for (int k = 0; k < 8; ++k) { acc[q][k] = 0.f; wr_[q][k] = 0.f; }
#pragma unroll 1
            for (int i4 = 0; i4 < 9; ++i4) {
#pragma unroll
                for (int ii = 0; ii < 4; ++ii) { const int i = 4 * i4 + ii;
                    f32x4 a = (f32x4){0.f, 0.f, 0.f, 0.f}, b = a;
                    if (i <= 30) { a = *(const LAS f32x4*)(ldw + i * 2048 + lane * 32); b = *(const LAS f32x4*)(ldw + i * 2048 + lane * 32 + 16); }
                    wr_[ii][0] = a.x; wr_[ii][1] = a.y; wr_[ii][2] = a.z; wr_[ii][3] = a.w; wr_[ii][4] = b.x; wr_[ii][5] = b.y; wr_[ii][6] = b.z; wr_[ii][7] = b.w;
                    float v[8]; ld8(lrow + (4 * w + i) * 1024 + lane * 16, v);
#pragma unroll
                    for (int q = 0; q < 4; ++q) {
#pragma unroll
                        for (int k = 0; k < 8; ++k) acc[q][k] = fmaf(v[k], wr_[(ii - q) & 3][k], acc[q][k]); }
                }
            }
#pragma unroll
            for (int q = 0; q < 4; ++q) {
                float s = 0.f;
#pragma unroll
                for (int k = 0; k < 8; ++k) s += acc[q][k];
                const float mean = wave_sum(s) * (1.f / CW); float s2 = 0.f;
#pragma unroll
                for (int k = 0; k < 8; ++k) { acc[q][k] -= mean; s2 += acc[q][k] * acc[q][k]; }
                const float rstd = 1.f / sqrtf(wave_sum(s2) * (1.f / CW) + LN_EPS);
                float y[8];
#pragma unroll
                for (int k = 0; k < 8; ++k) { const float z = acc[q][k] * rstd * lg[k] + lb[k]; y[k] = z * pg8::sigmoidf_(z); }
                v4u o; o.x = pk2(y[0], y[1]); o.y = pk2(y[2], y[3]); o.z = pk2(y[4], y[5]); o.w = pk2(y[6], y[7]);
                *(GAS v4u*)(Cb + (size_t)(t0 + 4 * w + q) * CW + lane * 8) = o;
            }
        }
        __syncthreads();
        for (int c = F.tid; c < UR * 64; c += NTHR) { const int row = c >> 6, q = c & 63; const int s = s0 - 15 + row;
            v4u val = (v4u){0u, 0u, 0u, 0u}; if (s >= 0) val = *(const GAS v4u*)(U + (size_t)(t0 - 15 + row) * PW + q * 8);
            *(LAS v4u*)(lrow + row * 1024 + q * 16) = val; }
        __syncthreads();
        {
            float acc[4][8], own[4][8];
#pragma unroll
            for (int q = 0; q < 4; ++q)
#pragma unroll
                for (int k = 0; k < 8; ++k) { acc[q][k] = 0.f; own[q][k] = 0.f; }
#pragma unroll
            for (int i = 0; i < 19; ++i) {
                float v[8]; ld8(lrow + (4 * w + i) * 1024 + lane * 16, v);
#pragma unroll
                for (int q = 0; q < 4; ++q) { const int d = q + 15 - i; if (d >= 0 && d <= 15) { const bool in = d < W;
#pragma unroll
                    for (int k = 0; k < 8; ++k) { acc[q][k] += in ? v[k] : 0.f; if (d == 0) own[q][k] = v[k]; } } }
            }
#pragma unroll
            for (int q = 0; q < 4; ++q) { const int s = s0 + 4 * w + q; const int cnt = (s + 1) < W ? (s + 1) : W; const float inv = 1.f / (float)cnt;
                float y[8];
#pragma unroll
                for (int k = 0; k < 8; ++k) y[k] = acc[q][k] * inv - own[q][k];
                v4u o; o.x = pk2(y[0], y[1]); o.y = pk2(y[2], y[3]); o.z = pk2(y[4], y[5]); o.w = pk2(y[6], y[7]);
                *(GAS v4u*)(Rb + (size_t)(t0 + 4 * w + q) * PW + lane * 8) = o; }
        }
    }
    __syncthreads();
}

__device__ __forceinline__ void p6_ln1(Frame& F) {
    const int gw = F.vcu * NWAVES + F.wave, NGW = F.G * NWAVES, lane = F.lane;
    const float* Z = (const float*)(F.ws + WS_Z); bf16* X1 = (bf16*)(F.ws + WS_X1);
    f32x4 g[4], b[4];
#pragma unroll
    for (int j = 0; j < 4; ++j) { g[j] = *(const GAS f32x4*)(F.in[9] + 4 * lane + 256 * j); b[j] = *(const GAS f32x4*)(F.in[10] + 4 * lane + 256 * j); }
    for (int m = gw; m < M; m += NGW) {
        const GAS f32x4* zr = (const GAS f32x4*)(Z + (size_t)m * D) + lane;
        f32x4 v[4]; float s = 0.f;
#pragma unroll
        for (int j = 0; j < 4; ++j) { v[j] = zr[64 * j]; s += (v[j].x + v[j].y) + (v[j].z + v[j].w); }
        const float mean = wave_sum(s) * (1.f / D); float s2 = 0.f;
#pragma unroll
        for (int j = 0; j < 4; ++j) { v[j] = v[j] - mean; s2 += (v[j].x * v[j].x + v[j].y * v[j].y) + (v[j].z * v[j].z + v[j].w * v[j].w); }
        const float rstd = 1.f / sqrtf(wave_sum(s2) * (1.f / D) + LN_EPS);
        GAS v2u* o8 = (GAS v2u*)(X1 + (size_t)m * D) + lane;
#pragma unroll
        for (int j = 0; j < 4; ++j) { const f32x4 y = v[j] * rstd * g[j] + b[j]; v2u o; o.x = pk2(y.x, y.y); o.y = pk2(y.z, y.w); o8[64 * j] = o; }
    }
}

__device__ __forceinline__ void p8_route(Frame& F) {
    const int gw = F.vcu * NWAVES + F.wave, NGW = F.G * NWAVES, lane = F.lane;
    const float* LOG = (const float*)(F.ws + WS_LOG); int* list = (int*)(F.ws + WS_LIST); unsigned* cnt = (unsigned*)F.ctl + CW_CNT;
    const f32x4 bias = *(const GAS f32x4*)(F.in[12] + 4 * lane);
    const float NEG = -__builtin_inff();
    for (int tok = gw; tok < M; tok += NGW) {
        const f32x4 lg = *(const GAS f32x4*)(LOG + (size_t)tok * NE + 4 * lane);
        float sc0 = 1.f / (1.f + __expf(-lg.x)), sc1 = 1.f / (1.f + __expf(-lg.y)), sc2 = 1.f / (1.f + __expf(-lg.z)), sc3 = 1.f / (1.f + __expf(-lg.w));
        float c0 = sc0 + bias.x, c1 = sc1 + bias.y, c2 = sc2 + bias.z, c3 = sc3 + bias.w;
        const float h01 = fmaxf(c0, c1), l01 = fminf(c0, c1), h23 = fmaxf(c2, c3), l23 = fminf(c2, c3);
        float m1 = fmaxf(h01, h23), m2 = fmaxf(fminf(h01, h23), fmaxf(l01, l23));
#pragma unroll
        for (int o = 1; o < 8; o <<= 1) { const float b1 = __shfl_xor(m1, o), b2 = __shfl_xor(m2, o); const float n1 = fmaxf(m1, b1), n2 = fmaxf(fminf(m1, b1), fmaxf(m2, b2)); m1 = n1; m2 = n2; }
        const float gs = m1 + m2; const int mygrp = lane >> 3; int rank = 0;
#pragma unroll
        for (int g = 0; g < NG; ++g) { const float og = __shfl(gs, g * 8); rank += (og > gs || (og == gs && g < mygrp)) ? 1 : 0; }
        if (rank >= 4) { c0 = NEG; c1 = NEG; c2 = NEG; c3 = NEG; }
        float sumw = 0.f, mysc = 0.f; int myidx = 0;
#pragma unroll
        for (int r = 0; r < TOPK; ++r) {
            float bv = c0, bs = sc0; int gi = 4 * lane;
            if (c1 > bv) { bv = c1; bs = sc1; gi = 4 * lane + 1; }
            if (c2 > bv) { bv = c2; bs = sc2; gi = 4 * lane + 2; }
            if (c3 > bv) { bv = c3; bs = sc3; gi = 4 * lane + 3; }
#pragma unroll
            for (int o = 32; o >= 1; o >>= 1) { const float ov = __shfl_xor(bv, o), os = __shfl_xor(bs, o); const int oi = __shfl_xor(gi, o);
                const bool take = (ov > bv) || (ov == bv && oi < gi); if (take) { bv = ov; bs = os; gi = oi; } }
            if (lane == r) { myidx = gi; mysc = bs; }
            sumw += bs;
            if (gi == 4 * lane) c0 = NEG; if (gi == 4 * lane + 1) c1 = NEG; if (gi == 4 * lane + 2) c2 = NEG; if (gi == 4 * lane + 3) c3 = NEG;
        }
        if (lane < TOPK) { const float wgt = mysc / sumw * RSCALE; const unsigned pos = atomicAdd(&cnt[myidx], 1u);
            v2u ent; ent.x = (unsigned)(tok * TOPK + lane); ent.y = __float_as_uint(wgt); *(GAS v2u*)(list + ((size_t)myidx * ECAP + pos) * 2) = ent; }
    }
}

__device__ __forceinline__ int expert_table(Frame& F) {
    LAS int* tstart = (LAS int*)(F.lds + TAB_OFF); LAS int* cntl = tstart + 260; LAS int* wtot = tstart + 520;
    const unsigned* cnt = (const unsigned*)F.ctl + CW_CNT;
    __syncthreads();
    int c = 0, incl = 0;
    if (F.tid < NE) { c = (int)__hip_atomic_load(cnt + F.tid, RLX_AGENT); incl = (c + 255) >> 8;
#pragma unroll
        for (int o = 1; o < 64; o <<= 1) { const int up = __shfl_up(incl, o); if (F.lane >= o) incl += up; }
        if (F.lane == 63) wtot[F.wave] = incl; cntl[F.tid] = c; }
    __syncthreads();
    if (F.tid < NE) { int base = 0;
#pragma unroll
        for (int k = 0; k < 4; ++k) if (k < F.wave) base += wtot[k];
        tstart[F.tid + 1] = base + incl; if (F.tid == 0) tstart[0] = 0; }
    __syncthreads();
    return tstart[NE];
}

__device__ __forceinline__ void p11_combine(Frame& F) {
    const int gw = F.vcu * NWAVES + F.wave, NGW = F.G * NWAVES, lane = F.lane;
    const bf16* Y = (const bf16*)(F.ws + WS_Y); const bf16* YS = (const bf16*)(F.ws + WS_YSH); const bf16* X1 = (const bf16*)(F.ws + WS_X1);
    for (int tok = gw; tok < M; tok += NGW) {
        f32x4 a[4];
#pragma unroll
        for (int j = 0; j < 2; ++j) { f32x4 x0, x1; unpack8(*(const GAS v4u*)(X1 + (size_t)tok * D + lane * 8 + 512 * j), x0, x1); a[2 * j] = x0 * ALPHA; a[2 * j + 1] = x1 * ALPHA;
#if !(defined(DBG_COMBINE) && (DBG_COMBINE & 2))
            f32x4 s0, s1; unpack8(*(const GAS v4u*)(YS + (size_t)tok * D + lane * 8 + 512 * j), s0, s1); a[2 * j] += s0; a[2 * j + 1] += s1;
#endif
        }
#if !(defined(DBG_COMBINE) && (DBG_COMBINE & 1))
#pragma unroll
        for (int k = 0; k < TOPK; ++k)
#pragma unroll
            for (int j = 0; j < 2; ++j) { f32x4 y0, y1; unpack8(*(const GAS v4u*)(Y + ((size_t)tok * TOPK + k) * D + lane * 8 + 512 * j), y0, y1); a[2 * j] += y0; a[2 * j + 1] += y1; }
#endif
        float s = 0.f;
#pragma unroll
        for (int j = 0; j < 4; ++j) s += (a[j].x + a[j].y) + (a[j].z + a[j].w);
        const float mean = wave_sum(s) * (1.f / D); float s2 = 0.f;
#pragma unroll
        for (int j = 0; j < 4; ++j) { a[j] = a[j] - mean; s2 += (a[j].x * a[j].x + a[j].y * a[j].y) + (a[j].z * a[j].z + a[j].w * a[j].w); }
        const float rstd = 1.f / sqrtf(wave_sum(s2) * (1.f / D) + LN_EPS);
#pragma unroll
        for (int j = 0; j < 4; ++j) { const int col = lane * 8 + 512 * (j >> 1) + 4 * (j & 1);
            const f32x4 g = *(const GAS f32x4*)(F.in[19] + col), b = *(const GAS f32x4*)(F.in[20] + col);
            *(GAS f32x4*)(F.out + (size_t)tok * D + col) = a[j] * rstd * g + b; }
    }
}
#ifdef DBG_CHECK
constexpr int NT = 512;
constexpr size_t DBG_OFF = 448 * MiB;
__device__ __forceinline__ float dsig(float x) { return 1.f / (1.f + expf(-x)); }
__device__ __forceinline__ float bf2f(unsigned short h) { return __uint_as_float((unsigned)h << 16); }
__global__ void dbg_proj(const float* x, const float* w_in, float* PN) {
    for (int i = blockIdx.x * blockDim.x + threadIdx.x; i < NT * INC; i += gridDim.x * blockDim.x) { const int tok = i / INC, col = i % INC; float a = 0.f;
        for (int k = 0; k < D; ++k) a = fmaf(x[(size_t)tok * D + k], w_in[(size_t)k * INC + col], a); PN[i] = a; }
}
__global__ void dbg_mix1(const float* PN, const float* dw, float* RN, float* CVN) {
    for (int i = blockIdx.x * blockDim.x + threadIdx.x; i < NT * 512; i += gridDim.x * blockDim.x) { const int tok = i / 512, ch = i % 512; const int g = ch / 128, W = 2 << g;
        float s = 0.f; int cnt = 0; for (int j = 0; j < W; ++j) if (tok - j >= 0) { s += PN[(size_t)(tok - j) * INC + ch]; ++cnt; }
        RN[i] = s / (float)cnt - PN[(size_t)tok * INC + ch];
        float c = 0.f; for (int j = 0; j < CK; ++j) { const int t = tok - (CK - 1) + j; if (t >= 0) c += PN[(size_t)t * INC + 512 + ch] * dsig(PN[(size_t)t * INC + 1024 + ch]) * dw[j * 512 + ch]; }
        CVN[i] = c; }
}
__global__ void dbg_ln(const float* IN, int n, const float* g, const float* b, float* OUT, int act) {
    const int tok = blockIdx.x * blockDim.x + threadIdx.x; if (tok >= NT) return;
    float m = 0.f; for (int k = 0; k < n; ++k) m += IN[(size_t)tok * n + k]; m /= n; float v = 0.f; for (int k = 0; k < n; ++k) { const float d = IN[(size_t)tok * n + k] - m; v += d * d; } v /= n;
    const float r = 1.f / sqrtf(v + LN_EPS); for (int k = 0; k < n; ++k) { float y = (IN[(size_t)tok * n + k] - m) * r * g[k] + b[k]; if (act) y = y * dsig(y); OUT[(size_t)tok * n + k] = y; }
}
__global__ void dbg_mix3(const float* PN, const float* RN, const float* CN, const float* pool_w, const float* scale, const float* cwo, float* MGN) {
    for (int i = blockIdx.x * blockDim.x + threadIdx.x; i < NT * D; i += gridDim.x * blockDim.x) { const int tok = i / D, d = i % D, g = d / 256, dd = d % 256;
        float yp = 0.f; for (int c = 0; c < 128; ++c) yp = fmaf(RN[(size_t)tok * 512 + g * 128 + c], pool_w[((size_t)g * 128 + c) * 256 + dd], yp); yp *= scale[d];
        float yc = 0.f; for (int c = 0; c < 512; ++c) yc = fmaf(CN[(size_t)tok * 512 + c], cwo[(size_t)c * D + d], yc);
        MGN[i] = dsig(PN[(size_t)tok * INC + 1536 + d]) * yp + dsig(PN[(size_t)tok * INC + 2560 + d]) * yc; }
}
__global__ void dbg_mix4(const float* MGN, const float* w_out, const float* x, float* ZN) {
    for (int i = blockIdx.x * blockDim.x + threadIdx.x; i < NT * D; i += gridDim.x * blockDim.x) { const int tok = i / D, e = i % D; float a = 0.f;
        for (int d = 0; d < D; ++d) a = fmaf(MGN[(size_t)tok * D + d], w_out[(size_t)d * D + e], a); ZN[i] = ALPHA * x[(size_t)tok * D + e] + a; }
}
__global__ void dbg_cmp(int k, const void* buf, int kind, int ld, int n, const float* NV, int nld, int ncol0, int fn, const float* PN, float* acc) {
    float e2 = 0.f, r2 = 0.f;
    for (int i = blockIdx.x * blockDim.x + threadIdx.x; i < NT * n; i += gridDim.x * blockDim.x) { const int tok = i / n, c = i % n;
        const float a = kind ? ((const float*)buf)[(size_t)tok * ld + c] : bf2f(((const unsigned short*)buf)[(size_t)tok * ld + c]);
        float b = NV[(size_t)tok * nld + ncol0 + c];
        if (fn == 1) b = dsig(b);
        if (fn == 2) b = b * dsig(PN[(size_t)tok * INC + 1024 + c]);
        e2 += (a - b) * (a - b); r2 += b * b; }
    atomicAdd(acc + 2 * k, e2); atomicAdd(acc + 2 * k + 1, r2);
}
__global__ void dbg_cmp_tile(int k, const void* buf, int ld, int r0, int c0, const float* NV, int nld, int ncol0, float* acc) {
    float e2 = 0.f, r2 = 0.f;
    for (int i = blockIdx.x * blockDim.x + threadIdx.x; i < 256 * 256; i += gridDim.x * blockDim.x) { const int tok = r0 + i / 256, c = c0 + i % 256;
        const float a = bf2f(((const unsigned short*)buf)[(size_t)tok * ld + c]); const float b = dsig(NV[(size_t)tok * nld + ncol0 + c]);
        e2 += (a - b) * (a - b); r2 += b * b; }
    atomicAdd(acc + 2 * k, e2); atomicAdd(acc + 2 * k + 1, r2);
}
__global__ void dbg_cmp_wt(int k, const unsigned short* WT, const float* W, int n0, float* acc) {
    float e2 = 0.f, r2 = 0.f;
    for (int i = blockIdx.x * blockDim.x + threadIdx.x; i < 256 * 1024; i += gridDim.x * blockDim.x) { const int n = n0 + i / 1024, kk = i % 1024;
        const float a = bf2f(WT[(size_t)n * 1024 + kk]); const float b = W[(size_t)kk * INC + n];
        e2 += (a - b) * (a - b); r2 += b * b; }
    atomicAdd(acc + 2 * k, e2); atomicAdd(acc + 2 * k + 1, r2);
}
__global__ void dbg_code(const float* acc, int nchk, float* out, int n) {
    int code = 0; for (int k = nchk - 1; k >= 0; --k) if (!(acc[2 * k] <= 1e-3f * acc[2 * k + 1])) code = k + 1;
#ifdef DBG_TILES
    code = 0; for (int k = 0; k < 4; ++k) if (!(acc[2 * (16 + k)] <= 1e-3f * acc[2 * (16 + k) + 1])) code |= 1 << k;
#endif
#ifdef DBG_SHOW
    const float val = sqrtf(1000.f * acc[2 * DBG_SHOW] / acc[2 * DBG_SHOW + 1]);
    for (int i = blockIdx.x * blockDim.x + threadIdx.x; i < n; i += gridDim.x * blockDim.x) out[i] = val;
#else
    for (int i = blockIdx.x * blockDim.x + threadIdx.x; i < n; i += gridDim.x * blockDim.x) out[i] = (float)code;
#endif
}
static void dbg_run(void* const* d_in, float* d_out, unsigned char* ws, hipStream_t st, int stop) {
    float* PN = d_out; float* RN = PN + (size_t)NT * INC; float* CVN = RN + NT * 512; float* CN = CVN + NT * 512; float* MGN = CN + NT * 512; float* ZN = MGN + (size_t)NT * D; float* X1N = ZN + (size_t)NT * D; float* acc = X1N + (size_t)NT * D;
    const float* x = (const float*)d_in[0];
    hipMemsetAsync(acc, 0, 64 * 4, st);
    dbg_proj<<<2048, 256, 0, st>>>(x, (const float*)d_in[1], PN);
    dbg_mix1<<<1024, 256, 0, st>>>(PN, (const float*)d_in[4], RN, CVN);
    dbg_ln<<<NT / 64, 64, 0, st>>>(CVN, 512, (const float*)d_in[5], (const float*)d_in[6], CN, 1);
    dbg_mix3<<<2048, 256, 0, st>>>(PN, RN, CN, (const float*)d_in[2], (const float*)d_in[3], (const float*)d_in[7], MGN);
    dbg_mix4<<<2048, 256, 0, st>>>(MGN, (const float*)d_in[8], x, ZN);
    dbg_ln<<<NT / 64, 64, 0, st>>>(ZN, D, (const float*)d_in[9], (const float*)d_in[10], X1N, 0);
    if (stop <= 4) {
    dbg_cmp<<<256, 256, 0, st>>>(0, ws + WS_U, 0, 512, 512, PN, INC, 0, 0, PN, acc);
    dbg_cmp<<<256, 256, 0, st>>>(1, ws + WS_V, 0, 512, 512, PN, INC, 512, 2, PN, acc);
    dbg_cmp<<<256, 256, 0, st>>>(2, ws + WS_GP, 0, D, D, PN, INC, 1536, 1, PN, acc);
    dbg_cmp<<<256, 256, 0, st>>>(3, ws + WS_GC, 0, D, D, PN, INC, 2560, 1, PN, acc);
    }
    dbg_cmp<<<256, 256, 0, st>>>(4, ws + WS_R, 0, 512, 512, RN, 512, 0, 0, PN, acc);
    dbg_cmp<<<256, 256, 0, st>>>(5, ws + WS_C, 0, 512, 512, CN, 512, 0, 0, PN, acc);
    if (stop >= 7) {
    dbg_cmp<<<256, 256, 0, st>>>(6, ws + WS_MG, 0, D, D, MGN, D, 0, 0, PN, acc);
    dbg_cmp<<<256, 256, 0, st>>>(7, ws + WS_Z, 1, D, D, ZN, D, 0, 0, PN, acc);
    dbg_cmp<<<256, 256, 0, st>>>(8, ws + WS_X1, 0, D, D, X1N, D, 0, 0, PN, acc);
    }
#ifdef DBG_WT
    dbg_cmp_wt<<<256, 256, 0, st>>>(DBG_SHOW, (const unsigned short*)(ws + WS_WIN), (const float*)d_in[1], DBG_WT, acc);
#endif
#ifdef DBG_TILES
    for (int t = 0; t < 4; ++t) dbg_cmp_tile<<<64, 256, 0, st>>>(16 + t, ws + ((DBG_TILES & 2) ? WS_GC : WS_GP), D, (DBG_TILES & 1) * 256, t * 256, PN, INC, ((DBG_TILES & 2) ? 2560 : 1536), acc);
#endif
    hipMemcpyAsync(ws + WS_CTL + 65536, acc, 64 * 4, hipMemcpyDeviceToDevice, st);
    dbg_code<<<1024, 256, 0, st>>>((const float*)(ws + WS_CTL + 65536), 9, d_out, M * D);
}
#endif

#ifndef MK_N_LAUNCHES
#define MK_N_LAUNCHES 1
#endif
constexpr int N_PHASES = 12;
struct Args { const float* in[21]; float* out; unsigned char* ws; int ph_lo, ph_hi; };
__global__ void __launch_bounds__(NTHR, 2) mk_fwd(Args args) {
    extern __shared__ __attribute__((aligned(16))) unsigned char lds[];
    Frame F;
    F.lds = (LAS unsigned char*)lds;
    F.MISC = (volatile LAS unsigned*)(F.lds + MISC_OFF);
    F.tid = threadIdx.x; F.lane = F.tid & 63; F.wave = __builtin_amdgcn_readfirstlane(F.tid >> 6);
    F.G = gridDim.x; { const int bx = blockIdx.x; F.vcu = (F.G % 8 == 0) ? (bx % 8) * (F.G / 8) + bx / 8 : bx; }
    F.ws = args.ws; F.ctl = (gu32*)(args.ws + WS_CTL); F.out = args.out;
#pragma unroll
    for (int i = 0; i < 21; ++i) F.in[i] = args.in[i];
    for (int u = F.tid; u < (LDS_BYTES - TAB_OFF) / 4; u += NTHR) ((LAS unsigned*)(F.lds + TAB_OFF))[u] = 0u;
    __syncthreads();
    const int lo = args.ph_lo, hi = args.ph_hi;
    const bool multi = (hi - lo) > 1;
    XcdBarrier bar; bar.bar = (unsigned*)(F.ctl + CW_BAR); bar.x = 0; bar.st = nullptr;
    if (multi) bar = xcd_barrier_post((unsigned*)(F.ctl + CW_BAR), F.MISC + 8);
#ifndef PH_MASK
#define PH_MASK 0xFFF
#endif
#define IN(k) ((((PH_MASK) >> (k)) & 1) && lo <= (k) && (k) < hi)
#define SEAM(k) do { if (IN(k) && IN((k) + 1)) xcd_barrier(bar); } while (0)
    unsigned char* ws = args.ws;
    LAS unsigned char* ring = F.lds + RING_OFF;
    const int bx = (int)blockIdx.x;

    if (IN(0)) { p0_prologue(F); } SEAM(0);
    if (IN(1)) { DenseOrder S; S.init((const bf16*)(ws + WS_XB), (const bf16*)(ws + WS_WIN), M, INC, D, D, D, 0, F.G, bx);
        EpiProj E{(bf16*)(ws + WS_U), (bf16*)(ws + WS_V), (bf16*)(ws + WS_GP), (bf16*)(ws + WS_GC)};
        pg8::gemm_phase<EpiProj, DenseOrder>(ring, S, E); } SEAM(1);
    if (IN(2)) { p2_mixer(F); } SEAM(2);
    if (IN(3)) { DenseOrder S; S.init((const bf16*)(ws + WS_R), (const bf16*)(ws + WS_POOL), M, D, 128, PW, 128, 128, F.G, bx);
        EpiPool E{F.in[3], (const bf16*)(ws + WS_GP), (bf16*)(ws + WS_T1)};
        pg8::gemm_phase<EpiPool, DenseOrder>(ring, S, E); } SEAM(3);
    if (IN(4)) { DenseOrder S; S.init((const bf16*)(ws + WS_C), (const bf16*)(ws + WS_CVO), M, D, CW, CW, CW, 0, F.G, bx);
        EpiConvOut E{(const bf16*)(ws + WS_T1), (const bf16*)(ws + WS_GC), (bf16*)(ws + WS_MG)};
        pg8::gemm_phase<EpiConvOut, DenseOrder>(ring, S, E); } SEAM(4);
    if (IN(5)) { DenseOrder S; S.init((const bf16*)(ws + WS_MG), (const bf16*)(ws + WS_WOUT), M, D, D, D, D, 0, F.G, bx);
        EpiWout E{F.in[0], (float*)(ws + WS_Z)};
        pg8::gemm_phase<EpiWout, DenseOrder>(ring, S, E); } SEAM(5);
    if (IN(6)) { p6_ln1(F); } SEAM(6);
    if (IN(7)) { DenseOrder S; S.init((const bf16*)(ws + WS_X1), (const bf16*)(ws + WS_RSH), M, 768, D, D, D, 0, F.G, bx);
        EpiRSh E{(float*)(ws + WS_LOG), (bf16*)(ws + WS_HS)};
        pg8::gemm_phase<EpiRSh, DenseOrder>(ring, S, E); } SEAM(7);
    if (IN(8)) { p8_route(F); } SEAM(8);
    if (IN(9)) { const int tt = expert_table(F);
        ExpertOrder<true> S; S.A = (const bf16*)(ws + WS_X1); S.Bt = (const bf16*)(ws + WS_EGU); S.lda = D; S.ldb = D; S.nt = D / 64; S.bstride = (size_t)512 * D;
        S.tstart = (const LAS int*)(F.lds + TAB_OFF); S.cntl = S.tstart + 260; S.list = (const int*)(ws + WS_LIST); S.nN = 2; S.nwg = tt * 2; S.G = F.G; S.c = bx;
        EpiEGU E{(bf16*)(ws + WS_HE)};
        pg8::gemm_phase<EpiEGU, ExpertOrder<true>>(ring, S, E); } SEAM(9);
    if (IN(10)) { const int tt = expert_table(F);
        { ExpertOrder<false> S; S.A = (const bf16*)(ws + WS_HE); S.Bt = (const bf16*)(ws + WS_EDN); S.lda = EH; S.ldb = EH; S.nt = EH / 64; S.bstride = (size_t)D * EH;
          S.tstart = (const LAS int*)(F.lds + TAB_OFF); S.cntl = S.tstart + 260; S.list = (const int*)(ws + WS_LIST); S.nN = 4; S.nwg = tt * 4; S.G = F.G; S.c = bx;
          EpiEDown E{(const int*)(ws + WS_LIST), (bf16*)(ws + WS_Y)};
          pg8::gemm_phase<EpiEDown, ExpertOrder<false>>(ring, S, E); }
        { DenseOrder S; S.init((const bf16*)(ws + WS_HS), (const bf16*)(ws + WS_SDN), M, D, EH, EH, EH, 0, F.G, bx);
          EpiSDown E{(bf16*)(ws + WS_YSH)};
          pg8::gemm_phase<EpiSDown, DenseOrder>(ring, S, E); } } SEAM(10);
    if (IN(11)) { p11_combine(F); }
#undef IN
#undef SEAM
}

extern "C" void kernel_launch(void* const* d_in, const int* in_sizes, int n_in, void* d_out, int out_size, void* d_ws, size_t ws_size, hipStream_t stream) {
    static int grid = 0;
    if (grid == 0) {
        if (n_in != 21 || in_sizes[0] != M * D || out_size != M * D || ws_size < WS_END) { fprintf(stderr, "kernel_launch: unexpected shapes (n_in %d, in0 %d, out %d, ws %zu)\n", n_in, n_in > 0 ? in_sizes[0] : -1, out_size, ws_size); grid = -1; return; }
        int dev = 0, cus = 0;
        if (hipGetDevice(&dev) != hipSuccess || hipDeviceGetAttribute(&cus, hipDeviceAttributeMultiprocessorCount, dev) != hipSuccess) { grid = -1; return; }
        if (hipFuncSetAttribute((const void*)mk_fwd, hipFuncAttributeMaxDynamicSharedMemorySize, LDS_BYTES) != hipSuccess) { fprintf(stderr, "kernel_launch: hipFuncSetAttribute failed\n"); grid = -1; return; }
        (void)hipGetLastError();
        grid = cus;
    }
    if (grid < 0) return;
    (void)hipMemsetAsync((char*)d_ws + WS_CTL, 0, CTL_ZERO_BYTES, stream);
    Args a{};
    for (int i = 0; i < 21; ++i) a.in[i] = (const float*)d_in[i];
    a.out = (float*)d_out; a.ws = (unsigned char*)d_ws;
    constexpr int NL = MK_N_LAUNCHES;
    for (int li = 0; li < NL; ++li) {
        a.ph_lo = (NL == 1) ? 0 : li; a.ph_hi = (NL == 1) ? N_PHASES : li + 1;
        hipLaunchKernelGGL(mk_fwd, dim3(grid), dim3(NTHR), LDS_BYTES, stream, a);
#ifdef DBG_CHECK
        if (a.ph_hi == DBG_CHECK) { dbg_run(d_in, (float*)d_out, (unsigned char*)d_ws, stream, DBG_CHECK); return; }
#endif
    }
}
```

```cpp
#define MK_N_LAUNCHES 1

#include <hip/hip_runtime.h>
#include <cstdio>
#include <cstdint>

namespace pg8 {
#define PG8_LAS __attribute__((address_space(3)))
typedef unsigned short bf16_t;
typedef short bf16x8 __attribute__((ext_vector_type(8)));
typedef float f32x4 __attribute__((ext_vector_type(4)));
typedef float f32x2 __attribute__((ext_vector_type(2)));
typedef unsigned u32x4 __attribute__((ext_vector_type(4)));
typedef unsigned u32x2 __attribute__((ext_vector_type(2)));
constexpr int BM = 256, BK = 64, HALF = 128, HTB = HALF * BK * 2  , STAGE_BYTES = 8 * HTB, NXCD = 8, WGM = 8;

__host__ __device__ __forceinline__ int lds_byte(int r, int c) { const int st = (r >> 4) * 2 + (c >> 5), rr = r & 15, cc = c & 31, ob = rr * 64 + cc * 2; return st * 1024 + (ob ^ (((ob >> 9) & 1) << 5)); }
__host__ __device__ __forceinline__ void stage_rc(int b, int& R, int& C) { const int st = b / 1024, sb = b % 1024, swz = sb ^ (((sb >> 9) & 1) << 5); R = (st >> 1) * 16 + swz / 64; C = (st & 1) * 32 + (swz % 64) / 2; }
__host__ __device__ __forceinline__ int perm32(int rho) { const int n = rho >> 4, i = rho & 15; return 8 * (i >> 2) + 4 * n + (i & 3); }

struct Unit { int pm, pn, e, r0, nrow; };

typedef __bf16 bf16x2_t __attribute__((ext_vector_type(2)));
__device__ __forceinline__ unsigned cvt_pk_bf16(float lo, float hi) { f32x2 v = {lo, hi}; bf16x2_t b = __builtin_convertvector(v, bf16x2_t); return __builtin_bit_cast(unsigned, b); }
__device__ __forceinline__ u32x4 pack8(const f32x4 a, const f32x4 b) { u32x4 w; w.x = cvt_pk_bf16(a[0], a[1]); w.y = cvt_pk_bf16(a[2], a[3]); w.z = cvt_pk_bf16(b[0], b[1]); w.w = cvt_pk_bf16(b[2], b[3]); return w; }
__device__ __forceinline__ float bf_lo(unsigned w) { return __uint_as_float(w << 16); }
__device__ __forceinline__ float bf_hi(unsigned w) { return __uint_as_float(w & 0xffff0000u); }
__device__ __forceinline__ void unpack8(const u32x4 w, f32x4& a, f32x4& b) { a = (f32x4){bf_lo(w.x), bf_hi(w.x), bf_lo(w.y), bf_hi(w.y)}; b = (f32x4){bf_lo(w.z), bf_hi(w.z), bf_lo(w.w), bf_hi(w.w)}; }
__device__ __forceinline__ float sigmoidf_(float x) { return __builtin_amdgcn_rcpf(1.0f + __expf(-x)); }
__device__ __forceinline__ f32x4 sigmoid4(const f32x4 x) { return (f32x4){sigmoidf_(x[0]), sigmoidf_(x[1]), sigmoidf_(x[2]), sigmoidf_(x[3])}; }

template <class Epi, class Sched>
__device__ __forceinline__ void gemm_phase(PG8_LAS unsigned char* lds, PG8_LAS unsigned char* ent, const Sched& S, const Epi& E, int wid_) {
    int lane_; asm volatile("v_mbcnt_lo_u32_b32 %0, -1, 0\n\tv_mbcnt_hi_u32_b32 %0, -1, %0" : "=v"(lane_));
    const int wid = __builtin_amdgcn_readfirstlane(wid_), lane = lane_, tid = wid * 64 + lane, wr = wid >> 2, wc = wid & 3, fr = lane & 15, fq = lane >> 4;
    int nt_ = S.nt; asm volatile("" : "+s"(nt_));
    const int nt = nt_;
    int sR[2], sC[2]; unsigned voffB[2];
#pragma unroll
    for (int i = 0; i < 2; ++i) { int R, C; stage_rc(tid * 16 + i * 8192, R, C); const int Rb = Epi::PERM ? ((R & ~31) + perm32(R & 31)) : R;
        sR[i] = R; sC[i] = C; voffB[i] = (unsigned)(Rb * S.ldb + C) * 2u; }
    const size_t kstep = (size_t)(BK * 2);
    const size_t hstepB = (size_t)HALF * S.ldb * 2;
    const unsigned ldsw = (unsigned)wid * 1024u;
    const int aoff = lds_byte(wr * 64 + fr, fq * 8), boff = lds_byte(wc * 32 + fr, fq * 8);
#define PG8_SA(b, h) (((b) * 2 + (h)) * HTB)
#define PG8_SB(b, h) ((4 + (b) * 2 + (h)) * HTB)
#define PG8_STAGE(bufoff, gbase, voff) do { _Pragma("unroll") for (int _i = 0; _i < 2; ++_i) \
        __builtin_amdgcn_global_load_lds((const unsigned*)((const char*)(gbase) + (voff)[_i]), (PG8_LAS unsigned*)(lds + (bufoff) + ldsw + _i * 8192), 16, 0, 0); } while (0)
#define PG8_LDA(dst, b, h) do { _Pragma("unroll") for (int m = 0; m < 4; ++m) _Pragma("unroll") for (int k = 0; k < 2; ++k) dst[m][k] = *(const PG8_LAS bf16x8*)(lds + PG8_SA(b, h) + aoff + m * 2048 + k * 1024); } while (0)
#define PG8_LDB(dst, b, h) do { _Pragma("unroll") for (int n = 0; n < 2; ++n) _Pragma("unroll") for (int k = 0; k < 2; ++k) dst[n][k] = *(const PG8_LAS bf16x8*)(lds + PG8_SB(b, h) + boff + n * 2048 + k * 1024); } while (0)
#define PG8_MMA(ai, bj, At, Bt) do { __builtin_amdgcn_s_setprio(1); _Pragma("unroll") for (int m = 0; m < 4; ++m) _Pragma("unroll") for (int n = 0; n < 2; ++n) _Pragma("unroll") for (int k = 0; k < 2; ++k) \
        acc[ai][bj][m][n] = __builtin_amdgcn_mfma_f32_16x16x32_bf16(Bt[n][k], At[m][k], acc[ai][bj][m][n], 0, 0, 0); __builtin_amdgcn_s_setprio(0); } while (0)
#define PG8_WAIT_V(n) asm volatile("s_waitcnt vmcnt(" #n ")" ::: "memory")
#define PG8_WAIT_L(n) asm volatile("s_waitcnt lgkmcnt(" #n ")" ::: "memory")
#define PG8_BAR __builtin_amdgcn_s_barrier()
#define PG8_SCHED __builtin_amdgcn_sched_barrier(0)
    Unit cur, nxt; int ui = 0;
    if (!S.next(0, cur)) return;
    f32x4 acc[2][2][4][2];
#pragma unroll
    for (int a = 0; a < 2; ++a)
#pragma unroll
        for (int b = 0; b < 2; ++b)
#pragma unroll
            for (int m = 0; m < 4; ++m)
#pragma unroll
                for (int n = 0; n < 2; ++n) acc[a][b][m][n] = (f32x4){0.f, 0.f, 0.f, 0.f};
    bf16x8 At[4][2], B0[2][2], B1[2][2];
    unsigned cvo[2][2], nvo[2][2];
    const char* cA = S.a_ptr(cur); const char* cB = S.b_ptr(cur);
    if constexpr (Sched::META) {
        S.meta_issue(cur, ent, wid, lane); if (S.next(1, nxt)) S.meta_issue(nxt, ent + 2048, wid, lane);
        PG8_WAIT_V(0); PG8_BAR;
    }
    S.a_off(cur, sR, sC, cvo, ent);
    PG8_STAGE(PG8_SB(0, 0), cB, voffB); PG8_STAGE(PG8_SB(0, 1), cB + hstepB, voffB); PG8_STAGE(PG8_SA(0, 0), cA, cvo[0]); PG8_STAGE(PG8_SA(0, 1), cA, cvo[1]);
    if (wr == 1) PG8_BAR;
    PG8_WAIT_V(2); PG8_BAR;
    PG8_STAGE(PG8_SB(1, 0), cB + kstep, voffB); PG8_STAGE(PG8_SA(1, 0), cA + kstep, cvo[0]); PG8_STAGE(PG8_SB(1, 1), cB + hstepB + kstep, voffB);
    PG8_WAIT_V(6); PG8_BAR;
    for (;;) {
        const bool has_next = S.next(ui + 1, nxt);
        const char* nA = cA; const char* nB = cB;
#pragma unroll
        for (int h = 0; h < 2; ++h)
#pragma unroll
            for (int i = 0; i < 2; ++i) nvo[h][i] = cvo[h][i];
        if (has_next) { nA = S.a_ptr(nxt); nB = S.b_ptr(nxt); S.a_off(nxt, sR, sC, nvo, ent + ((ui + 1) & 3) * 2048); }
        if constexpr (Sched::META) { Unit u2; if (S.next(ui + 2, u2)) S.meta_issue(u2, ent + ((ui + 2) & 3) * 2048, wid, lane); }
        for (int t = 0; t < nt; t += 2) {
            const bool last = (t == nt - 2);
            const char* a1 = cA + (size_t)(t + 1) * kstep;
            const char* a2 = last ? nA : cA + (size_t)(t + 2) * kstep; const char* b2 = last ? nB : cB + (size_t)(t + 2) * kstep;
            const char* a3 = a2 + kstep; const char* b3 = b2 + kstep;
            unsigned xvo[2][2];
#pragma unroll
            for (int h = 0; h < 2; ++h)
#pragma unroll
                for (int i = 0; i < 2; ++i) xvo[h][i] = last ? nvo[h][i] : cvo[h][i];
            PG8_LDB(B0, 0, 0); PG8_LDB(B1, 0, 1); PG8_SCHED; PG8_LDA(At, 0, 0); PG8_STAGE(PG8_SA(1, 1), a1, cvo[1]);
            PG8_WAIT_V(8); PG8_WAIT_L(0); PG8_BAR; PG8_MMA(0, 0, At, B0); PG8_MMA(0, 1, At, B1); PG8_BAR; PG8_SCHED;
            PG8_LDA(At, 0, 1); PG8_STAGE(PG8_SB(0, 0), b2, voffB); PG8_STAGE(PG8_SB(0, 1), b2 + hstepB, voffB); PG8_STAGE(PG8_SA(0, 0), a2, xvo[0]);
            PG8_WAIT_V(8); PG8_WAIT_L(0); PG8_BAR; PG8_MMA(1, 0, At, B0); PG8_MMA(1, 1, At, B1); PG8_BAR; PG8_SCHED;
            PG8_LDB(B0, 1, 0); PG8_LDB(B1, 1, 1); PG8_SCHED; PG8_LDA(At, 1, 0); PG8_STAGE(PG8_SA(0, 1), a2, xvo[1]);
            PG8_WAIT_V(8); PG8_WAIT_L(0); PG8_BAR; PG8_MMA(0, 0, At, B0); PG8_MMA(0, 1, At, B1); PG8_BAR; PG8_SCHED;
            PG8_LDA(At, 1, 1); PG8_STAGE(PG8_SB(1, 0), b3, voffB); PG8_STAGE(PG8_SB(1, 1), b3 + hstepB, voffB); PG8_STAGE(PG8_SA(1, 0), a3, xvo[0]);
            PG8_WAIT_V(8); PG8_WAIT_L(0); PG8_BAR; PG8_MMA(1, 0, At, B0); PG8_MMA(1, 1, At, B1); PG8_BAR; PG8_SCHED;
        }
        if (wr == 0) PG8_BAR;
        E(acc, cur, wr, wc, fr, fq, ent + (ui & 3) * 2048);
        if (!has_next) break;
#pragma unroll
        for (int a = 0; a < 2; ++a)
#pragma unroll
            for (int b = 0; b < 2; ++b)
#pragma unroll
                for (int m = 0; m < 4; ++m)
#pragma unroll
                    for (int n = 0; n < 2; ++n) acc[a][b][m][n] = (f32x4){0.f, 0.f, 0.f, 0.f};
        cur = nxt; cA = nA; cB = nB; ++ui;
#pragma unroll
        for (int h = 0; h < 2; ++h)
#pragma unroll
            for (int i = 0; i < 2; ++i) cvo[h][i] = nvo[h][i];
        if (wr == 1) PG8_BAR;
    }
    PG8_WAIT_V(0);
    PG8_BAR;
#undef PG8_SA
#undef PG8_SB
#undef PG8_STAGE
#undef PG8_LDA
#undef PG8_LDB
#undef PG8_MMA
#undef PG8_WAIT_V
#undef PG8_WAIT_L
#undef PG8_BAR
#undef PG8_SCHED
}
}

constexpr int NWAVES = 8, NTHR = NWAVES * 64;
constexpr int D = 1024, BATCH = 4, SEQ = 8192, M = BATCH * SEQ;
constexpr int PW = 512, CW = 512, CK = 31, INC = 3584;
constexpr int NE = 256, TOPK = 8, NG = 8, EH = 256;
constexpr int ECAP = M;
constexpr int MAXT = (M * TOPK) / 256 + NE;
constexpr float LN_EPS = 1e-5f, ALPHA = 1.189207115002721f  , RSCALE = 2.5f;

constexpr size_t MiB = 1u << 20;
constexpr size_t WS_CTL = 0, CTL_ZERO_BYTES = 1 * MiB;
constexpr size_t WS_WIN = 1 * MiB;
constexpr size_t WS_POOL = 8 * MiB;
constexpr size_t WS_CVO = 8 * MiB + 512 * 1024;
constexpr size_t WS_WOUT = 10 * MiB;
constexpr size_t WS_RSH = 12 * MiB;
constexpr size_t WS_SDN = 14 * MiB;
constexpr size_t WS_EDN = 16 * MiB;
constexpr size_t WS_X1 = 144 * MiB;
constexpr size_t WS_HS = 208 * MiB;
constexpr size_t WS_LIST = 224 * MiB;
constexpr size_t WS_HE = 288 * MiB;
constexpr size_t WS_EGU = 448 * MiB;
constexpr size_t WS_PH = 704 * MiB;
constexpr size_t WS_XB = WS_PH;
constexpr size_t WS_U = WS_PH + 64 * MiB, WS_V = WS_PH + 96 * MiB;
constexpr size_t WS_GP = WS_PH + 128 * MiB, WS_GC = WS_PH + 192 * MiB;
constexpr size_t WS_R = WS_PH + 256 * MiB, WS_C = WS_PH + 288 * MiB;
constexpr size_t WS_T1 = WS_XB;
constexpr size_t WS_MG = WS_U;
constexpr size_t WS_Z = WS_GP;
constexpr size_t WS_LOG = WS_HE;
constexpr size_t WS_END = 1024 * MiB;
constexpr size_t WS_Y = WS_EGU;
static_assert(WS_Y + (size_t)M * 8 * D * 2 <= WS_R, "Y slots end before R");
constexpr size_t WS_YSH = WS_R;
static_assert(WS_YSH + (size_t)M * D * 2 <= WS_END, "ws map");
static_assert(WS_HE + (size_t)MAXT * 256 * EH * 2 <= WS_EGU, "HE fits");
static_assert(WS_LIST + (size_t)NE * ECAP * 8 <= WS_HE, "LIST fits");

constexpr int CW_CNT = 1024;
constexpr int CW_BAR = 4096;

constexpr int RING_OFF = 0, RING_BYTES = 131072;
constexpr int TAB_OFF = RING_BYTES;
constexpr int ENT_OFF = TAB_OFF + 4096;
constexpr int MISC_OFF = ENT_OFF + 8192;
constexpr int LDS_BYTES = 147456;
static_assert(MISC_OFF + 128 <= LDS_BYTES, "LDS map");

#define GAS __attribute__((address_space(1)))
#define LAS __attribute__((address_space(3)))
typedef unsigned short bf16;
typedef unsigned v4u __attribute__((ext_vector_type(4)));
typedef unsigned v2u __attribute__((ext_vector_type(2)));
typedef float f32x4 __attribute__((ext_vector_type(4)));
typedef GAS unsigned gu32;
#define RLX_AGENT __ATOMIC_RELAXED, __HIP_MEMORY_SCOPE_AGENT
#define LDS_WAIT() asm volatile("s_waitcnt lgkmcnt(0)" ::: "memory")
#define VM_WAIT() asm volatile("s_waitcnt vmcnt(0)" ::: "memory")
__device__ __forceinline__ unsigned f2bf(float f) { unsigned u = __builtin_bit_cast(unsigned, f); return (u + 0x7fffu + ((u >> 16) & 1u)) >> 16; }
__device__ __forceinline__ unsigned pk2(float lo, float hi) { return pg8::cvt_pk_bf16(lo, hi); }

#define XB_TMO      128
#define XB_XCNT(j)  (256  + 64 * (j))
#define XB_XSUB(j)  (1280 + 64 * (j))
#define XB_XGEN(j)  (2304 + 64 * (j))
#define XB_TOP      3328
#define XB_TOPGEN   3392
#define XCD_BAR_WORDS 3456
#define XB_SPIN_CAP (1u << 20)
__device__ __forceinline__ unsigned xb_ld(unsigned* p)              { return __hip_atomic_load(p, __ATOMIC_RELAXED, __HIP_MEMORY_SCOPE_AGENT); }
__device__ __forceinline__ unsigned xb_add(unsigned* p, unsigned v) { return __hip_atomic_fetch_add(p, v, __ATOMIC_RELAXED, __HIP_MEMORY_SCOPE_AGENT); }
__device__ __forceinline__ unsigned xb_xcc_id() { return (unsigned)__builtin_amdgcn_s_getreg((3 << 11) | 20) & 0xFu; }
#define XB_SPIN(cond, bar) do { unsigned _sp = 0; while (cond) { __builtin_amdgcn_s_sleep(1); \
    if ((++_sp & 255u) == 0u) { if (xb_ld(&(bar)[XB_TMO])) break; if (_sp > XB_SPIN_CAP) { atomicAdd(&(bar)[XB_TMO], 1u); break; } } } } while (0)
struct XcdBarrier { unsigned* bar; unsigned x; volatile LAS unsigned* st; };
__device__ __forceinline__ XcdBarrier xcd_barrier_post(unsigned* bar, volatile LAS unsigned* st) {
    XcdBarrier b; b.bar = bar; b.x = xb_xcc_id(); b.st = st;
    if (threadIdx.x == 0) (void)xb_add(&bar[XB_XCNT(b.x)], 1u);
    return b;
}
__device__ __forceinline__ void xcd_barrier_complete(unsigned* bar, unsigned x, unsigned& nloc, unsigned& nx) {
    const unsigned G = gridDim.x * gridDim.y * gridDim.z;
    unsigned sum, cnt, mine, sp = 0u;
    for (;;) {
        sum = 0u; cnt = 0u; mine = 0u;
#pragma unroll
        for (unsigned j = 0; j < 16; ++j) { const unsigned c = xb_ld(&bar[XB_XCNT(j)]); sum += c; cnt += (c > 0u) ? 1u : 0u; mine = (j == x) ? c : mine; }
        if (sum == G) break;
        __builtin_amdgcn_s_sleep(1);
        if ((++sp & 255u) == 0u) { if (xb_ld(&bar[XB_TMO])) break; if (sp > XB_SPIN_CAP) { atomicAdd(&bar[XB_TMO], 1u); break; } }
    }
    nloc = mine > 0u ? mine : 1u; nx = cnt > 0u ? cnt : 1u;
}
__device__ __forceinline__ void xcd_barrier(const XcdBarrier& b) {
    asm volatile("s_waitcnt vmcnt(0)" ::: "memory");
    __syncthreads();
    if (threadIdx.x == 0) {
        unsigned* bar = b.bar;
        __builtin_amdgcn_s_waitcnt(0);
        unsigned nloc = b.st[0], nx = b.st[1];
        if (nloc == 0u) { xcd_barrier_complete(bar, b.x, nloc, nx); b.st[0] = nloc; b.st[1] = nx; }
        const unsigned old = xb_add(&bar[XB_XSUB(b.x)], 1u);
        const unsigned gen = old / nloc;
        if (old + 1u == (gen + 1u) * nloc) {
            __builtin_amdgcn_fence(__ATOMIC_RELEASE, "agent");
            asm volatile("s_waitcnt vmcnt(0)" ::: "memory");
            const unsigned og = xb_add(&bar[XB_TOP], 1u);
            const unsigned tg = og / nx;
            if (og + 1u == (tg + 1u) * nx) xb_add(&bar[XB_TOPGEN], 1u);
            else XB_SPIN(xb_ld(&bar[XB_TOPGEN]) == tg, bar);
            __builtin_amdgcn_fence(__ATOMIC_ACQUIRE, "agent");
            xb_add(&bar[XB_XGEN(b.x)], 1u);
            asm volatile("s_waitcnt vmcnt(0)" ::: "memory");
        } else {
            XB_SPIN(xb_ld(&bar[XB_XGEN(b.x)]) == gen, bar);
            __builtin_amdgcn_fence(__ATOMIC_ACQUIRE, "agent");
            asm volatile("s_waitcnt vmcnt(0)" ::: "memory");
        }
    }
    __syncthreads();
}

struct Frame {
    LAS unsigned char* lds;
    volatile LAS unsigned* MISC;
    gu32* ctl;
    int wave;
    int vcu, G;
    const float* in[21]; float* out; unsigned char* ws;
};
__device__ __forceinline__ int lane_id() { int l; asm volatile("v_mbcnt_lo_u32_b32 %0, -1, 0\n\tv_mbcnt_hi_u32_b32 %0, -1, %0" : "=v"(l)); return l; }
__device__ __forceinline__ float wave_sum(float v) {
#pragma unroll
    for (int o = 1; o < 64; o <<= 1) v += __shfl_xor(v, o);
    return v;
}

__host__ __device__ __forceinline__ int xcd_chunk(int L, int nwg) {
    const int q = nwg / 8, r = nwg % 8, xcd = L % 8, off = L / 8;
    return (xcd < r ? xcd * (q + 1) : r * (q + 1) + (xcd - r) * q) + off;
}
struct DenseOrder {   static constexpr bool META = false;
    const bf16* A; const bf16* Bt; int lda, ldb, nt, acol_pn;
    int nM, nN, nwg, G, c;
    __device__ __forceinline__ void init(const bf16* A_, const bf16* Bt_, int Mr, int N, int K, int lda_, int ldb_, int acol_pn_, int G_, int c_) {
        A = A_; Bt = Bt_; lda = lda_; ldb = ldb_; nt = K / 64; acol_pn = acol_pn_; nM = Mr / 256; nN = N / 256; nwg = nM * nN; G = G_; c = c_; }
    __device__ __forceinline__ bool next(int i, pg8::Unit& u) const {
        const int L = i * G + c; if (L >= nwg) return false;
        const int wgid = xcd_chunk(L, nwg);
        const int nig = 8 * nN, gid = wgid / nig, fm = gid * 8, gsz = (nM - fm) < 8 ? (nM - fm) : 8;
        u.pm = fm + ((wgid % nig) % gsz); u.pn = (wgid % nig) / gsz; u.e = 0; u.r0 = 0; u.nrow = 256; return true;
    }
    __device__ __forceinline__ const char* a_ptr(const pg8::Unit& u) const { return (const char*)(A + (size_t)u.pm * 256 * lda + u.pn * acol_pn); }
    __device__ __forceinline__ const char* b_ptr(const pg8::Unit& u) const { return (const char*)(Bt + (size_t)u.pn * 256 * ldb); }
    __device__ __forceinline__ void a_off(const pg8::Unit&, const int (&R)[2], const int (&C)[2], unsigned (&o)[2][2], const LAS unsigned char*) const {
#pragma unroll
        for (int h = 0; h < 2; ++h)
#pragma unroll
            for (int i = 0; i < 2; ++i) o[h][i] = (unsigned)((h * 128 + R[i]) * lda + C[i]) * 2u;
    }
};
template <bool GATHER> struct ExpertOrder {
    static constexpr bool META = true;
    const bf16* A; const bf16* Bt; int lda, ldb, nt; size_t bstride;
    const LAS int* tstart; const LAS int* cntl; const int* list;
    int nN, nwg, G, c;
    __device__ __forceinline__ bool next(int i, pg8::Unit& u) const {
        const int L = i * G + c; if (L >= nwg) return false;
        const int wgid = xcd_chunk(L, nwg);
        const int t = wgid / nN; u.pn = wgid % nN; u.pm = t;
        int lo = 0, hi = NE;
#pragma unroll
        for (int s = 0; s < 8; ++s) { const int mid = (lo + hi) >> 1; if (tstart[mid] <= t) lo = mid; else hi = mid; }
        u.e = lo; u.r0 = (t - tstart[lo]) * 256; u.nrow = cntl[lo] - u.r0; return true;
    }
    __device__ __forceinline__ const char* a_ptr(const pg8::Unit& u) const { return GATHER ? (const char*)A : (const char*)(A + (size_t)u.pm * 256 * lda); }
    __device__ __forceinline__ const char* b_ptr(const pg8::Unit& u) const { return (const char*)(Bt + (size_t)u.e * bstride + (size_t)u.pn * 256 * ldb); }
    __device__ __forceinline__ void meta_issue(const pg8::Unit& u, LAS unsigned char* dst, int wid, int lane) const {
        const char* src = (const char*)(list + ((size_t)u.e * ECAP + u.r0) * 2) + wid * 256 + lane * 4;
        __builtin_amdgcn_global_load_lds((const unsigned*)src, (LAS unsigned*)(dst + wid * 256), 4, 0, 0);
    }
    __device__ __forceinline__ void a_off(const pg8::Unit& u, const int (&R)[2], const int (&C)[2], unsigned (&o)[2][2], const LAS unsigned char* ent) const {
#pragma unroll
        for (int h = 0; h < 2; ++h)
#pragma unroll
            for (int i = 0; i < 2; ++i) {
                const int rl = h * 128 + R[i];
                if (GATHER) { int slot = *(const LAS int*)(ent + rl * 8); if (rl >= u.nrow) slot = 0; o[h][i] = (unsigned)((slot >> 3) * lda + C[i]) * 2u; }
                else o[h][i] = (unsigned)(rl * lda + C[i]) * 2u;
            }
    }
};

using pg8::f32x4; using pg8::u32x4; using pg8::pack8; using pg8::unpack8; using pg8::sigmoid4;
#define EPI_ROWS_BEGIN _Pragma("unroll") for (int ai = 0; ai < 2; ++ai) _Pragma("unroll") for (int m = 0; m < 4; ++m) { const int row = u.pm * 256 + ai * 128 + wr * 64 + m * 16 + fr;
#define EPI_ROWS_END }
#define UNROLL _Pragma("unroll")
typedef const pg8::f32x4 (&AccRef)[2][2][4][2];
struct EpiProj { static constexpr bool PERM = true; bf16 *U, *V, *GP, *GC;
    __device__ __forceinline__ void operator()(AccRef acc, const pg8::Unit& u, int wr, int wc, int fr, int fq, const LAS unsigned char* ent) const {
        const int cb = wc * 32 + 8 * fq;
        if (u.pn < 2) {
            EPI_ROWS_BEGIN
                bf16* p = U + (size_t)row * PW + u.pn * 256 + cb;
                UNROLL for (int bj = 0; bj < 2; ++bj) *(u32x4*)(p + bj * 128) = pack8(acc[ai][bj][m][0], acc[ai][bj][m][1]);
            EPI_ROWS_END
        } else if (u.pn < 6) {
            const int j = u.pn - 2;
            EPI_ROWS_BEGIN
                bf16* p = V + (size_t)row * CW + j * 128 + cb;
                *(u32x4*)p = pack8(acc[ai][0][m][0] * sigmoid4(acc[ai][1][m][0]), acc[ai][0][m][1] * sigmoid4(acc[ai][1][m][1]));
            EPI_ROWS_END
        } else {
            bf16* Gt = (u.pn < 10) ? GP : GC; const int t = (u.pn - 6) & 3;
            EPI_ROWS_BEGIN
                bf16* p = Gt + (size_t)row * D + t * 256 + cb;
                UNROLL for (int bj = 0; bj < 2; ++bj) *(u32x4*)(p + bj * 128) = pack8(sigmoid4(acc[ai][bj][m][0]), sigmoid4(acc[ai][bj][m][1]));
            EPI_ROWS_END
        }
    }
};
struct EpiPool { static constexpr bool PERM = true; const float* scale; const bf16* GP; bf16* T1;
    __device__ __forceinline__ void operator()(AccRef acc, const pg8::Unit& u, int wr, int wc, int fr, int fq, const LAS unsigned char* ent) const {
        const int c0 = u.pn * 256 + wc * 32 + 8 * fq; const int row0 = u.pm * 256 + wr * 64 + fr;
        UNROLL for (int bj = 0; bj < 2; ++bj) {
            const f32x4 sc0 = *(const f32x4*)(scale + c0 + bj * 128), sc1 = *(const f32x4*)(scale + c0 + bj * 128 + 4);
            u32x4 g[2][4];
            UNROLL for (int ai = 0; ai < 2; ++ai) UNROLL for (int m = 0; m < 4; ++m) g[ai][m] = *(const u32x4*)(GP + (size_t)(row0 + ai * 128 + m * 16) * D + c0 + bj * 128);
            UNROLL for (int ai = 0; ai < 2; ++ai) UNROLL for (int m = 0; m < 4; ++m) { f32x4 g0, g1; unpack8(g[ai][m], g0, g1);
                *(u32x4*)(T1 + (size_t)(row0 + ai * 128 + m * 16) * D + c0 + bj * 128) = pack8(acc[ai][bj][m][0] * sc0 * g0, acc[ai][bj][m][1] * sc1 * g1); }
        }
    }
};
struct EpiConvOut { static constexpr bool PERM = true; const bf16* T1; const bf16* GC; bf16* MG;
    __device__ __forceinline__ void operator()(AccRef acc, const pg8::Unit& u, int wr, int wc, int fr, int fq, const LAS unsigned char* ent) const {
        const int c0 = u.pn * 256 + wc * 32 + 8 * fq; const int row0 = u.pm * 256 + wr * 64 + fr;
        UNROLL for (int bj = 0; bj < 2; ++bj)
            UNROLL for (int ai = 0; ai < 2; ++ai) {
                u32x4 g[4], t[4];
                UNROLL for (int m = 0; m < 4; ++m) { const size_t o = (size_t)(row0 + ai * 128 + m * 16) * D + c0 + bj * 128; g[m] = *(const u32x4*)(GC + o); t[m] = *(const u32x4*)(T1 + o); }
                UNROLL for (int m = 0; m < 4; ++m) { const size_t o = (size_t)(row0 + ai * 128 + m * 16) * D + c0 + bj * 128; f32x4 g0, g1, t0, t1; unpack8(g[m], g0, g1); unpack8(t[m], t0, t1);
                    *(u32x4*)(MG + o) = pack8(t0 + acc[ai][bj][m][0] * g0, t1 + acc[ai][bj][m][1] * g1); }
                asm volatile("" ::: "memory");
            }
    }
};
struct EpiWout { static constexpr bool PERM = true; const float* X; float* Z;
    __device__ __forceinline__ void operator()(AccRef acc, const pg8::Unit& u, int wr, int wc, int fr, int fq, const LAS unsigned char* ent) const {
        const int c0 = u.pn * 256 + wc * 32 + 8 * fq; const int row0 = u.pm * 256 + wr * 64 + fr;
        UNROLL for (int bj = 0; bj < 2; ++bj)
            UNROLL for (int ai = 0; ai < 2; ++ai) {
                f32x4 x0[4], x1[4];
                UNROLL for (int m = 0; m < 4; ++m) { const size_t o = (size_t)(row0 + ai * 128 + m * 16) * D + c0 + bj * 128; x0[m] = *(const f32x4*)(X + o); x1[m] = *(const f32x4*)(X + o + 4); }
                UNROLL for (int m = 0; m < 4; ++m) { const size_t o = (size_t)(row0 + ai * 128 + m * 16) * D + c0 + bj * 128;
                    *(f32x4*)(Z + o) = x0[m] * ALPHA + acc[ai][bj][m][0]; *(f32x4*)(Z + o + 4) = x1[m] * ALPHA + acc[ai][bj][m][1]; }
                asm volatile("" ::: "memory");
            }
    }
};
__device__ __forceinline__ f32x4 silu_mul4(const f32x4 g, const f32x4 v) { return g * sigmoid4(g) * v; }
struct EpiRSh { static constexpr bool PERM = true; float* LOG; bf16* HS;
    __device__ __forceinline__ void operator()(AccRef acc, const pg8::Unit& u, int wr, int wc, int fr, int fq, const LAS unsigned char* ent) const {
        const int cb = wc * 32 + 8 * fq;
        if (u.pn == 0) {
            EPI_ROWS_BEGIN
                float* p = LOG + (size_t)row * NE + cb;
                UNROLL for (int bj = 0; bj < 2; ++bj) { *(f32x4*)(p + bj * 128) = acc[ai][bj][m][0]; *(f32x4*)(p + bj * 128 + 4) = acc[ai][bj][m][1]; }
            EPI_ROWS_END
        } else {
            const int j = u.pn - 1;
            EPI_ROWS_BEGIN
                bf16* p = HS + (size_t)row * EH + j * 128 + cb;
                *(u32x4*)p = pack8(silu_mul4(acc[ai][0][m][0], acc[ai][1][m][0]), silu_mul4(acc[ai][0][m][1], acc[ai][1][m][1]));
            EPI_ROWS_END
        }
    }
};
struct EpiEGU { static constexpr bool PERM = true; bf16* HE;
    __device__ __forceinline__ void operator()(AccRef acc, const pg8::Unit& u, int wr, int wc, int fr, int fq, const LAS unsigned char* ent) const {
        const int cb = wc * 32 + 8 * fq;
        EPI_ROWS_BEGIN
            bf16* p = HE + (size_t)row * EH + u.pn * 128 + cb;
            *(u32x4*)p = pack8(silu_mul4(acc[ai][0][m][0], acc[ai][1][m][0]), silu_mul4(acc[ai][0][m][1], acc[ai][1][m][1]));
        EPI_ROWS_END
    }
};
struct EpiEDown { static constexpr bool PERM = true; bf16* Y;
    __device__ __forceinline__ void operator()(AccRef acc, const pg8::Unit& u, int wr, int wc, int fr, int fq, const LAS unsigned char* ent) const {
        const unsigned cbyte = (unsigned)(u.pn * 256 + wc * 32 + 8 * fq) * 2u;
        UNROLL for (int ai = 0; ai < 2; ++ai)
            UNROLL for (int m = 0; m < 4; ++m) { const int rl = ai * 128 + wr * 64 + m * 16 + fr;
                if (rl < u.nrow) { const v2u e2 = *(const LAS v2u*)(ent + rl * 8); const float w = __uint_as_float(e2.y);
                    const unsigned off = e2.x * (unsigned)(D * 2) + cbyte;
                    UNROLL for (int bj = 0; bj < 2; ++bj) *(u32x4*)((char*)Y + off + bj * 256) = pack8(acc[ai][bj][m][0] * w, acc[ai][bj][m][1] * w); }
                asm volatile("" ::: "memory"); }
    }
};
struct EpiSDown { static constexpr bool PERM = true; bf16* YS;
    __device__ __forceinline__ void operator()(AccRef acc, const pg8::Unit& u, int wr, int wc, int fr, int fq, const LAS unsigned char* ent) const {
        const int c0 = u.pn * 256 + wc * 32 + 8 * fq;
        EPI_ROWS_BEGIN
            bf16* p = YS + (size_t)row * D + c0;
            UNROLL for (int bj = 0; bj < 2; ++bj) *(u32x4*)(p + bj * 128) = pack8(acc[ai][bj][m][0], acc[ai][bj][m][1]);
        EPI_ROWS_END
    }
};

__device__ __forceinline__ void p0_item(const float* W, int N, bf16* WT, int ldw, int k0, int n0, int drow0, LAS float* scr, int lane) {
#pragma unroll 8
    for (int i = 0; i < 32; ++i) { const int kk = 2 * i + (lane >> 5); scr[kk * 33 + (lane & 31)] = W[(size_t)(k0 + kk) * N + n0 + (lane & 31)]; }
    LDS_WAIT(); asm volatile("" ::: "memory");
    const int c = lane & 7;
#pragma unroll
    for (int j = 0; j < 4; ++j) { const int n = (lane >> 3) + 8 * j; const LAS float* s = scr + (8 * c) * 33 + n;
        v4u o; o.x = pk2(s[0 * 33], s[1 * 33]); o.y = pk2(s[2 * 33], s[3 * 33]); o.z = pk2(s[4 * 33], s[5 * 33]); o.w = pk2(s[6 * 33], s[7 * 33]);
        *(GAS v4u*)(WT + (size_t)(drow0 + n) * ldw + k0 + 8 * c) = o; }
    LDS_WAIT(); asm volatile("" ::: "memory");
}
__device__ __forceinline__ int win_row(int n0) {
    if (n0 < 512) return n0;
    if (n0 < 1024) { const int q = n0 - 512; return 512 + (q >> 7) * 256 + (q & 127); }
    if (n0 < 1536) { const int q = n0 - 1024; return 512 + (q >> 7) * 256 + 128 + (q & 127); }
    return n0;
}
__device__ __forceinline__ int gu_row(int n0, int up) { return (n0 >> 7) * 256 + up * 128 + (n0 & 127); }
__device__ __forceinline__ void p0_prologue(Frame& F) {
    LAS float* scr = (LAS float*)(F.lds + RING_OFF + F.wave * 16384);
    const int lane = lane_id(), tid = F.wave * 64 + lane;
    const int gw = F.vcu * NWAVES + F.wave, NGW = F.G * NWAVES;
    unsigned char* ws = F.ws;
    constexpr int I_WIN = 16 * 112, I_POOL = 4 * 16, I_CVO = 8 * 32, I_WOUT = 16 * 32, I_RT = 16 * 8, I_SG = 128, I_SU = 128, I_SD = 4 * 32, I_EG = NE * 128, I_EU = NE * 128, I_ED = NE * 128;
    constexpr int NITEMS = I_WIN + I_POOL + I_CVO + I_WOUT + I_RT + I_SG + I_SU + I_SD + I_EG + I_EU + I_ED;
    for (int it = gw; it < NITEMS; it += NGW) {
        int r = it;
        if (r < I_EG) { const int e = r >> 7, rr = r & 127, kb = rr >> 3, nb = rr & 7;
            p0_item(F.in[13] + (size_t)e * D * EH, EH, (bf16*)(ws + WS_EGU) + (size_t)e * 512 * D, D, 64 * kb, 32 * nb, gu_row(32 * nb, 0), scr, lane); continue; } r -= I_EG;
        if (r < I_EU) { const int e = r >> 7, rr = r & 127, kb = rr >> 3, nb = rr & 7;
            p0_item(F.in[14] + (size_t)e * D * EH, EH, (bf16*)(ws + WS_EGU) + (size_t)e * 512 * D, D, 64 * kb, 32 * nb, gu_row(32 * nb, 1), scr, lane); continue; } r -= I_EU;
        if (r < I_ED) { const int e = r >> 7, rr = r & 127, kb = rr >> 5, nb = rr & 31;
            p0_item(F.in[15] + (size_t)e * EH * D, D, (bf16*)(ws + WS_EDN) + (size_t)e * D * EH, EH, 64 * kb, 32 * nb, 32 * nb, scr, lane); continue; } r -= I_ED;
        if (r < I_WIN) { const int kb = r / 112, nb = r % 112; p0_item(F.in[1], INC, (bf16*)(ws + WS_WIN), D, 64 * kb, 32 * nb, win_row(32 * nb), scr, lane); continue; } r -= I_WIN;
        if (r < I_POOL) { const int g = r >> 4, rr = r & 15, kb = rr >> 3, nb = rr & 7;
            p0_item(F.in[2] + (size_t)g * 128 * 256, 256, (bf16*)(ws + WS_POOL) + (size_t)g * 256 * 128, 128, 64 * kb, 32 * nb, 32 * nb, scr, lane); continue; } r -= I_POOL;
        if (r < I_CVO) { const int kb = r >> 5, nb = r & 31; p0_item(F.in[7], D, (bf16*)(ws + WS_CVO), CW, 64 * kb, 32 * nb, 32 * nb, scr, lane); continue; } r -= I_CVO;
        if (r < I_WOUT) { const int kb = r >> 5, nb = r & 31; p0_item(F.in[8], D, (bf16*)(ws + WS_WOUT), D, 64 * kb, 32 * nb, 32 * nb, scr, lane); continue; } r -= I_WOUT;
        if (r < I_RT) { const int kb = r >> 3, nb = r & 7; p0_item(F.in[11], NE, (bf16*)(ws + WS_RSH), D, 64 * kb, 32 * nb, 32 * nb, scr, lane); continue; } r -= I_RT;
        if (r < I_SG) { const int kb = r >> 3, nb = r & 7; p0_item(F.in[16], EH, (bf16*)(ws + WS_RSH), D, 64 * kb, 32 * nb, 256 + gu_row(32 * nb, 0), scr, lane); continue; } r -= I_SG;
        if (r < I_SU) { const int kb = r >> 3, nb = r & 7; p0_item(F.in[17], EH, (bf16*)(ws + WS_RSH), D, 64 * kb, 32 * nb, 256 + gu_row(32 * nb, 1), scr, lane); continue; } r -= I_SU;
        { const int kb = r >> 5, nb = r & 31; p0_item(F.in[18], D, (bf16*)(ws + WS_SDN), EH, 64 * kb, 32 * nb, 32 * nb, scr, lane); }
    }
    const GAS f32x4* x4 = (const GAS f32x4*)F.in[0]; GAS v4u* xb = (GAS v4u*)(ws + WS_XB);
    for (int i = (int)blockIdx.x * NTHR + tid; i < M * D / 8; i += F.G * NTHR) { const f32x4 a = x4[2 * i], b = x4[2 * i + 1];
        v4u o; o.x = pk2(a.x, a.y); o.y = pk2(a.z, a.w); o.z = pk2(b.x, b.y); o.w = pk2(b.z, b.w); xb[i] = o; }
}

__device__ __forceinline__ void ld8(const LAS unsigned char* p, float (&v)[8]) { const v4u w = *(const LAS v4u*)p;
    v[0] = pg8::bf_lo(w.x); v[1] = pg8::bf_hi(w.x); v[2] = pg8::bf_lo(w.y); v[3] = pg8::bf_hi(w.y); v[4] = pg8::bf_lo(w.z); v[5] = pg8::bf_hi(w.z); v[6] = pg8::bf_lo(w.w); v[7] = pg8::bf_hi(w.w); }
__device__ __forceinline__ void p2_mixer(Frame& F) {
    constexpr int TT = 32, VR = TT + CK - 1  , UR = TT + 15  , DW_BYTES = CK * CW * 4  ;
    LAS unsigned char* ldw = F.lds; LAS unsigned char* lrow = F.lds + DW_BYTES;
    const bf16* U = (const bf16*)(F.ws + WS_U); const bf16* V = (const bf16*)(F.ws + WS_V); bf16* Rb = (bf16*)(F.ws + WS_R); bf16* Cb = (bf16*)(F.ws + WS_C);
    const int lane = lane_id(), w = F.wave, tid = w * 64 + lane;
    for (int i = tid; i < CK * CW / 4; i += NTHR) *(LAS f32x4*)(ldw + 16 * i) = *(const GAS f32x4*)(F.in[4] + 4 * i);
    for (int i = tid; i < 128; i += NTHR) *(LAS v4u*)(lrow + 62 * 1024 + 16 * i) = (v4u){0u, 0u, 0u, 0u};
    float lg[8], lb[8];
#pragma unroll
    for (int k = 0; k < 8; ++k) { lg[k] = F.in[5][lane * 8 + k]; lb[k] = F.in[6][lane * 8 + k]; }
    const int W = 2 << (lane >> 4);
    for (int unit = F.vcu; unit < M / TT; unit += F.G) {
        const int t0 = unit * TT, s0 = t0 % SEQ;
        __syncthreads();
        for (int c = tid; c < VR * 64; c += NTHR) { const int row = c >> 6, q = c & 63; const int s = s0 - (CK - 1) + row;
            v4u val = (v4u){0u, 0u, 0u, 0u}; if (s >= 0) val = *(const GAS v4u*)(V + (size_t)(t0 - (CK - 1) + row) * CW + q * 8);
            *(LAS v4u*)(lrow + row * 1024 + q * 16) = val; }
        __syncthreads();
        {
            float acc[4][8], wr_[4][8];
#pragma unroll
            for (int q = 0; q < 4; ++q)
#pragma unroll
                for (int k = 0; k < 8; ++k) { acc[q][k] = 0.f; wr_[q][k] = 0.f; }
#pragma unroll 1
            for (int i4 = 0; i4 < 9; ++i4) {
#pragma unroll
                for (int ii = 0; ii < 4; ++ii) { const int i = 4 * i4 + ii;
                    f32x4 a = (f32x4){0.f, 0.f, 0.f, 0.f}, b = a;
                    if (i <= 30) { a = *(const LAS f32x4*)(ldw + i * 2048 + lane * 32); b = *(const LAS f32x4*)(ldw + i * 2048 + lane * 32 + 16); }
                    wr_[ii][0] = a.x; wr_[ii][1] = a.y; wr_[ii][2] = a.z; wr_[ii][3] = a.w; wr_[ii][4] = b.x; wr_[ii][5] = b.y; wr_[ii][6] = b.z; wr_[ii][7] = b.w;
                    float v[8]; ld8(lrow + (4 * w + i) * 1024 + lane * 16, v);
#pragma unroll
                    for (int q = 0; q < 4; ++q) {
#pragma unroll
                        for (int k = 0; k < 8; ++k) acc[q][k] = fmaf(v[k], wr_[(ii - q) & 3][k], acc[q][k]); }
                }
            }
#pragma unroll
            for (int q = 0; q < 4; ++q) {
                float s = 0.f;
#pragma unroll
                for (int k = 0; k < 8; ++k) s += acc[q][k];
                const float mean = wave_sum(s) * (1.f / CW); float s2 = 0.f;
#pragma unroll
                for (int k = 0; k < 8; ++k) { acc[q][k] -= mean; s2 += acc[q][k] * acc[q][k]; }
                const float rstd = 1.f / sqrtf(wave_sum(s2) * (1.f / CW) + LN_EPS);
                float y[8];
#pragma unroll
                for (int k = 0; k < 8; ++k) { const float z = acc[q][k] * rstd * lg[k] + lb[k]; y[k] = z * pg8::sigmoidf_(z); }
                v4u o; o.x = pk2(y[0], y[1]); o.y = pk2(y[2], y[3]); o.z = pk2(y[4], y[5]); o.w = pk2(y[6], y[7]);
                *(GAS v4u*)(Cb + (size_t)(t0 + 4 * w + q) * CW + lane * 8) = o;
            }
        }
        __syncthreads();
        for (int c = tid; c < UR * 64; c += NTHR) { const int row = c >> 6, q = c & 63; const int s = s0 - 15 + row;
            v4u val = (v4u){0u, 0u, 0u, 0u}; if (s >= 0) val = *(const GAS v4u*)(U + (size_t)(t0 - 15 + row) * PW + q * 8);
            *(LAS v4u*)(lrow + row * 1024 + q * 16) = val; }
        __syncthreads();
        {
            float acc[4][8], own[4][8];
#pragma unroll
            for (int q = 0; q < 4; ++q)
#pragma unroll
                for (int k = 0; k < 8; ++k) { acc[q][k] = 0.f; own[q][k] = 0.f; }
#pragma unroll
            for (int i = 0; i < 19; ++i) {
                float v[8]; ld8(lrow + (4 * w + i) * 1024 + lane * 16, v);
#pragma unroll
                for (int q = 0; q < 4; ++q) { const int d = q + 15 - i; if (d >= 0 && d <= 15) { const bool in = d < W;
#pragma unroll
                    for (int k = 0; k < 8; ++k) { acc[q][k] += in ? v[k] : 0.f; if (d == 0) own[q][k] = v[k]; } } }
            }
#pragma unroll
            for (int q = 0; q < 4; ++q) { const int s = s0 + 4 * w + q; const int cnt = (s + 1) < W ? (s + 1) : W; const float inv = 1.f / (float)cnt;
                float y[8];
#pragma unroll
                for (int k = 0; k < 8; ++k) y[k] = acc[q][k] * inv - own[q][k];
                v4u o; o.x = pk2(y[0], y[1]); o.y = pk2(y[2], y[3]); o.z = pk2(y[4], y[5]); o.w = pk2(y[6], y[7]);
                *(GAS v4u*)(Rb + (size_t)(t0 + 4 * w + q) * PW + lane * 8) = o; }
        }
    }
    __syncthreads();
}

__device__ __forceinline__ void p6_ln1(Frame& F) {
    const int lane = lane_id();
    const int gw = F.vcu * NWAVES + F.wave, NGW = F.G * NWAVES;
    const float* Z = (const float*)(F.ws + WS_Z); bf16* X1 = (bf16*)(F.ws + WS_X1);
    f32x4 g[4], b[4];
#pragma unroll
    for (int j = 0; j < 4; ++j) { g[j] = *(const GAS f32x4*)(F.in[9] + 4 * lane + 256 * j); b[j] = *(const GAS f32x4*)(F.in[10] + 4 * lane + 256 * j); }
    for (int m = gw; m < M; m += NGW) {
        const GAS f32x4* zr = (const GAS f32x4*)(Z + (size_t)m * D) + lane;
        f32x4 v[4]; float s = 0.f;
#pragma unroll
        for (int j = 0; j < 4; ++j) { v[j] = zr[64 * j]; s += (v[j].x + v[j].y) + (v[j].z + v[j].w); }
        const float mean = wave_sum(s) * (1.f / D); float s2 = 0.f;
#pragma unroll
        for (int j = 0; j < 4; ++j) { v[j] = v[j] - mean; s2 += (v[j].x * v[j].x + v[j].y * v[j].y) + (v[j].z * v[j].z + v[j].w * v[j].w); }
        const float rstd = 1.f / sqrtf(wave_sum(s2) * (1.f / D) + LN_EPS);
        GAS v2u* o8 = (GAS v2u*)(X1 + (size_t)m * D) + lane;
#pragma unroll
        for (int j = 0; j < 4; ++j) { const f32x4 y = v[j] * rstd * g[j] + b[j]; v2u o; o.x = pk2(y.x, y.y); o.y = pk2(y.z, y.w); o8[64 * j] = o; }
    }
}

__device__ __forceinline__ void p8_route(Frame& F) {
    const int lane = lane_id();
    const int gw = F.vcu * NWAVES + F.wave, NGW = F.G * NWAVES;
    const float* LOG = (const float*)(F.ws + WS_LOG); int* list = (int*)(F.ws + WS_LIST); unsigned* cnt = (unsigned*)F.ctl + CW_CNT;
    const f32x4 bias = *(const GAS f32x4*)(F.in[12] + 4 * lane);
    const float NEG = -__builtin_inff();
    for (int tok = gw; tok < M; tok += NGW) {
        const f32x4 lg = *(const GAS f32x4*)(LOG + (size_t)tok * NE + 4 * lane);
        float sc0 = 1.f / (1.f + __expf(-lg.x)), sc1 = 1.f / (1.f + __expf(-lg.y)), sc2 = 1.f / (1.f + __expf(-lg.z)), sc3 = 1.f / (1.f + __expf(-lg.w));
        float c0 = sc0 + bias.x, c1 = sc1 + bias.y, c2 = sc2 + bias.z, c3 = sc3 + bias.w;
        const float h01 = fmaxf(c0, c1), l01 = fminf(c0, c1), h23 = fmaxf(c2, c3), l23 = fminf(c2, c3);
        float m1 = fmaxf(h01, h23), m2 = fmaxf(fminf(h01, h23), fmaxf(l01, l23));
#pragma unroll
        for (int o = 1; o < 8; o <<= 1) { const float b1 = __shfl_xor(m1, o), b2 = __shfl_xor(m2, o); const float n1 = fmaxf(m1, b1), n2 = fmaxf(fminf(m1, b1), fmaxf(m2, b2)); m1 = n1; m2 = n2; }
        const float gs = m1 + m2; const int mygrp = lane >> 3; int rank = 0;
#pragma unroll
        for (int g = 0; g < NG; ++g) { const float og = __shfl(gs, g * 8); rank += (og > gs || (og == gs && g < mygrp)) ? 1 : 0; }
        if (rank >= 4) { c0 = NEG; c1 = NEG; c2 = NEG; c3 = NEG; }
        float sumw = 0.f, mysc = 0.f; int myidx = 0;
#pragma unroll
        for (int r = 0; r < TOPK; ++r) {
            float bv = c0, bs = sc0; int gi = 4 * lane;
            if (c1 > bv) { bv = c1; bs = sc1; gi = 4 * lane + 1; }
            if (c2 > bv) { bv = c2; bs = sc2; gi = 4 * lane + 2; }
            if (c3 > bv) { bv = c3; bs = sc3; gi = 4 * lane + 3; }
#pragma unroll
            for (int o = 32; o >= 1; o >>= 1) { const float ov = __shfl_xor(bv, o), os = __shfl_xor(bs, o); const int oi = __shfl_xor(gi, o);
                const bool take = (ov > bv) || (ov == bv && oi < gi); if (take) { bv = ov; bs = os; gi = oi; } }
            if (lane == r) { myidx = gi; mysc = bs; }
            sumw += bs;
            if (gi == 4 * lane) c0 = NEG; if (gi == 4 * lane + 1) c1 = NEG; if (gi == 4 * lane + 2) c2 = NEG; if (gi == 4 * lane + 3) c3 = NEG;
        }
        if (lane < TOPK) { const float wgt = mysc / sumw * RSCALE; const unsigned pos = atomicAdd(&cnt[myidx], 1u);
            v2u ent; ent.x = (unsigned)(tok * TOPK + lane); ent.y = __float_as_uint(wgt); *(GAS v2u*)(list + ((size_t)myidx * ECAP + pos) * 2) = ent; }
    }
}

__device__ __forceinline__ int expert_table(Frame& F) {
    LAS int* tstart = (LAS int*)(F.lds + TAB_OFF); LAS int* cntl = tstart + 260; LAS int* wtot = tstart + 520;
    const unsigned* cnt = (const unsigned*)F.ctl + CW_CNT;
    const int lane = lane_id(), tid = F.wave * 64 + lane;
    __syncthreads();
    int c = 0, incl = 0;
    if (tid < NE) { c = (int)__hip_atomic_load(cnt + tid, RLX_AGENT); incl = (c + 255) >> 8;
#pragma unroll
        for (int o = 1; o < 64; o <<= 1) { const int up = __shfl_up(incl, o); if (lane >= o) incl += up; }
        if (lane == 63) wtot[F.wave] = incl; cntl[tid] = c; }
    __syncthreads();
    if (tid < NE) { int base = 0;
#pragma unroll
        for (int k = 0; k < 4; ++k) if (k < F.wave) base += wtot[k];
        tstart[tid + 1] = base + incl; if (tid == 0) tstart[0] = 0; }
    __syncthreads();
    return tstart[NE];
}

__device__ __forceinline__ void p11_combine(Frame& F) {
    const int lane = lane_id();
    const int gw = F.vcu * NWAVES + F.wave, NGW = F.G * NWAVES;
    const bf16* Y = (const bf16*)(F.ws + WS_Y); const bf16* YS = (const bf16*)(F.ws + WS_YSH); const bf16* X1 = (const bf16*)(F.ws + WS_X1);
    for (int tok = gw; tok < M; tok += NGW) {
        f32x4 a[4];
#pragma unroll
        for (int j = 0; j < 2; ++j) { f32x4 x0, x1; unpack8(*(const GAS v4u*)(X1 + (size_t)tok * D + lane * 8 + 512 * j), x0, x1); a[2 * j] = x0 * ALPHA; a[2 * j + 1] = x1 * ALPHA;
#if !(defined(DBG_COMBINE) && (DBG_COMBINE & 2))
            f32x4 s0, s1; unpack8(*(const GAS v4u*)(YS + (size_t)tok * D + lane * 8 + 512 * j), s0, s1); a[2 * j] += s0; a[2 * j + 1] += s1;
#endif
        }
#if !(defined(DBG_COMBINE) && (DBG_COMBINE & 1))
#pragma unroll
        for (int k = 0; k < TOPK; ++k)
#pragma unroll
            for (int j = 0; j < 2; ++j) { f32x4 y0, y1; unpack8(*(const GAS v4u*)(Y + ((size_t)tok * TOPK + k) * D + lane * 8 + 512 * j), y0, y1); a[2 * j] += y0; a[2 * j + 1] += y1; }
#endif
        float s = 0.f;
#pragma unroll
        for (int j = 0; j < 4; ++j) s += (a[j].x + a[j].y) + (a[j].z + a[j].w);
        const float mean = wave_sum(s) * (1.f / D); float s2 = 0.f;
#pragma unroll
        for (int j = 0; j < 4; ++j) { a[j] = a[j] - mean; s2 += (a[j].x * a[j].x + a[j].y * a[j].y) + (a[j].z * a[j].z + a[j].w * a[j].w); }
        const float rstd = 1.f / sqrtf(wave_sum(s2) * (1.f / D) + LN_EPS);
#pragma unroll
        for (int j = 0; j < 4; ++j) { const int col = lane * 8 + 512 * (j >> 1) + 4 * (j & 1);
            const f32x4 g = *(const GAS f32x4*)(F.in[19] + col), b = *(const GAS f32x4*)(F.in[20] + col);
            *(GAS f32x4*)(F.out + (size_t)tok * D + col) = a[j] * rstd * g + b; }
    }
}
#ifdef DBG_CHECK
constexpr int NT = 512;
constexpr size_t DBG_OFF = 448 * MiB;
__device__ __forceinline__ float dsig(float x) { return 1.f / (1.f + expf(-x)); }
__device__ __forceinline__ float bf2f(unsigned short h) { return __uint_as_float((unsigned)h << 16); }
__global__ void dbg_proj(const float* x, const float* w_in, float* PN) {
    for (int i = blockIdx.x * blockDim.x + threadIdx.x; i < NT * INC; i += gridDim.x * blockDim.x) { const int tok = i / INC, col = i % INC; float a = 0.f;
        for (int k = 0; k < D; ++k) a = fmaf(x[(size_t)tok * D + k], w_in[(size_t)k * INC + col], a); PN[i] = a; }
}
__global__ void dbg_mix1(const float* PN, const float* dw, float* RN, float* CVN) {
    for (int i = blockIdx.x * blockDim.x + threadIdx.x; i < NT * 512; i += gridDim.x * blockDim.x) { const int tok = i / 512, ch = i % 512; const int g = ch / 128, W = 2 << g;
        float s = 0.f; int cnt = 0; for (int j = 0; j < W; ++j) if (tok - j >= 0) { s += PN[(size_t)(tok - j) * INC + ch]; ++cnt; }
        RN[i] = s / (float)cnt - PN[(size_t)tok * INC + ch];
        float c = 0.f; for (int j = 0; j < CK; ++j) { const int t = tok - (CK - 1) + j; if (t >= 0) c += PN[(size_t)t * INC + 512 + ch] * dsig(PN[(size_t)t * INC + 1024 + ch]) * dw[j * 512 + ch]; }
        CVN[i] = c; }
}
__global__ void dbg_ln(const float* IN, int n, const float* g, const float* b, float* OUT, int act) {
    const int tok = blockIdx.x * blockDim.x + threadIdx.x; if (tok >= NT) return;
    float m = 0.f; for (int k = 0; k < n; ++k) m += IN[(size_t)tok * n + k]; m /= n; float v = 0.f; for (int k = 0; k < n; ++k) { const float d = IN[(size_t)tok * n + k] - m; v += d * d; } v /= n;
    const float r = 1.f / sqrtf(v + LN_EPS); for (int k = 0; k < n; ++k) { float y = (IN[(size_t)tok * n + k] - m) * r * g[k] + b[k]; if (act) y = y * dsig(y); OUT[(size_t)tok * n + k] = y; }
}
__global__ void dbg_mix3(const float* PN, const float* RN, const float* CN, const float* pool_w, const float* scale, const float* cwo, float* MGN) {
    for (int i = blockIdx.x * blockDim.x + threadIdx.x; i < NT * D; i += gridDim.x * blockDim.x) { const int tok = i / D, d = i % D, g = d / 256, dd = d % 256;
        float yp = 0.f; for (int c = 0; c < 128; ++c) yp = fmaf(RN[(size_t)tok * 512 + g * 128 + c], pool_w[((size_t)g * 128 + c) * 256 + dd], yp); yp *= scale[d];
        float yc = 0.f; for (int c = 0; c < 512; ++c) yc = fmaf(CN[(size_t)tok * 512 + c], cwo[(size_t)c * D + d], yc);
        MGN[i] = dsig(PN[(size_t)tok * INC + 1536 + d]) * yp + dsig(PN[(size_t)tok * INC + 2560 + d]) * yc; }
}
__global__ void dbg_mix4(const float* MGN, const float* w_out, const float* x, float* ZN) {
    for (int i = blockIdx.x * blockDim.x + threadIdx.x; i < NT * D; i += gridDim.x * blockDim.x) { const int tok = i / D, e = i % D; float a = 0.f;
        for (int d = 0; d < D; ++d) a = fmaf(MGN[(size_t)tok * D + d], w_out[(size_t)d * D + e], a); ZN[i] = ALPHA * x[(size_t)tok * D + e] + a; }
}
__global__ void dbg_cmp(int k, const void* buf, int kind, int ld, int n, const float* NV, int nld, int ncol0, int fn, const float* PN, float* acc) {
    float e2 = 0.f, r2 = 0.f;
    for (int i = blockIdx.x * blockDim.x + threadIdx.x; i < NT * n; i += gridDim.x * blockDim.x) { const int tok = i / n, c = i % n;
        const float a = kind ? ((const float*)buf)[(size_t)tok * ld + c] : bf2f(((const unsigned short*)buf)[(size_t)tok * ld + c]);
        float b = NV[(size_t)tok * nld + ncol0 + c];
        if (fn == 1) b = dsig(b);
        if (fn == 2) b = b * dsig(PN[(size_t)tok * INC + 1024 + c]);
        e2 += (a - b) * (a - b); r2 += b * b; }
    atomicAdd(acc + 2 * k, e2); atomicAdd(acc + 2 * k + 1, r2);
}
__global__ void dbg_cmp_tile(int k, const void* buf, int ld, int r0, int c0, const float* NV, int nld, int ncol0, float* acc) {
    float e2 = 0.f, r2 = 0.f;
    for (int i = blockIdx.x * blockDim.x + threadIdx.x; i < 256 * 256; i += gridDim.x * blockDim.x) { const int tok = r0 + i / 256, c = c0 + i % 256;
        const float a = bf2f(((const unsigned short*)buf)[(size_t)tok * ld + c]); const float b = dsig(NV[(size_t)tok * nld + ncol0 + c]);
        e2 += (a - b) * (a - b); r2 += b * b; }
    atomicAdd(acc + 2 * k, e2); atomicAdd(acc + 2 * k + 1, r2);
}
__global__ void dbg_cmp_wt(int k, const unsigned short* WT, const float* W, int n0, float* acc) {
    float e2 = 0.f, r2 = 0.f;
    for (int i = blockIdx.x * blockDim.x + threadIdx.x; i < 256 * 1024; i += gridDim.x * blockDim.x) { const int n = n0 + i / 1024, kk = i % 1024;
        const float a = bf2f(WT[(size_t)n * 1024 + kk]); const float b = W[(size_t)kk * INC + n];
        e2 += (a - b) * (a - b); r2 += b * b; }
    atomicAdd(acc + 2 * k, e2); atomicAdd(acc + 2 * k + 1, r2);
}
__global__ void dbg_code(const float* acc, int nchk, float* out, int n) {
    int code = 0; for (int k = nchk - 1; k >= 0; --k) if (!(acc[2 * k] <= 1e-3f * acc[2 * k + 1])) code = k + 1;
#ifdef DBG_TILES
    code = 0; for (int k = 0; k < 4; ++k) if (!(acc[2 * (16 + k)] <= 1e-3f * acc[2 * (16 + k) + 1])) code |= 1 << k;
#endif
#ifdef DBG_SHOW
    const float val = sqrtf(1000.f * acc[2 * DBG_SHOW] / acc[2 * DBG_SHOW + 1]);
    for (int i = blockIdx.x * blockDim.x + threadIdx.x; i < n; i += gridDim.x * blockDim.x) out[i] = val;
#else
    for (int i = blockIdx.x * blockDim.x + threadIdx.x; i < n; i += gridDim.x * blockDim.x) out[i] = (float)code;
#endif
}
static void dbg_run(void* const* d_in, float* d_out, unsigned char* ws, hipStream_t st, int stop) {
    float* PN = d_out; float* RN = PN + (size_t)NT * INC; float* CVN = RN + NT * 512; float* CN = CVN + NT * 512; float* MGN = CN + NT * 512; float* ZN = MGN + (size_t)NT * D; float* X1N = ZN + (size_t)NT * D; float* acc = X1N + (size_t)NT * D;
    const float* x = (const float*)d_in[0];
    hipMemsetAsync(acc, 0, 64 * 4, st);
    dbg_proj<<<2048, 256, 0, st>>>(x, (const float*)d_in[1], PN);
    dbg_mix1<<<1024, 256, 0, st>>>(PN, (const float*)d_in[4], RN, CVN);
    dbg_ln<<<NT / 64, 64, 0, st>>>(CVN, 512, (const float*)d_in[5], (const float*)d_in[6], CN, 1);
    dbg_mix3<<<2048, 256, 0, st>>>(PN, RN, CN, (const float*)d_in[2], (const float*)d_in[3], (const float*)d_in[7], MGN);
    dbg_mix4<<<2048, 256, 0, st>>>(MGN, (const float*)d_in[8], x, ZN);
    dbg_ln<<<NT / 64, 64, 0, st>>>(ZN, D, (const float*)d_in[9], (const float*)d_in[10], X1N, 0);
    if (stop <= 4) {
    dbg_cmp<<<256, 256, 0, st>>>(0, ws + WS_U, 0, 512, 512, PN, INC, 0, 0, PN, acc);
    dbg_cmp<<<256, 256, 0, st>>>(1, ws + WS_V, 0, 512, 512, PN, INC, 512, 2, PN, acc);
    dbg_cmp<<<256, 256, 0, st>>>(2, ws + WS_GP, 0, D, D, PN, INC, 1536, 1, PN, acc);
    dbg_cmp<<<256, 256, 0, st>>>(3, ws + WS_GC, 0, D, D, PN, INC, 2560, 1, PN, acc);
    }
    dbg_cmp<<<256, 256, 0, st>>>(4, ws + WS_R, 0, 512, 512, RN, 512, 0, 0, PN, acc);
    dbg_cmp<<<256, 256, 0, st>>>(5, ws + WS_C, 0, 512, 512, CN, 512, 0, 0, PN, acc);
    if (stop >= 7) {
    dbg_cmp<<<256, 256, 0, st>>>(6, ws + WS_MG, 0, D, D, MGN, D, 0, 0, PN, acc);
    dbg_cmp<<<256, 256, 0, st>>>(7, ws + WS_Z, 1, D, D, ZN, D, 0, 0, PN, acc);
    dbg_cmp<<<256, 256, 0, st>>>(8, ws + WS_X1, 0, D, D, X1N, D, 0, 0, PN, acc);
    }
#ifdef DBG_WT
    dbg_cmp_wt<<<256, 256, 0, st>>>(DBG_SHOW, (const unsigned short*)(ws + WS_WIN), (const float*)d_in[1], DBG_WT, acc);
#endif
#ifdef DBG_TILES
    for (int t = 0; t < 4; ++t) dbg_cmp_tile<<<64, 256, 0, st>>>(16 + t, ws + ((DBG_TILES & 2) ? WS_GC : WS_GP), D, (DBG_TILES & 1) * 256, t * 256, PN, INC, ((DBG_TILES & 2) ? 2560 : 1536), acc);
#endif
    hipMemcpyAsync(ws + WS_CTL + 65536, acc, 64 * 4, hipMemcpyDeviceToDevice, st);
    dbg_code<<<1024, 256, 0, st>>>((const float*)(ws + WS_CTL + 65536), 9, d_out, M * D);
}
#endif

#ifndef MK_N_LAUNCHES
#define MK_N_LAUNCHES 1
#endif
constexpr int N_PHASES = 12;
struct Args { const float* in[21]; float* out; unsigned char* ws; int ph_lo, ph_hi; };
__global__ void __launch_bounds__(NTHR, 2) mk_fwd(Args args) {
    extern __shared__ __attribute__((aligned(16))) unsigned char lds[];
    Frame F;
    F.lds = (LAS unsigned char*)lds;
    F.MISC = (volatile LAS unsigned*)(F.lds + MISC_OFF);
    F.wave = __builtin_amdgcn_readfirstlane((int)threadIdx.x >> 6);
    F.G = gridDim.x; { const int bx = blockIdx.x; F.vcu = (F.G % 8 == 0) ? (bx % 8) * (F.G / 8) + bx / 8 : bx; }
    F.ws = args.ws; F.ctl = (gu32*)(args.ws + WS_CTL); F.out = args.out;
#pragma unroll
    for (int i = 0; i < 21; ++i) F.in[i] = args.in[i];
    for (int u = threadIdx.x; u < (LDS_BYTES - TAB_OFF) / 4; u += NTHR) ((LAS unsigned*)(F.lds + TAB_OFF))[u] = 0u;
    __syncthreads();
    const int lo = args.ph_lo, hi = args.ph_hi;
    const bool multi = (hi - lo) > 1;
    XcdBarrier bar; bar.bar = (unsigned*)(F.ctl + CW_BAR); bar.x = 0; bar.st = nullptr;
    if (multi) bar = xcd_barrier_post((unsigned*)(F.ctl + CW_BAR), F.MISC + 8);
#ifndef PH_MASK
#define PH_MASK 0xFFF
#endif
#define IN(k) ((((PH_MASK) >> (k)) & 1) && lo <= (k) && (k) < hi)
#define SEAM(k) do { if (IN(k) && IN((k) + 1)) xcd_barrier(bar); } while (0)
    unsigned char* ws = args.ws;
    LAS unsigned char* ring = F.lds + RING_OFF; LAS unsigned char* entl = F.lds + ENT_OFF;
    const int bx = (int)blockIdx.x;

#ifndef DUP_MASK
#define DUP_MASK 0
#endif
#define DUP(k) ((((DUP_MASK) >> (k)) & 1) != 0)
#define PHASE(k, BODY) do { if (IN(k)) { BODY; if (DUP(k)) { xcd_barrier(bar); BODY; } } SEAM(k); } while (0)
    PHASE(0, p0_prologue(F));
#define P1_BODY { DenseOrder S; S.init((const bf16*)(ws + WS_XB), (const bf16*)(ws + WS_WIN), M, INC, D, D, D, 0, F.G, bx); \
        EpiProj E{(bf16*)(ws + WS_U), (bf16*)(ws + WS_V), (bf16*)(ws + WS_GP), (bf16*)(ws + WS_GC)}; \
        pg8::gemm_phase<EpiProj, DenseOrder>(ring, entl, S, E, F.wave); }
    PHASE(1, P1_BODY);
    PHASE(2, p2_mixer(F));
#define P3_BODY { DenseOrder S; S.init((const bf16*)(ws + WS_R), (const bf16*)(ws + WS_POOL), M, D, 128, PW, 128, 128, F.G, bx); \
        EpiPool E{F.in[3], (const bf16*)(ws + WS_GP), (bf16*)(ws + WS_T1)}; \
        pg8::gemm_phase<EpiPool, DenseOrder>(ring, entl, S, E, F.wave); }
    PHASE(3, P3_BODY);
#define P4_BODY { DenseOrder S; S.init((const bf16*)(ws + WS_C), (const bf16*)(ws + WS_CVO), M, D, CW, CW, CW, 0, F.G, bx); \
        EpiConvOut E{(const bf16*)(ws + WS_T1), (const bf16*)(ws + WS_GC), (bf16*)(ws + WS_MG)}; \
        pg8::gemm_phase<EpiConvOut, DenseOrder>(ring, entl, S, E, F.wave); }
    PHASE(4, P4_BODY);
#define P5_BODY { DenseOrder S; S.init((const bf16*)(ws + WS_MG), (const bf16*)(ws + WS_WOUT), M, D, D, D, D, 0, F.G, bx); \
        EpiWout E{F.in[0], (float*)(ws + WS_Z)}; \
        pg8::gemm_phase<EpiWout, DenseOrder>(ring, entl, S, E, F.wave); }
    PHASE(5, P5_BODY);
    PHASE(6, p6_ln1(F));
#define P7_BODY { DenseOrder S; S.init((const bf16*)(ws + WS_X1), (const bf16*)(ws + WS_RSH), M, 768, D, D, D, 0, F.G, bx); \
        EpiRSh E{(float*)(ws + WS_LOG), (bf16*)(ws + WS_HS)}; \
        pg8::gemm_phase<EpiRSh, DenseOrder>(ring, entl, S, E, F.wave); }
    PHASE(7, P7_BODY);
    if (IN(8)) { p8_route(F);
        { DenseOrder S; S.init((const bf16*)(ws + WS_HS), (const bf16*)(ws + WS_SDN), M, D, EH, EH, EH, 0, F.G, bx);
          EpiSDown E{(bf16*)(ws + WS_YSH)};
          pg8::gemm_phase<EpiSDown, DenseOrder>(ring, entl, S, E, F.wave); } } SEAM(8);
#define P9_BODY { const int tt = expert_table(F); \
        ExpertOrder<true> S; S.A = (const bf16*)(ws + WS_X1); S.Bt = (const bf16*)(ws + WS_EGU); S.lda = D; S.ldb = D; S.nt = D / 64; S.bstride = (size_t)512 * D; \
        S.tstart = (const LAS int*)(F.lds + TAB_OFF); S.cntl = S.tstart + 260; S.list = (const int*)(ws + WS_LIST); S.nN = 2; S.nwg = tt * 2; S.G = F.G; S.c = bx; \
        EpiEGU E{(bf16*)(ws + WS_HE)}; \
        pg8::gemm_phase<EpiEGU, ExpertOrder<true>>(ring, entl, S, E, F.wave); }
    PHASE(9, P9_BODY);
#define P10_BODY { const int tt = expert_table(F); \
        { ExpertOrder<false> S; S.A = (const bf16*)(ws + WS_HE); S.Bt = (const bf16*)(ws + WS_EDN); S.lda = EH; S.ldb = EH; S.nt = EH / 64; S.bstride = (size_t)D * EH; \
          S.tstart = (const LAS int*)(F.lds + TAB_OFF); S.cntl = S.tstart + 260; S.list = (const int*)(ws + WS_LIST); S.nN = 4; S.nwg = tt * 4; S.G = F.G; S.c = bx; \
          EpiEDown E{(bf16*)(ws + WS_Y)}; \
          pg8::gemm_phase<EpiEDown, ExpertOrder<false>>(ring, entl, S, E, F.wave); } }
    PHASE(10, P10_BODY);
    PHASE(11, p11_combine(F));
#undef IN
#undef SEAM
}

extern "C" void kernel_launch(void* const* d_in, const int* in_sizes, int n_in, void* d_out, int out_size, void* d_ws, size_t ws_size, hipStream_t stream) {
    static int grid = 0;
    if (grid == 0) {
        if (n_in != 21 || in_sizes[0] != M * D || out_size != M * D || ws_size < WS_END) { fprintf(stderr, "kernel_launch: unexpected shapes (n_in %d, in0 %d, out %d, ws %zu)\n", n_in, n_in > 0 ? in_sizes[0] : -1, out_size, ws_size); grid = -1; return; }
        int dev = 0, cus = 0;
        if (hipGetDevice(&dev) != hipSuccess || hipDeviceGetAttribute(&cus, hipDeviceAttributeMultiprocessorCount, dev) != hipSuccess) { grid = -1; return; }
        if (hipFuncSetAttribute((const void*)mk_fwd, hipFuncAttributeMaxDynamicSharedMemorySize, LDS_BYTES) != hipSuccess) { fprintf(stderr, "kernel_launch: hipFuncSetAttribute failed\n"); grid = -1; return; }
        (void)hipGetLastError();
        grid = cus;
    }
    if (grid < 0) return;
    (void)hipMemsetAsync((char*)d_ws + WS_CTL, 0, CTL_ZERO_BYTES, stream);
    Args a{};
    for (int i = 0; i < 21; ++i) a.in[i] = (const float*)d_in[i];
    a.out = (float*)d_out; a.ws = (unsigned char*)d_ws;
    constexpr int NL = MK_N_LAUNCHES;
    for (int li = 0; li < NL; ++li) {
        a.ph_lo = (NL == 1) ? 0 : li; a.ph_hi = (NL == 1) ? N_PHASES : li + 1;
        hipLaunchKernelGGL(mk_fwd, dim3(grid), dim3(NTHR), LDS_BYTES, stream, a);
#ifdef DBG_CHECK
        if (a.ph_hi == DBG_CHECK) { dbg_run(d_in, (float*)d_out, (unsigned char*)d_ws, stream, DBG_CHECK); return; }
#endif
    }
}
```

```cpp
#define MK_N_LAUNCHES 1

#include <hip/hip_runtime.h>
#include <cstdio>
#include <cstdint>

namespace pg8 {
#define PG8_LAS __attribute__((address_space(3)))
typedef unsigned short bf16_t;
typedef short bf16x8 __attribute__((ext_vector_type(8)));
typedef float f32x4 __attribute__((ext_vector_type(4)));
typedef float f32x2 __attribute__((ext_vector_type(2)));
typedef unsigned u32x4 __attribute__((ext_vector_type(4)));
typedef unsigned u32x2 __attribute__((ext_vector_type(2)));
typedef int i32x4 __attribute__((ext_vector_type(4)));
typedef int i32x8 __attribute__((ext_vector_type(8)));
constexpr int BM = 256, BK = 64, HALF = 128, HTB = HALF * BK * 2  , STAGE_BYTES = 8 * HTB, NXCD = 8, WGM = 8;

__host__ __device__ __forceinline__ int lds_byte(int r, int c) { const int st = (r >> 4) * 2 + (c >> 5), rr = r & 15, cc = c & 31, ob = rr * 64 + cc * 2; return st * 1024 + (ob ^ (((ob >> 9) & 1) << 5)); }
__host__ __device__ __forceinline__ void stage_rc(int b, int& R, int& C) { const int st = b / 1024, sb = b % 1024, swz = sb ^ (((sb >> 9) & 1) << 5); R = (st >> 1) * 16 + swz / 64; C = (st & 1) * 32 + (swz % 64) / 2; }
__host__ __device__ __forceinline__ int perm32(int rho) { const int n = rho >> 4, i = rho & 15; return 8 * (i >> 2) + 4 * n + (i & 3); }

struct Unit { int pm, pn, e, r0, nrow; };

typedef __bf16 bf16x2_t __attribute__((ext_vector_type(2)));
__device__ __forceinline__ unsigned cvt_pk_bf16(float lo, float hi) { f32x2 v = {lo, hi}; bf16x2_t b = __builtin_convertvector(v, bf16x2_t); return __builtin_bit_cast(unsigned, b); }
__device__ __forceinline__ u32x4 pack8(const f32x4 a, const f32x4 b) { u32x4 w; w.x = cvt_pk_bf16(a[0], a[1]); w.y = cvt_pk_bf16(a[2], a[3]); w.z = cvt_pk_bf16(b[0], b[1]); w.w = cvt_pk_bf16(b[2], b[3]); return w; }
__device__ __forceinline__ float bf_lo(unsigned w) { return __uint_as_float(w << 16); }
__device__ __forceinline__ float bf_hi(unsigned w) { return __uint_as_float(w & 0xffff0000u); }
__device__ __forceinline__ void unpack8(const u32x4 w, f32x4& a, f32x4& b) { a = (f32x4){bf_lo(w.x), bf_hi(w.x), bf_lo(w.y), bf_hi(w.y)}; b = (f32x4){bf_lo(w.z), bf_hi(w.z), bf_lo(w.w), bf_hi(w.w)}; }
__device__ __forceinline__ float sigmoidf_(float x) { return __builtin_amdgcn_rcpf(1.0f + __expf(-x)); }
__device__ __forceinline__ f32x4 sigmoid4(const f32x4 x) { return (f32x4){sigmoidf_(x[0]), sigmoidf_(x[1]), sigmoidf_(x[2]), sigmoidf_(x[3])}; }

template <class Epi, class Sched>
__device__ __forceinline__ void gemm_phase(PG8_LAS unsigned char* lds, PG8_LAS unsigned char* ent, const Sched& S, const Epi& E, int wid_) {
    int lane_; asm volatile("v_mbcnt_lo_u32_b32 %0, -1, 0\n\tv_mbcnt_hi_u32_b32 %0, -1, %0" : "=v"(lane_));
    const int wid = __builtin_amdgcn_readfirstlane(wid_), lane = lane_, tid = wid * 64 + lane, wr = wid >> 2, wc = wid & 3, fr = lane & 15, fq = lane >> 4;
    int nt_ = S.nt; asm volatile("" : "+s"(nt_));
    const int nt = nt_;
    int sR[2], sC[2]; unsigned voffB[2];
#pragma unroll
    for (int i = 0; i < 2; ++i) { int R, C; stage_rc(tid * 16 + i * 8192, R, C); const int Rb = Epi::PERM ? ((R & ~31) + perm32(R & 31)) : R;
        sR[i] = R; sC[i] = C; voffB[i] = (unsigned)(Rb * S.ldbB + C * 2); }
    const size_t kstep = (size_t)(BK * 2);
    const size_t hstepB = (size_t)HALF * S.ldbB;
    const unsigned ldsw = (unsigned)wid * 1024u;
    const int aoff = lds_byte(wr * 64 + fr, fq * 8), boff = lds_byte(wc * 32 + fr, fq * 8);
    PG8_LAS unsigned char* abase = lds + aoff; PG8_LAS unsigned char* bbase = lds + 4 * HTB + boff;
    asm volatile("" : "+v"(abase), "+v"(bbase));
#define PG8_SA(b, h) (((b) * 2 + (h)) * HTB)
#define PG8_SB(b, h) ((4 + (b) * 2 + (h)) * HTB)
#define PG8_STAGE(bufoff, gbase, voff) do { _Pragma("unroll") for (int _i = 0; _i < 2; ++_i) \
        __builtin_amdgcn_global_load_lds((const unsigned*)((const char*)(gbase) + (voff)[_i]), (PG8_LAS unsigned*)(lds + (bufoff) + ldsw + _i * 8192), 16, 0, 0); } while (0)
#define PG8_STAGE_A(bufoff, gbase, nrow_, e_, h) do { _Pragma("unroll") for (int _i = 0; _i < 2; ++_i) \
        __builtin_amdgcn_global_load_lds((const unsigned*)((const char*)(gbase) + S.a_voff((nrow_), (e_), (h) * 128 + sR[_i], sC[_i])), (PG8_LAS unsigned*)(lds + (bufoff) + ldsw + _i * 8192), 16, 0, 0); } while (0)
#define PG8_LD8(p) __builtin_shufflevector(*(const PG8_LAS i32x4*)(p), *(const PG8_LAS i32x4*)((p) + 1024), 0, 1, 2, 3, 4, 5, 6, 7)
#define PG8_LDA(dst, b, h) do { if constexpr (Sched::FP8) { _Pragma("unroll") for (int m = 0; m < 4; ++m) dst##8[m] = PG8_LD8(abase + PG8_SA(b, h) + m * 2048); } \
        else { _Pragma("unroll") for (int m = 0; m < 4; ++m) _Pragma("unroll") for (int k = 0; k < 2; ++k) dst[m][k] = *(const PG8_LAS bf16x8*)(abase + PG8_SA(b, h) + m * 2048 + k * 1024); } } while (0)
#define PG8_LDB(dst, b, h) do { if constexpr (Sched::FP8) { _Pragma("unroll") for (int n = 0; n < 2; ++n) dst##8[n] = PG8_LD8(bbase + PG8_SA(b, h) + n * 2048); } \
        else { _Pragma("unroll") for (int n = 0; n < 2; ++n) _Pragma("unroll") for (int k = 0; k < 2; ++k) dst[n][k] = *(const PG8_LAS bf16x8*)(bbase + PG8_SA(b, h) + n * 2048 + k * 1024); } } while (0)
#define PG8_MMA(ai, bj, At, Bt) do { __builtin_amdgcn_s_setprio(1); \
        if constexpr (Sched::FP8) { _Pragma("unroll") for (int m = 0; m < 4; ++m) _Pragma("unroll") for (int n = 0; n < 2; ++n) \
            asm volatile("v_mfma_scale_f32_16x16x128_f8f6f4 %0, %1, %2, %0, %3, %4 op_sel_hi:[0,0,0]" : "+v"(acc[ai][bj][m][n]) : "v"(Bt##8[n]), "v"(At##8[m]), "v"(scB), "v"(scA)); } \
        else { _Pragma("unroll") for (int m = 0; m < 4; ++m) _Pragma("unroll") for (int n = 0; n < 2; ++n) _Pragma("unroll") for (int k = 0; k < 2; ++k) \
            acc[ai][bj][m][n] = __builtin_amdgcn_mfma_f32_16x16x32_bf16(Bt[n][k], At[m][k], acc[ai][bj][m][n], 0, 0, 0); } \
        __builtin_amdgcn_s_setprio(0); } while (0)
#define PG8_WAIT_V(n) asm volatile("s_waitcnt vmcnt(" #n ")" ::: "memory")
#define PG8_WAIT_L(n) asm volatile("s_waitcnt lgkmcnt(" #n ")" ::: "memory")
#define PG8_BAR __builtin_amdgcn_s_barrier()
#define PG8_SCHED __builtin_amdgcn_sched_barrier(0)
    Unit cur, nxt; int ui = 0;
    if (!S.next(0, cur)) return;
    f32x4 acc[2][2][4][2];
#pragma unroll
    for (int a = 0; a < 2; ++a)
#pragma unroll
        for (int b = 0; b < 2; ++b)
#pragma unroll
            for (int m = 0; m < 4; ++m)
#pragma unroll
                for (int n = 0; n < 2; ++n) acc[a][b][m][n] = (f32x4){0.f, 0.f, 0.f, 0.f};
    const int scA = S.scaleA, scB = S.scaleB;
    bf16x8 At[4][2], B0[2][2], B1[2][2]; i32x8 At8[4], B08[2], B18[2];
    const char* cA = S.a_ptr(cur); const char* cB = S.b_ptr(cur);
    if constexpr (Sched::META) {
        S.meta_issue(cur, ent, wid, lane); if (S.next(1, nxt)) S.meta_issue(nxt, ent + 2048, wid, lane);
        PG8_WAIT_V(0); PG8_BAR;
    }
    PG8_STAGE(PG8_SB(0, 0), cB, voffB); PG8_STAGE(PG8_SB(0, 1), cB + hstepB, voffB); PG8_STAGE_A(PG8_SA(0, 0), cA, cur.nrow, ent, 0); PG8_STAGE_A(PG8_SA(0, 1), cA, cur.nrow, ent, 1);
    if (wr == 1) PG8_BAR;
    PG8_WAIT_V(2); PG8_BAR;
    PG8_STAGE(PG8_SB(1, 0), cB + kstep, voffB); PG8_STAGE_A(PG8_SA(1, 0), cA + kstep, cur.nrow, ent, 0); PG8_STAGE(PG8_SB(1, 1), cB + hstepB + kstep, voffB);
    PG8_WAIT_V(6); PG8_BAR;
    for (;;) {
        const bool has_next = S.next(ui + 1, nxt);
        const char* nA = cA; const char* nB = cB; int nnrow = cur.nrow; PG8_LAS unsigned char* const cent = ent + (ui & 3) * 2048; PG8_LAS unsigned char* nent = cent;
        if (has_next) { nA = S.a_ptr(nxt); nB = S.b_ptr(nxt); nnrow = nxt.nrow; nent = ent + ((ui + 1) & 3) * 2048; }
        if constexpr (Sched::META) { Unit u2; if (S.next(ui + 2, u2)) S.meta_issue(u2, ent + ((ui + 2) & 3) * 2048, wid, lane); }
        for (int t = 0; t < nt; t += 2) {
            const bool last = (t == nt - 2);
            const char* a1 = cA + (size_t)(t + 1) * kstep;
            const char* a2 = last ? nA : cA + (size_t)(t + 2) * kstep; const char* b2 = last ? nB : cB + (size_t)(t + 2) * kstep;
            const char* a3 = a2 + kstep; const char* b3 = b2 + kstep;
            const int xnrow = last ? nnrow : cur.nrow; PG8_LAS unsigned char* const xent = last ? nent : cent;
            PG8_LDB(B0, 0, 0); PG8_LDB(B1, 0, 1); PG8_SCHED; PG8_LDA(At, 0, 0); PG8_STAGE_A(PG8_SA(1, 1), a1, cur.nrow, cent, 1);
            PG8_WAIT_V(8); PG8_WAIT_L(0); PG8_BAR; PG8_MMA(0, 0, At, B0); PG8_MMA(0, 1, At, B1); PG8_BAR; PG8_SCHED;
            PG8_LDA(At, 0, 1); PG8_STAGE(PG8_SB(0, 0), b2, voffB); PG8_STAGE(PG8_SB(0, 1), b2 + hstepB, voffB); PG8_STAGE_A(PG8_SA(0, 0), a2, xnrow, xent, 0);
            PG8_WAIT_V(8); PG8_WAIT_L(0); PG8_BAR; PG8_MMA(1, 0, At, B0); PG8_MMA(1, 1, At, B1); PG8_BAR; PG8_SCHED;
            PG8_LDB(B0, 1, 0); PG8_LDB(B1, 1, 1); PG8_SCHED; PG8_LDA(At, 1, 0); PG8_STAGE_A(PG8_SA(0, 1), a2, xnrow, xent, 1);
            PG8_WAIT_V(8); PG8_WAIT_L(0); PG8_BAR; PG8_MMA(0, 0, At, B0); PG8_MMA(0, 1, At, B1); PG8_BAR; PG8_SCHED;
            PG8_LDA(At, 1, 1); PG8_STAGE(PG8_SB(1, 0), b3, voffB); PG8_STAGE(PG8_SB(1, 1), b3 + hstepB, voffB); PG8_STAGE_A(PG8_SA(1, 0), a3, xnrow, xent, 0);
            PG8_WAIT_V(8); PG8_WAIT_L(0); PG8_BAR; PG8_MMA(1, 0, At, B0); PG8_MMA(1, 1, At, B1); PG8_BAR; PG8_SCHED;
        }
        if (wr == 0) PG8_BAR;
        if constexpr (Sched::FP8) asm volatile("s_nop 15\n\ts_nop 15" ::: "memory");
        E(acc, cur, wr, wc, fr, fq, cent);
        if (!has_next) break;
#pragma unroll
        for (int a = 0; a < 2; ++a)
#pragma unroll
            for (int b = 0; b < 2; ++b)
#pragma unroll
                for (int m = 0; m < 4; ++m)
#pragma unroll
                    for (int n = 0; n < 2; ++n) acc[a][b][m][n] = (f32x4){0.f, 0.f, 0.f, 0.f};
        cur = nxt; cA = nA; cB = nB; ++ui;
        if (wr == 1) PG8_BAR;
    }
    PG8_WAIT_V(0);
    PG8_BAR;
#undef PG8_SA
#undef PG8_SB
#undef PG8_STAGE
#undef PG8_STAGE_A
#undef PG8_LDA
#undef PG8_LDB
#undef PG8_MMA
#undef PG8_WAIT_V
#undef PG8_WAIT_L
#undef PG8_BAR
#undef PG8_SCHED
}
}

constexpr int NWAVES = 8, NTHR = NWAVES * 64;
constexpr int D = 1024, BATCH = 4, SEQ = 8192, M = BATCH * SEQ;
constexpr int PW = 512, CW = 512, CK = 31, INC = 3584;
constexpr int NE = 256, TOPK = 8, NG = 8, EH = 256;
constexpr int ECAP = M;
constexpr int MAXT = (M * TOPK) / 256 + NE;
constexpr float XSCALE = 16.f, WSCALE = 128.f, HSCALE = 8.f, YSCALE = 64.f;
constexpr int E8_X = 0x7b7b7b7b, E8_W = 0x78787878, E8_H = 0x7c7c7c7c;
constexpr float LN_EPS = 1e-5f, ALPHA = 1.189207115002721f  , RSCALE = 2.5f;

constexpr size_t MiB = 1u << 20;
constexpr size_t WS_CTL = 0, CTL_ZERO_BYTES = 1 * MiB;
constexpr size_t WS_WIN = 1 * MiB;
constexpr size_t WS_POOL = 8 * MiB;
constexpr size_t WS_CVO = 8 * MiB + 512 * 1024;
constexpr size_t WS_WOUT = 10 * MiB;
constexpr size_t WS_RSH = 12 * MiB;
constexpr size_t WS_SDN = 14 * MiB;
constexpr size_t WS_EDN = 16 * MiB;
constexpr size_t WS_X18 = 96 * MiB;
constexpr size_t WS_X1 = 144 * MiB;
constexpr size_t WS_HS = 208 * MiB;
constexpr size_t WS_LIST = 224 * MiB;
constexpr size_t WS_HE = 288 * MiB;
constexpr size_t WS_EGU = 448 * MiB;
constexpr size_t WS_PH = 704 * MiB;
constexpr size_t WS_XB = WS_PH;
constexpr size_t WS_U = WS_PH + 64 * MiB, WS_V = WS_PH + 96 * MiB;
constexpr size_t WS_GP = WS_PH + 128 * MiB, WS_GC = WS_PH + 192 * MiB;
constexpr size_t WS_R = WS_PH + 256 * MiB, WS_C = WS_PH + 288 * MiB;
constexpr size_t WS_T1 = WS_XB;
constexpr size_t WS_MG = WS_U;
constexpr size_t WS_Z = WS_GP;
constexpr size_t WS_LOG = WS_HE;
constexpr size_t WS_END = 1024 * MiB;
constexpr size_t WS_Y = WS_EGU;
static_assert(WS_Y + (size_t)M * 8 * D * 2 <= WS_R, "Y slots end before R");
constexpr size_t WS_YSH = WS_R;
static_assert(WS_YSH + (size_t)M * D * 2 <= WS_END, "ws map");
static_assert(WS_HE + (size_t)MAXT * 256 * EH * 2 <= WS_EGU, "HE fits");
static_assert(WS_LIST + (size_t)NE * ECAP * 8 <= WS_HE, "LIST fits");

constexpr int CW_CNT = 1024;
constexpr int CW_BAR = 4096;

constexpr int RING_OFF = 0, RING_BYTES = 131072;
constexpr int TAB_OFF = RING_BYTES;
constexpr int ENT_OFF = TAB_OFF + 4096;
constexpr int MISC_OFF = ENT_OFF + 8192;
constexpr int LDS_BYTES = 147456;
static_assert(MISC_OFF + 128 <= LDS_BYTES, "LDS map");

#define GAS __attribute__((address_space(1)))
#define LAS __attribute__((address_space(3)))
typedef unsigned short bf16;
typedef unsigned v4u __attribute__((ext_vector_type(4)));
typedef unsigned v2u __attribute__((ext_vector_type(2)));
typedef float f32x4 __attribute__((ext_vector_type(4)));
typedef GAS unsigned gu32;
#define RLX_AGENT __ATOMIC_RELAXED, __HIP_MEMORY_SCOPE_AGENT
#define LDS_WAIT() asm volatile("s_waitcnt lgkmcnt(0)" ::: "memory")
#define VM_WAIT() asm volatile("s_waitcnt vmcnt(0)" ::: "memory")
__device__ __forceinline__ unsigned f2bf(float f) { unsigned u = __builtin_bit_cast(unsigned, f); return (u + 0x7fffu + ((u >> 16) & 1u)) >> 16; }
__device__ __forceinline__ unsigned pk2(float lo, float hi) { return pg8::cvt_pk_bf16(lo, hi); }

#define XB_TMO      128
#define XB_XCNT(j)  (256  + 64 * (j))
#define XB_XSUB(j)  (1280 + 64 * (j))
#define XB_XGEN(j)  (2304 + 64 * (j))
#define XB_TOP      3328
#define XB_TOPGEN   3392
#define XCD_BAR_WORDS 3456
#define XB_SPIN_CAP (1u << 20)
__device__ __forceinline__ unsigned xb_ld(unsigned* p)              { return __hip_atomic_load(p, __ATOMIC_RELAXED, __HIP_MEMORY_SCOPE_AGENT); }
__device__ __forceinline__ unsigned xb_add(unsigned* p, unsigned v) { return __hip_atomic_fetch_add(p, v, __ATOMIC_RELAXED, __HIP_MEMORY_SCOPE_AGENT); }
__device__ __forceinline__ unsigned xb_xcc_id() { return (unsigned)__builtin_amdgcn_s_getreg((3 << 11) | 20) & 0xFu; }
#define XB_SPIN(cond, bar) do { unsigned _sp = 0; while (cond) { __builtin_amdgcn_s_sleep(1); \
    if ((++_sp & 255u) == 0u) { if (xb_ld(&(bar)[XB_TMO])) break; if (_sp > XB_SPIN_CAP) { atomicAdd(&(bar)[XB_TMO], 1u); break; } } } } while (0)
struct XcdBarrier { unsigned* bar; unsigned x; volatile LAS unsigned* st; };
__device__ __forceinline__ XcdBarrier xcd_barrier_post(unsigned* bar, volatile LAS unsigned* st) {
    XcdBarrier b; b.bar = bar; b.x = xb_xcc_id(); b.st = st;
    if (threadIdx.x == 0) (void)xb_add(&bar[XB_XCNT(b.x)], 1u);
    return b;
}
__device__ __forceinline__ void xcd_barrier_complete(unsigned* bar, unsigned x, unsigned& nloc, unsigned& nx) {
    const unsigned G = gridDim.x * gridDim.y * gridDim.z;
    unsigned sum, cnt, mine, sp = 0u;
    for (;;) {
        sum = 0u; cnt = 0u; mine = 0u;
#pragma unroll
        for (unsigned j = 0; j < 16; ++j) { const unsigned c = xb_ld(&bar[XB_XCNT(j)]); sum += c; cnt += (c > 0u) ? 1u : 0u; mine = (j == x) ? c : mine; }
        if (sum == G) break;
        __builtin_amdgcn_s_sleep(1);
        if ((++sp & 255u) == 0u) { if (xb_ld(&bar[XB_TMO])) break; if (sp > XB_SPIN_CAP) { atomicAdd(&bar[XB_TMO], 1u); break; } }
    }
    nloc = mine > 0u ? mine : 1u; nx = cnt > 0u ? cnt : 1u;
}
__device__ __forceinline__ int lane_id();
__device__ __forceinline__ void xcd_barrier(const XcdBarrier& b, int wave) {
    asm volatile("s_waitcnt vmcnt(0)" ::: "memory");
    __syncthreads();
    if (wave == 0 && lane_id() == 0) {
        unsigned* bar = b.bar;
        __builtin_amdgcn_s_waitcnt(0);
        unsigned nloc = b.st[0], nx = b.st[1];
        if (nloc == 0u) { xcd_barrier_complete(bar, b.x, nloc, nx); b.st[0] = nloc; b.st[1] = nx; }
        const unsigned old = xb_add(&bar[XB_XSUB(b.x)], 1u);
        const unsigned gen = old / nloc;
        if (old + 1u == (gen + 1u) * nloc) {
            __builtin_amdgcn_fence(__ATOMIC_RELEASE, "agent");
            asm volatile("s_waitcnt vmcnt(0)" ::: "memory");
            const unsigned og = xb_add(&bar[XB_TOP], 1u);
            const unsigned tg = og / nx;
            if (og + 1u == (tg + 1u) * nx) xb_add(&bar[XB_TOPGEN], 1u);
            else XB_SPIN(xb_ld(&bar[XB_TOPGEN]) == tg, bar);
            __builtin_amdgcn_fence(__ATOMIC_ACQUIRE, "agent");
            xb_add(&bar[XB_XGEN(b.x)], 1u);
            asm volatile("s_waitcnt vmcnt(0)" ::: "memory");
        } else {
            XB_SPIN(xb_ld(&bar[XB_XGEN(b.x)]) == gen, bar);
            __builtin_amdgcn_fence(__ATOMIC_ACQUIRE, "agent");
            asm volatile("s_waitcnt vmcnt(0)" ::: "memory");
        }
    }
    __syncthreads();
}

struct Frame {
    LAS unsigned char* lds;
    volatile LAS unsigned* MISC;
    gu32* ctl;
    int wave;
    int vcu, G;
    const float* in[21]; float* out; unsigned char* ws;
};
__device__ __forceinline__ int lane_id() { int l; asm volatile("v_mbcnt_lo_u32_b32 %0, -1, 0\n\tv_mbcnt_hi_u32_b32 %0, -1, %0" : "=v"(l)); return l; }
__device__ __forceinline__ float wave_sum(float v) {
#pragma unroll
    for (int o = 1; o < 64; o <<= 1) v += __shfl_xor(v, o);
    return v;
}

__host__ __device__ __forceinline__ int xcd_chunk(int L, int nwg) {
    const int q = nwg / 8, r = nwg % 8, xcd = L % 8, off = L / 8;
    return (xcd < r ? xcd * (q + 1) : r * (q + 1) + (xcd - r) * q) + off;
}
struct DenseOrder {   static constexpr bool META = false, FP8 = false;
    const bf16* A; const bf16* Bt; int ldaB, ldbB, nt, acol_pn; int scaleA, scaleB;
    int nM, nN, nwg, G, c;
    __device__ __forceinline__ void init(const bf16* A_, const bf16* Bt_, int Mr, int N, int K, int lda_, int ldb_, int acol_pn_, int G_, int c_) {
        A = A_; Bt = Bt_; ldaB = lda_ * 2; ldbB = ldb_ * 2; nt = K / 64; acol_pn = acol_pn_; nM = Mr / 256; nN = N / 256; nwg = nM * nN; G = G_; c = c_; scaleA = 0; scaleB = 0; }
    __device__ __forceinline__ bool next(int i, pg8::Unit& u) const {
        const int L = i * G + c; if (L >= nwg) return false;
        const int wgid = xcd_chunk(L, nwg);
        const int nig = 8 * nN, gid = wgid / nig, fm = gid * 8, gsz = (nM - fm) < 8 ? (nM - fm) : 8;
        u.pm = fm + ((wgid % nig) % gsz); u.pn = (wgid % nig) / gsz; u.e = 0; u.r0 = 0; u.nrow = 256; return true;
    }
    __device__ __forceinline__ const char* a_ptr(const pg8::Unit& u) const { return (const char*)A + (size_t)u.pm * 256 * ldaB + u.pn * acol_pn * 2; }
    __device__ __forceinline__ const char* b_ptr(const pg8::Unit& u) const { return (const char*)Bt + (size_t)u.pn * 256 * ldbB; }
    __device__ __forceinline__ unsigned a_voff(int, const LAS unsigned char*, int rl, int C) const { return (unsigned)(rl * ldaB + C * 2); }
};
template <bool GATHER> struct ExpertOrder {
    static constexpr bool META = true, FP8 = true;
    const unsigned char* A; const unsigned char* Bt; int ldaB, ldbB, nt; size_t bstride;
    int scaleA, scaleB;
    const LAS int* tstart; const LAS int* cntl; const int* list;
    int nN, nwg, G, c;
    __device__ __forceinline__ bool next(int i, pg8::Unit& u) const {
        const int L = i * G + c; if (L >= nwg) return false;
        const int wgid = xcd_chunk(L, nwg);
        const int t = wgid / nN; u.pn = wgid % nN; u.pm = t;
        int lo = 0, hi = NE;
#pragma unroll
        for (int s = 0; s < 8; ++s) { const int mid = (lo + hi) >> 1; if (tstart[mid] <= t) lo = mid; else hi = mid; }
        u.e = lo; u.r0 = (t - tstart[lo]) * 256; u.nrow = cntl[lo] - u.r0; return true;
    }
    __device__ __forceinline__ const char* a_ptr(const pg8::Unit& u) const { return GATHER ? (const char*)A : (const char*)A + (size_t)u.pm * 256 * ldaB; }
    __device__ __forceinline__ const char* b_ptr(const pg8::Unit& u) const { return (const char*)Bt + (size_t)u.e * bstride + (size_t)u.pn * 256 * ldbB; }
    __device__ __forceinline__ void meta_issue(const pg8::Unit& u, LAS unsigned char* dst, int wid, int lane) const {
        const char* src = (const char*)(list + ((size_t)u.e * ECAP + u.r0) * 2) + wid * 256 + lane * 4;
        __builtin_amdgcn_global_load_lds((const unsigned*)src, (LAS unsigned*)(dst + wid * 256), 4, 0, 0);
    }
    __device__ __forceinline__ unsigned a_voff(int nrow, const LAS unsigned char* ent, int rl, int C) const {
        if (GATHER) { int slot = *(const volatile LAS int*)(ent + rl * 8); if (rl >= nrow) slot = 0; return (unsigned)((slot >> 3) * ldaB + C * 2); }
        return (unsigned)(rl * ldaB + C * 2);
    }
};

using pg8::f32x4; using pg8::u32x4; using pg8::pack8; using pg8::unpack8; using pg8::sigmoid4;
#define EPI_ROWS_BEGIN _Pragma("unroll") for (int ai = 0; ai < 2; ++ai) _Pragma("unroll") for (int m = 0; m < 4; ++m) { const int row = u.pm * 256 + ai * 128 + wr * 64 + m * 16 + fr;
#define EPI_ROWS_END }
#define UNROLL _Pragma("unroll")
typedef const pg8::f32x4 (&AccRef)[2][2][4][2];
__device__ __forceinline__ v2u pack8_fp8(f32x4 a, f32x4 b) {
    UNROLL for (int i = 0; i < 4; ++i) { a[i] = fminf(fmaxf(a[i], -448.f), 448.f); b[i] = fminf(fmaxf(b[i], -448.f), 448.f); }
    int p0 = __builtin_amdgcn_cvt_pk_fp8_f32(a[0], a[1], 0, false); p0 = __builtin_amdgcn_cvt_pk_fp8_f32(a[2], a[3], p0, true);
    int p1 = __builtin_amdgcn_cvt_pk_fp8_f32(b[0], b[1], 0, false); p1 = __builtin_amdgcn_cvt_pk_fp8_f32(b[2], b[3], p1, true);
    v2u r; r.x = (unsigned)p0; r.y = (unsigned)p1; return r; }
__device__ __forceinline__ f32x4 unpack4_fp8(unsigned w) { const auto lo = __builtin_amdgcn_cvt_pk_f32_fp8((int)w, false), hi = __builtin_amdgcn_cvt_pk_f32_fp8((int)w, true); return (f32x4){lo[0], lo[1], hi[0], hi[1]}; }
struct EpiProj { static constexpr bool PERM = true; bf16 *U, *V, *GP, *GC;
    __device__ __forceinline__ void operator()(AccRef acc, const pg8::Unit& u, int wr, int wc, int fr, int fq, const LAS unsigned char* ent) const {
        const int cb = wc * 32 + 8 * fq;
        if (u.pn < 2) {
            EPI_ROWS_BEGIN
                bf16* p = U + (size_t)row * PW + u.pn * 256 + cb;
                UNROLL for (int bj = 0; bj < 2; ++bj) *(u32x4*)(p + bj * 128) = pack8(acc[ai][bj][m][0], acc[ai][bj][m][1]);
            EPI_ROWS_END
        } else if (u.pn < 6) {
            const int j = u.pn - 2;
            EPI_ROWS_BEGIN
                bf16* p = V + (size_t)row * CW + j * 128 + cb;
                *(u32x4*)p = pack8(acc[ai][0][m][0] * sigmoid4(acc[ai][1][m][0]), acc[ai][0][m][1] * sigmoid4(acc[ai][1][m][1]));
            EPI_ROWS_END
        } else {
            bf16* Gt = (u.pn < 10) ? GP : GC; const int t = (u.pn - 6) & 3;
            EPI_ROWS_BEGIN
                bf16* p = Gt + (size_t)row * D + t * 256 + cb;
                UNROLL for (int bj = 0; bj < 2; ++bj) *(u32x4*)(p + bj * 128) = pack8(sigmoid4(acc[ai][bj][m][0]), sigmoid4(acc[ai][bj][m][1]));
            EPI_ROWS_END
        }
    }
};
struct EpiPool { static constexpr bool PERM = true; const float* scale; const bf16* GP; bf16* T1;
    __device__ __forceinline__ void operator()(AccRef acc, const pg8::Unit& u, int wr, int wc, int fr, int fq, const LAS unsigned char* ent) const {
        const int c0 = u.pn * 256 + wc * 32 + 8 * fq; const int row0 = u.pm * 256 + wr * 64 + fr;
        UNROLL for (int bj = 0; bj < 2; ++bj) {
            const f32x4 sc0 = *(const f32x4*)(scale + c0 + bj * 128), sc1 = *(const f32x4*)(scale + c0 + bj * 128 + 4);
            u32x4 g[2][4];
            UNROLL for (int ai = 0; ai < 2; ++ai) UNROLL for (int m = 0; m < 4; ++m) g[ai][m] = *(const u32x4*)(GP + (size_t)(row0 + ai * 128 + m * 16) * D + c0 + bj * 128);
            UNROLL for (int ai = 0; ai < 2; ++ai) UNROLL for (int m = 0; m < 4; ++m) { f32x4 g0, g1; unpack8(g[ai][m], g0, g1);
                *(u32x4*)(T1 + (size_t)(row0 + ai * 128 + m * 16) * D + c0 + bj * 128) = pack8(acc[ai][bj][m][0] * sc0 * g0, acc[ai][bj][m][1] * sc1 * g1); }
        }
    }
};
struct EpiConvOut { static constexpr bool PERM = true; const bf16* T1; const bf16* GC; bf16* MG;
    __device__ __forceinline__ void operator()(AccRef acc, const pg8::Unit& u, int wr, int wc, int fr, int fq, const LAS unsigned char* ent) const {
        const int c0 = u.pn * 256 + wc * 32 + 8 * fq; const int row0 = u.pm * 256 + wr * 64 + fr;
        UNROLL for (int bj = 0; bj < 2; ++bj)
            UNROLL for (int ai = 0; ai < 2; ++ai) {
                u32x4 g[4], t[4];
                UNROLL for (int m = 0; m < 4; ++m) { const size_t o = (size_t)(row0 + ai * 128 + m * 16) * D + c0 + bj * 128; g[m] = *(const u32x4*)(GC + o); t[m] = *(const u32x4*)(T1 + o); }
                UNROLL for (int m = 0; m < 4; ++m) { const size_t o = (size_t)(row0 + ai * 128 + m * 16) * D + c0 + bj * 128; f32x4 g0, g1, t0, t1; unpack8(g[m], g0, g1); unpack8(t[m], t0, t1);
                    *(u32x4*)(MG + o) = pack8(t0 + acc[ai][bj][m][0] * g0, t1 + acc[ai][bj][m][1] * g1); }
                asm volatile("" ::: "memory");
            }
    }
};
struct EpiWout { static constexpr bool PERM = true; const float* X; float* Z;
    __device__ __forceinline__ void operator()(AccRef acc, const pg8::Unit& u, int wr, int wc, int fr, int fq, const LAS unsigned char* ent) const {
        const int c0 = u.pn * 256 + wc * 32 + 8 * fq; const int row0 = u.pm * 256 + wr * 64 + fr;
        UNROLL for (int bj = 0; bj < 2; ++bj)
            UNROLL for (int ai = 0; ai < 2; ++ai) {
                f32x4 x0[4], x1[4];
                UNROLL for (int m = 0; m < 4; ++m) { const size_t o = (size_t)(row0 + ai * 128 + m * 16) * D + c0 + bj * 128; x0[m] = *(const f32x4*)(X + o); x1[m] = *(const f32x4*)(X + o + 4); }
                UNROLL for (int m = 0; m < 4; ++m) { const size_t o = (size_t)(row0 + ai * 128 + m * 16) * D + c0 + bj * 128;
                    *(f32x4*)(Z + o) = x0[m] * ALPHA + acc[ai][bj][m][0]; *(f32x4*)(Z + o + 4) = x1[m] * ALPHA + acc[ai][bj][m][1]; }
                asm volatile("" ::: "memory");
            }
    }
};
__device__ __forceinline__ f32x4 silu_mul4(const f32x4 g, const f32x4 v) { return g * sigmoid4(g) * v; }
struct EpiRSh { static constexpr bool PERM = true; float* LOG; bf16* HS;
    __device__ __forceinline__ void operator()(AccRef acc, const pg8::Unit& u, int wr, int wc, int fr, int fq, const LAS unsigned char* ent) const {
        const int cb = wc * 32 + 8 * fq;
        if (u.pn == 0) {
            EPI_ROWS_BEGIN
                float* p = LOG + (size_t)row * NE + cb;
                UNROLL for (int bj = 0; bj < 2; ++bj) { *(f32x4*)(p + bj * 128) = acc[ai][bj][m][0]; *(f32x4*)(p + bj * 128 + 4) = acc[ai][bj][m][1]; }
            EPI_ROWS_END
        } else {
            const int j = u.pn - 1;
            EPI_ROWS_BEGIN
                bf16* p = HS + (size_t)row * EH + j * 128 + cb;
                *(u32x4*)p = pack8(silu_mul4(acc[ai][0][m][0], acc[ai][1][m][0]), silu_mul4(acc[ai][0][m][1], acc[ai][1][m][1]));
            EPI_ROWS_END
        }
    }
};
struct EpiEGU { static constexpr bool PERM = true; unsigned char* HE;
    __device__ __forceinline__ void operator()(AccRef acc, const pg8::Unit& u, int wr, int wc, int fr, int fq, const LAS unsigned char* ent) const {
        const int cb = wc * 32 + 8 * fq;
        EPI_ROWS_BEGIN
            unsigned char* p = HE + (size_t)row * EH + u.pn * 128 + cb;
            *(v2u*)p = pack8_fp8(silu_mul4(acc[ai][0][m][0], acc[ai][1][m][0]) * HSCALE, silu_mul4(acc[ai][0][m][1], acc[ai][1][m][1]) * HSCALE);
        EPI_ROWS_END
    }
};
struct EpiEDown { static constexpr bool PERM = true; unsigned char* Y;
    __device__ __forceinline__ void operator()(AccRef acc, const pg8::Unit& u, int wr, int wc, int fr, int fq, const LAS unsigned char* ent) const {
        const unsigned cbyte = (unsigned)(u.pn * 256 + wc * 32 + 8 * fq);
        UNROLL for (int ai = 0; ai < 2; ++ai)
            UNROLL for (int m = 0; m < 4; ++m) { const int rl = ai * 128 + wr * 64 + m * 16 + fr;
                if (rl < u.nrow) { const v2u e2 = *(const LAS v2u*)(ent + rl * 8); const float w = __uint_as_float(e2.y) * YSCALE;
                    const unsigned off = e2.x * (unsigned)D + cbyte;
                    UNROLL for (int bj = 0; bj < 2; ++bj) *(v2u*)(Y + off + bj * 128) = pack8_fp8(acc[ai][bj][m][0] * w, acc[ai][bj][m][1] * w); }
                asm volatile("" ::: "memory"); }
    }
};
struct EpiSDown { static constexpr bool PERM = true; bf16* YS;
    __device__ __forceinline__ void operator()(AccRef acc, const pg8::Unit& u, int wr, int wc, int fr, int fq, const LAS unsigned char* ent) const {
        const int c0 = u.pn * 256 + wc * 32 + 8 * fq;
        EPI_ROWS_BEGIN
            bf16* p = YS + (size_t)row * D + c0;
            UNROLL for (int bj = 0; bj < 2; ++bj) *(u32x4*)(p + bj * 128) = pack8(acc[ai][bj][m][0], acc[ai][bj][m][1]);
        EPI_ROWS_END
    }
};

__device__ __forceinline__ void p0_item(const float* W, int N, bf16* WT, int ldw, int k0, int n0, int drow0, LAS float* scr, int lane) {
#pragma unroll 8
    for (int i = 0; i < 32; ++i) { const int kk = 2 * i + (lane >> 5); scr[kk * 33 + (lane & 31)] = W[(size_t)(k0 + kk) * N + n0 + (lane & 31)]; }
    LDS_WAIT(); asm volatile("" ::: "memory");
    const int c = lane & 7;
#pragma unroll
    for (int j = 0; j < 4; ++j) { const int n = (lane >> 3) + 8 * j; const LAS float* s = scr + (8 * c) * 33 + n;
        v4u o; o.x = pk2(s[0 * 33], s[1 * 33]); o.y = pk2(s[2 * 33], s[3 * 33]); o.z = pk2(s[4 * 33], s[5 * 33]); o.w = pk2(s[6 * 33], s[7 * 33]);
        *(GAS v4u*)(WT + (size_t)(drow0 + n) * ldw + k0 + 8 * c) = o; }
    LDS_WAIT(); asm volatile("" ::: "memory");
}
__device__ __forceinline__ void p0_item_fp8(const float* W, int N, unsigned char* WT, int ldw, int k0, int n0, int drow0, LAS float* scr, int lane) {
#pragma unroll 8
    for (int i = 0; i < 32; ++i) { const int kk = 2 * i + (lane >> 5); scr[kk * 33 + (lane & 31)] = W[(size_t)(k0 + kk) * N + n0 + (lane & 31)]; }
    LDS_WAIT(); asm volatile("" ::: "memory");
    const int c = lane & 3;
#pragma unroll
    for (int j = 0; j < 2; ++j) { const int n = (lane >> 2) + 16 * j; const LAS float* s = scr + (16 * c) * 33 + n;
        f32x4 a, b, c2, d;
        a = (f32x4){s[0 * 33], s[1 * 33], s[2 * 33], s[3 * 33]} * WSCALE; b = (f32x4){s[4 * 33], s[5 * 33], s[6 * 33], s[7 * 33]} * WSCALE;
        c2 = (f32x4){s[8 * 33], s[9 * 33], s[10 * 33], s[11 * 33]} * WSCALE; d = (f32x4){s[12 * 33], s[13 * 33], s[14 * 33], s[15 * 33]} * WSCALE;
        const v2u lo = pack8_fp8(a, b), hi = pack8_fp8(c2, d); v4u o; o.x = lo.x; o.y = lo.y; o.z = hi.x; o.w = hi.y;
        *(GAS v4u*)(WT + (size_t)(drow0 + n) * ldw + k0 + 16 * c) = o; }
    LDS_WAIT(); asm volatile("" ::: "memory");
}
__device__ __forceinline__ int win_row(int n0) {
    if (n0 < 512) return n0;
    if (n0 < 1024) { const int q = n0 - 512; return 512 + (q >> 7) * 256 + (q & 127); }
    if (n0 < 1536) { const int q = n0 - 1024; return 512 + (q >> 7) * 256 + 128 + (q & 127); }
    return n0;
}
__device__ __forceinline__ int gu_row(int n0, int up) { return (n0 >> 7) * 256 + up * 128 + (n0 & 127); }
__device__ __forceinline__ void p0_prologue(Frame& F) {
    LAS float* scr = (LAS float*)(F.lds + RING_OFF + F.wave * 16384);
    const int lane = lane_id(), tid = F.wave * 64 + lane;
    const int gw = F.vcu * NWAVES + F.wave, NGW = F.G * NWAVES;
    unsigned char* ws = F.ws;
    constexpr int I_WIN = 16 * 112, I_POOL = 4 * 16, I_CVO = 8 * 32, I_WOUT = 16 * 32, I_RT = 16 * 8, I_SG = 128, I_SU = 128, I_SD = 4 * 32, I_EG = NE * 128, I_EU = NE * 128, I_ED = NE * 128;
    constexpr int NITEMS = I_WIN + I_POOL + I_CVO + I_WOUT + I_RT + I_SG + I_SU + I_SD + I_EG + I_EU + I_ED;
    for (int it = gw; it < NITEMS; it += NGW) {
        int r = it;
        if (r < I_EG) { const int e = r >> 7, rr = r & 127, kb = rr >> 3, nb = rr & 7;
            p0_item_fp8(F.in[13] + (size_t)e * D * EH, EH, ws + WS_EGU + (size_t)e * 512 * D, D, 64 * kb, 32 * nb, gu_row(32 * nb, 0), scr, lane); continue; } r -= I_EG;
        if (r < I_EU) { const int e = r >> 7, rr = r & 127, kb = rr >> 3, nb = rr & 7;
            p0_item_fp8(F.in[14] + (size_t)e * D * EH, EH, ws + WS_EGU + (size_t)e * 512 * D, D, 64 * kb, 32 * nb, gu_row(32 * nb, 1), scr, lane); continue; } r -= I_EU;
        if (r < I_ED) { const int e = r >> 7, rr = r & 127, kb = rr >> 5, nb = rr & 31;
            p0_item_fp8(F.in[15] + (size_t)e * EH * D, D, ws + WS_EDN + (size_t)e * D * EH, EH, 64 * kb, 32 * nb, 32 * nb, scr, lane); continue; } r -= I_ED;
        if (r < I_WIN) { const int kb = r / 112, nb = r % 112; p0_item(F.in[1], INC, (bf16*)(ws + WS_WIN), D, 64 * kb, 32 * nb, win_row(32 * nb), scr, lane); continue; } r -= I_WIN;
        if (r < I_POOL) { const int g = r >> 4, rr = r & 15, kb = rr >> 3, nb = rr & 7;
            p0_item(F.in[2] + (size_t)g * 128 * 256, 256, (bf16*)(ws + WS_POOL) + (size_t)g * 256 * 128, 128, 64 * kb, 32 * nb, 32 * nb, scr, lane); continue; } r -= I_POOL;
        if (r < I_CVO) { const int kb = r >> 5, nb = r & 31; p0_item(F.in[7], D, (bf16*)(ws + WS_CVO), CW, 64 * kb, 32 * nb, 32 * nb, scr, lane); continue; } r -= I_CVO;
        if (r < I_WOUT) { const int kb = r >> 5, nb = r & 31; p0_item(F.in[8], D, (bf16*)(ws + WS_WOUT), D, 64 * kb, 32 * nb, 32 * nb, scr, lane); continue; } r -= I_WOUT;
        if (r < I_RT) { const int kb = r >> 3, nb = r & 7; p0_item(F.in[11], NE, (bf16*)(ws + WS_RSH), D, 64 * kb, 32 * nb, 32 * nb, scr, lane); continue; } r -= I_RT;
        if (r < I_SG) { const int kb = r >> 3, nb = r & 7; p0_item(F.in[16], EH, (bf16*)(ws + WS_RSH), D, 64 * kb, 32 * nb, 256 + gu_row(32 * nb, 0), scr, lane); continue; } r -= I_SG;
        if (r < I_SU) { const int kb = r >> 3, nb = r & 7; p0_item(F.in[17], EH, (bf16*)(ws + WS_RSH), D, 64 * kb, 32 * nb, 256 + gu_row(32 * nb, 1), scr, lane); continue; } r -= I_SU;
        { const int kb = r >> 5, nb = r & 31; p0_item(F.in[18], D, (bf16*)(ws + WS_SDN), EH, 64 * kb, 32 * nb, 32 * nb, scr, lane); }
    }
    const GAS f32x4* x4 = (const GAS f32x4*)F.in[0]; GAS v4u* xb = (GAS v4u*)(ws + WS_XB);
    for (int i = (int)blockIdx.x * NTHR + tid; i < M * D / 8; i += F.G * NTHR) { const f32x4 a = x4[2 * i], b = x4[2 * i + 1];
        v4u o; o.x = pk2(a.x, a.y); o.y = pk2(a.z, a.w); o.z = pk2(b.x, b.y); o.w = pk2(b.z, b.w); xb[i] = o; }
}

__device__ __forceinline__ void ld8(const LAS unsigned char* p, float (&v)[8]) { const v4u w = *(const LAS v4u*)p;
    v[0] = pg8::bf_lo(w.x); v[1] = pg8::bf_hi(w.x); v[2] = pg8::bf_lo(w.y); v[3] = pg8::bf_hi(w.y); v[4] = pg8::bf_lo(w.z); v[5] = pg8::bf_hi(w.z); v[6] = pg8::bf_lo(w.w); v[7] = pg8::bf_hi(w.w); }
__device__ __forceinline__ void p2_mixer(Frame& F) {
    constexpr int TT = 32, VR = TT + CK - 1  , UR = TT + 15  , DW_BYTES = CK * CW * 4  ;
    LAS unsigned char* ldw = F.lds; LAS unsigned char* lrow = F.lds + DW_BYTES;
    const bf16* U = (const bf16*)(F.ws + WS_U); const bf16* V = (const bf16*)(F.ws + WS_V); bf16* Rb = (bf16*)(F.ws + WS_R); bf16* Cb = (bf16*)(F.ws + WS_C);
    const int lane = lane_id(), w = F.wave, tid = w * 64 + lane;
    for (int i = tid; i < CK * CW / 4; i += NTHR) *(LAS f32x4*)(ldw + 16 * i) = *(const GAS f32x4*)(F.in[4] + 4 * i);
    for (int i = tid; i < 128; i += NTHR) *(LAS v4u*)(lrow + 62 * 1024 + 16 * i) = (v4u){0u, 0u, 0u, 0u};
    float lg[8], lb[8];
#pragma unroll
    for (int k = 0; k < 8; ++k) { lg[k] = F.in[5][lane * 8 + k]; lb[k] = F.in[6][lane * 8 + k]; }
    const int W = 2 << (lane >> 4);
    for (int unit = F.vcu; unit < M / TT; unit += F.G) {
        const int t0 = unit * TT, s0 = t0 % SEQ;
        __syncthreads();
        for (int c = tid; c < VR * 64; c += NTHR) { const int row = c >> 6, q = c & 63; const int s = s0 - (CK - 1) + row;
            v4u val = (v4u){0u, 0u, 0u, 0u}; if (s >= 0) val = *(const GAS v4u*)(V + (size_t)(t0 - (CK - 1) + row) * CW + q * 8);
            *(LAS v4u*)(lrow + row * 1024 + q * 16) = val; }
        __syncthreads();
        {
            float acc[4][8], wr_[4][8];
#pragma unroll
            for (int q = 0; q < 4; ++q)
#pragma unroll
                for (int k = 0; k < 8; ++k) { acc[q][k] = 0.f; wr_[q][k] = 0.f; }
#pragma unroll 1
            for (int i4 = 0; i4 < 9; ++i4) {
#pragma unroll
                for (int ii = 0; ii < 4; ++ii) { const int i = 4 * i4 + ii;
                    f32x4 a = (f32x4){0.f, 0.f, 0.f, 0.f}, b = a;
                    if (i <= 30) { a = *(const LAS f32x4*)(ldw + i * 2048 + lane * 32); b = *(const LAS f32x4*)(ldw + i * 2048 + lane * 32 + 16); }
                    wr_[ii][0] = a.x; wr_[ii][1] = a.y; wr_[ii][2] = a.z; wr_[ii][3] = a.w; wr_[ii][4] = b.x; wr_[ii][5] = b.y; wr_[ii][6] = b.z; wr_[ii][7] = b.w;
                    float v[8]; ld8(lrow + (4 * w + i) * 1024 + lane * 16, v);
#pragma unroll
                    for (int q = 0; q < 4; ++q) {
#pragma unroll
                        for (int k = 0; k < 8; ++k) acc[q][k] = fmaf(v[k], wr_[(ii - q) & 3][k], acc[q][k]); }
                }
            }
#pragma unroll
            for (int q = 0; q < 4; ++q) {
                float s = 0.f;
#pragma unroll
                for (int k = 0; k < 8; ++k) s += acc[q][k];
                const float mean = wave_sum(s) * (1.f / CW); float s2 = 0.f;
#pragma unroll
                for (int k = 0; k < 8; ++k) { acc[q][k] -= mean; s2 += acc[q][k] * acc[q][k]; }
                const float rstd = 1.f / sqrtf(wave_sum(s2) * (1.f / CW) + LN_EPS);
                float y[8];
#pragma unroll
                for (int k = 0; k < 8; ++k) { const float z = acc[q][k] * rstd * lg[k] + lb[k]; y[k] = z * pg8::sigmoidf_(z); }
                v4u o; o.x = pk2(y[0], y[1]); o.y = pk2(y[2], y[3]); o.z = pk2(y[4], y[5]); o.w = pk2(y[6], y[7]);
                *(GAS v4u*)(Cb + (size_t)(t0 + 4 * w + q) * CW + lane * 8) = o;
            }
        }
        __syncthreads();
        for (int c = tid; c < UR * 64; c += NTHR) { const int row = c >> 6, q = c & 63; const int s = s0 - 15 + row;
            v4u val = (v4u){0u, 0u, 0u, 0u}; if (s >= 0) val = *(const GAS v4u*)(U + (size_t)(t0 - 15 + row) * PW + q * 8);
            *(LAS v4u*)(lrow + row * 1024 + q * 16) = val; }
        __syncthreads();
        {
            float acc[4][8], own[4][8];
#pragma unroll
            for (int q = 0; q < 4; ++q)
#pragma unroll
                for (int k = 0; k < 8; ++k) { acc[q][k] = 0.f; own[q][k] = 0.f; }
#pragma unroll
            for (int i = 0; i < 19; ++i) {
                float v[8]; ld8(lrow + (4 * w + i) * 1024 + lane * 16, v);
#pragma unroll
                for (int q = 0; q < 4; ++q) { const int d = q + 15 - i; if (d >= 0 && d <= 15) { const bool in = d < W;
#pragma unroll
                    for (int k = 0; k < 8; ++k) { acc[q][k] += in ? v[k] : 0.f; if (d == 0) own[q][k] = v[k]; } } }
            }
#pragma unroll
            for (int q = 0; q < 4; ++q) { const int s = s0 + 4 * w + q; const int cnt = (s + 1) < W ? (s + 1) : W; const float inv = 1.f / (float)cnt;
                float y[8];
#pragma unroll
                for (int k = 0; k < 8; ++k) y[k] = acc[q][k] * inv - own[q][k];
                v4u o; o.x = pk2(y[0], y[1]); o.y = pk2(y[2], y[3]); o.z = pk2(y[4], y[5]); o.w = pk2(y[6], y[7]);
                *(GAS v4u*)(Rb + (size_t)(t0 + 4 * w + q) * PW + lane * 8) = o; }
        }
    }
    __syncthreads();
}

__device__ __forceinline__ void p6_ln1(Frame& F) {
    const int lane = lane_id();
    const int gw = F.vcu * NWAVES + F.wave, NGW = F.G * NWAVES;
    const float* Z = (const float*)(F.ws + WS_Z); bf16* X1 = (bf16*)(F.ws + WS_X1); unsigned char* X18 = F.ws + WS_X18;
    f32x4 g[4], b[4];
#pragma unroll
    for (int j = 0; j < 4; ++j) { g[j] = *(const GAS f32x4*)(F.in[9] + 4 * lane + 256 * j); b[j] = *(const GAS f32x4*)(F.in[10] + 4 * lane + 256 * j); }
    for (int m = gw; m < M; m += NGW) {
        const GAS f32x4* zr = (const GAS f32x4*)(Z + (size_t)m * D) + lane;
        f32x4 v[4]; float s = 0.f;
#pragma unroll
        for (int j = 0; j < 4; ++j) { v[j] = zr[64 * j]; s += (v[j].x + v[j].y) + (v[j].z + v[j].w); }
        const float mean = wave_sum(s) * (1.f / D); float s2 = 0.f;
#pragma unroll
        for (int j = 0; j < 4; ++j) { v[j] = v[j] - mean; s2 += (v[j].x * v[j].x + v[j].y * v[j].y) + (v[j].z * v[j].z + v[j].w * v[j].w); }
        const float rstd = 1.f / sqrtf(wave_sum(s2) * (1.f / D) + LN_EPS);
        GAS v2u* o8 = (GAS v2u*)(X1 + (size_t)m * D) + lane;
#pragma unroll
        for (int j = 0; j < 4; ++j) { const f32x4 y = v[j] * rstd * g[j] + b[j]; v2u o; o.x = pk2(y.x, y.y); o.y = pk2(y.z, y.w); o8[64 * j] = o;
            const v2u q = pack8_fp8(y * XSCALE, y * XSCALE); *(GAS unsigned*)(X18 + (size_t)m * D + 4 * lane + 256 * j) = q.x; }
    }
}

__device__ __forceinline__ void p8_route(Frame& F) {
    const int lane = lane_id();
    const int gw = F.vcu * NWAVES + F.wave, NGW = F.G * NWAVES;
    const float* LOG = (const float*)(F.ws + WS_LOG); int* list = (int*)(F.ws + WS_LIST); unsigned* cnt = (unsigned*)F.ctl + CW_CNT;
    const f32x4 bias = *(const GAS f32x4*)(F.in[12] + 4 * lane);
    const float NEG = -__builtin_inff();
    for (int tok = gw; tok < M; tok += NGW) {
        const f32x4 lg = *(const GAS f32x4*)(LOG + (size_t)tok * NE + 4 * lane);
        float sc0 = 1.f / (1.f + __expf(-lg.x)), sc1 = 1.f / (1.f + __expf(-lg.y)), sc2 = 1.f / (1.f + __expf(-lg.z)), sc3 = 1.f / (1.f + __expf(-lg.w));
        float c0 = sc0 + bias.x, c1 = sc1 + bias.y, c2 = sc2 + bias.z, c3 = sc3 + bias.w;
        const float h01 = fmaxf(c0, c1), l01 = fminf(c0, c1), h23 = fmaxf(c2, c3), l23 = fminf(c2, c3);
        float m1 = fmaxf(h01, h23), m2 = fmaxf(fminf(h01, h23), fmaxf(l01, l23));
#pragma unroll
        for (int o = 1; o < 8; o <<= 1) { const float b1 = __shfl_xor(m1, o), b2 = __shfl_xor(m2, o); const float n1 = fmaxf(m1, b1), n2 = fmaxf(fminf(m1, b1), fmaxf(m2, b2)); m1 = n1; m2 = n2; }
        const float gs = m1 + m2; const int mygrp = lane >> 3; int rank = 0;
#pragma unroll
        for (int g = 0; g < NG; ++g) { const float og = __shfl(gs, g * 8); rank += (og > gs || (og == gs && g < mygrp)) ? 1 : 0; }
        if (rank >= 4) { c0 = NEG; c1 = NEG; c2 = NEG; c3 = NEG; }
        float sumw = 0.f, mysc = 0.f; int myidx = 0;
#pragma unroll
        for (int r = 0; r < TOPK; ++r) {
            float bv = c0, bs = sc0; int gi = 4 * lane;
            if (c1 > bv) { bv = c1; bs = sc1; gi = 4 * lane + 1; }
            if (c2 > bv) { bv = c2; bs = sc2; gi = 4 * lane + 2; }
            if (c3 > bv) { bv = c3; bs = sc3; gi = 4 * lane + 3; }
#pragma unroll
            for (int o = 32; o >= 1; o >>= 1) { const float ov = __shfl_xor(bv, o), os = __shfl_xor(bs, o); const int oi = __shfl_xor(gi, o);
                const bool take = (ov > bv) || (ov == bv && oi < gi); if (take) { bv = ov; bs = os; gi = oi; } }
            if (lane == r) { myidx = gi; mysc = bs; }
            sumw += bs;
            if (gi == 4 * lane) c0 = NEG; if (gi == 4 * lane + 1) c1 = NEG; if (gi == 4 * lane + 2) c2 = NEG; if (gi == 4 * lane + 3) c3 = NEG;
        }
        if (lane < TOPK) { const float wgt = mysc / sumw * RSCALE; const unsigned pos = atomicAdd(&cnt[myidx], 1u);
            v2u ent; ent.x = (unsigned)(tok * TOPK + lane); ent.y = __float_as_uint(wgt); *(GAS v2u*)(list + ((size_t)myidx * ECAP + pos) * 2) = ent; }
    }
}

__device__ __forceinline__ int expert_table(Frame& F) {
    LAS int* tstart = (LAS int*)(F.lds + TAB_OFF); LAS int* cntl = tstart + 260; LAS int* wtot = tstart + 520;
    const unsigned* cnt = (const unsigned*)F.ctl + CW_CNT;
    const int lane = lane_id(), tid = F.wave * 64 + lane;
    __syncthreads();
    int c = 0, incl = 0;
    if (tid < NE) { c = (int)__hip_atomic_load(cnt + tid, RLX_AGENT); incl = (c + 255) >> 8;
#pragma unroll
        for (int o = 1; o < 64; o <<= 1) { const int up = __shfl_up(incl, o); if (lane >= o) incl += up; }
        if (lane == 63) wtot[F.wave] = incl; cntl[tid] = c; }
    __syncthreads();
    if (tid < NE) { int base = 0;
#pragma unroll
        for (int k = 0; k < 4; ++k) if (k < F.wave) base += wtot[k];
        tstart[tid + 1] = base + incl; if (tid == 0) tstart[0] = 0; }
    __syncthreads();
    return tstart[NE];
}

__device__ __forceinline__ void p11_combine(Frame& F) {
    const int lane = lane_id();
    const int gw = F.vcu * NWAVES + F.wave, NGW = F.G * NWAVES;
    const unsigned char* Y = F.ws + WS_Y; const bf16* YS = (const bf16*)(F.ws + WS_YSH); const bf16* X1 = (const bf16*)(F.ws + WS_X1);
    for (int tok = gw; tok < M; tok += NGW) {
        f32x4 a[4];
#pragma unroll
        for (int j = 0; j < 2; ++j) { f32x4 x0, x1; unpack8(*(const GAS v4u*)(X1 + (size_t)tok * D + lane * 16 + 8 * j), x0, x1); a[2 * j] = x0 * ALPHA; a[2 * j + 1] = x1 * ALPHA;
            f32x4 s0, s1; unpack8(*(const GAS v4u*)(YS + (size_t)tok * D + lane * 16 + 8 * j), s0, s1); a[2 * j] += s0; a[2 * j + 1] += s1; }
#if !(defined(DBG_COMBINE) && (DBG_COMBINE & 1))
        f32x4 r[4] = {(f32x4){0.f, 0.f, 0.f, 0.f}, (f32x4){0.f, 0.f, 0.f, 0.f}, (f32x4){0.f, 0.f, 0.f, 0.f}, (f32x4){0.f, 0.f, 0.f, 0.f}};
#pragma unroll
        for (int k = 0; k < TOPK; ++k) { const v4u q = *(const GAS v4u*)(Y + ((size_t)tok * TOPK + k) * D + lane * 16);
            r[0] += unpack4_fp8(q.x); r[1] += unpack4_fp8(q.y); r[2] += unpack4_fp8(q.z); r[3] += unpack4_fp8(q.w); }
#pragma unroll
        for (int j = 0; j < 4; ++j) a[j] += r[j] * (1.f / YSCALE);
#endif
        float s = 0.f;
#pragma unroll
        for (int j = 0; j < 4; ++j) s += (a[j].x + a[j].y) + (a[j].z + a[j].w);
        const float mean = wave_sum(s) * (1.f / D); float s2 = 0.f;
#pragma unroll
        for (int j = 0; j < 4; ++j) { a[j] = a[j] - mean; s2 += (a[j].x * a[j].x + a[j].y * a[j].y) + (a[j].z * a[j].z + a[j].w * a[j].w); }
        const float rstd = 1.f / sqrtf(wave_sum(s2) * (1.f / D) + LN_EPS);
#pragma unroll
        for (int j = 0; j < 4; ++j) { const int col = lane * 16 + 4 * j;
            const f32x4 g = *(const GAS f32x4*)(F.in[19] + col), b = *(const GAS f32x4*)(F.in[20] + col);
            *(GAS f32x4*)(F.out + (size_t)tok * D + col) = a[j] * rstd * g + b; }
    }
}
#ifdef DBG_CHECK
constexpr int NT = 512;
constexpr size_t DBG_OFF = 448 * MiB;
__device__ __forceinline__ float dsig(float x) { return 1.f / (1.f + expf(-x)); }
__device__ __forceinline__ float bf2f(unsigned short h) { return __uint_as_float((unsigned)h << 16); }
__global__ void dbg_proj(const float* x, const float* w_in, float* PN) {
    for (int i = blockIdx.x * blockDim.x + threadIdx.x; i < NT * INC; i += gridDim.x * blockDim.x) { const int tok = i / INC, col = i % INC; float a = 0.f;
        for (int k = 0; k < D; ++k) a = fmaf(x[(size_t)tok * D + k], w_in[(size_t)k * INC + col], a); PN[i] = a; }
}
__global__ void dbg_mix1(const float* PN, const float* dw, float* RN, float* CVN) {
    for (int i = blockIdx.x * blockDim.x + threadIdx.x; i < NT * 512; i += gridDim.x * blockDim.x) { const int tok = i / 512, ch = i % 512; const int g = ch / 128, W = 2 << g;
        float s = 0.f; int cnt = 0; for (int j = 0; j < W; ++j) if (tok - j >= 0) { s += PN[(size_t)(tok - j) * INC + ch]; ++cnt; }
        RN[i] = s / (float)cnt - PN[(size_t)tok * INC + ch];
        float c = 0.f; for (int j = 0; j < CK; ++j) { const int t = tok - (CK - 1) + j; if (t >= 0) c += PN[(size_t)t * INC + 512 + ch] * dsig(PN[(size_t)t * INC + 1024 + ch]) * dw[j * 512 + ch]; }
        CVN[i] = c; }
}
__global__ void dbg_ln(const float* IN, int n, const float* g, const float* b, float* OUT, int act) {
    const int tok = blockIdx.x * blockDim.x + threadIdx.x; if (tok >= NT) return;
    float m = 0.f; for (int k = 0; k < n; ++k) m += IN[(size_t)tok * n + k]; m /= n; float v = 0.f; for (int k = 0; k < n; ++k) { const float d = IN[(size_t)tok * n + k] - m; v += d * d; } v /= n;
    const float r = 1.f / sqrtf(v + LN_EPS); for (int k = 0; k < n; ++k) { float y = (IN[(size_t)tok * n + k] - m) * r * g[k] + b[k]; if (act) y = y * dsig(y); OUT[(size_t)tok * n + k] = y; }
}
__global__ void dbg_mix3(const float* PN, const float* RN, const float* CN, const float* pool_w, const float* scale, const float* cwo, float* MGN) {
    for (int i = blockIdx.x * blockDim.x + threadIdx.x; i < NT * D; i += gridDim.x * blockDim.x) { const int tok = i / D, d = i % D, g = d / 256, dd = d % 256;
        float yp = 0.f; for (int c = 0; c < 128; ++c) yp = fmaf(RN[(size_t)tok * 512 + g * 128 + c], pool_w[((size_t)g * 128 + c) * 256 + dd], yp); yp *= scale[d];
        float yc = 0.f; for (int c = 0; c < 512; ++c) yc = fmaf(CN[(size_t)tok * 512 + c], cwo[(size_t)c * D + d], yc);
        MGN[i] = dsig(PN[(size_t)tok * INC + 1536 + d]) * yp + dsig(PN[(size_t)tok * INC + 2560 + d]) * yc; }
}
__global__ void dbg_mix4(const float* MGN, const float* w_out, const float* x, float* ZN) {
    for (int i = blockIdx.x * blockDim.x + threadIdx.x; i < NT * D; i += gridDim.x * blockDim.x) { const int tok = i / D, e = i % D; float a = 0.f;
        for (int d = 0; d < D; ++d) a = fmaf(MGN[(size_t)tok * D + d], w_out[(size_t)d * D + e], a); ZN[i] = ALPHA * x[(size_t)tok * D + e] + a; }
}
__global__ void dbg_cmp(int k, const void* buf, int kind, int ld, int n, const float* NV, int nld, int ncol0, int fn, const float* PN, float* acc) {
    float e2 = 0.f, r2 = 0.f;
    for (int i = blockIdx.x * blockDim.x + threadIdx.x; i < NT * n; i += gridDim.x * blockDim.x) { const int tok = i / n, c = i % n;
        const float a = kind ? ((const float*)buf)[(size_t)tok * ld + c] : bf2f(((const unsigned short*)buf)[(size_t)tok * ld + c]);
        float b = NV[(size_t)tok * nld + ncol0 + c];
        if (fn == 1) b = dsig(b);
        if (fn == 2) b = b * dsig(PN[(size_t)tok * INC + 1024 + c]);
        e2 += (a - b) * (a - b); r2 += b * b; }
    atomicAdd(acc + 2 * k, e2); atomicAdd(acc + 2 * k + 1, r2);
}
__global__ void dbg_cmp_tile(int k, const void* buf, int ld, int r0, int c0, const float* NV, int nld, int ncol0, float* acc) {
    float e2 = 0.f, r2 = 0.f;
    for (int i = blockIdx.x * blockDim.x + threadIdx.x; i < 256 * 256; i += gridDim.x * blockDim.x) { const int tok = r0 + i / 256, c = c0 + i % 256;
        const float a = bf2f(((const unsigned short*)buf)[(size_t)tok * ld + c]); const float b = dsig(NV[(size_t)tok * nld + ncol0 + c]);
        e2 += (a - b) * (a - b); r2 += b * b; }
    atomicAdd(acc + 2 * k, e2); atomicAdd(acc + 2 * k + 1, r2);
}
__global__ void dbg_cmp_wt(int k, const unsigned short* WT, const float* W, int n0, float* acc) {
    float e2 = 0.f, r2 = 0.f;
    for (int i = blockIdx.x * blockDim.x + threadIdx.x; i < 256 * 1024; i += gridDim.x * blockDim.x) { const int n = n0 + i / 1024, kk = i % 1024;
        const float a = bf2f(WT[(size_t)n * 1024 + kk]); const float b = W[(size_t)kk * INC + n];
        e2 += (a - b) * (a - b); r2 += b * b; }
    atomicAdd(acc + 2 * k, e2); atomicAdd(acc + 2 * k + 1, r2);
}
__global__ void dbg_code(const float* acc, int nchk, float* out, int n) {
    int code = 0; for (int k = nchk - 1; k >= 0; --k) if (!(acc[2 * k] <= 1e-3f * acc[2 * k + 1])) code = k + 1;
#ifdef DBG_TILES
    code = 0; for (int k = 0; k < 4; ++k) if (!(acc[2 * (16 + k)] <= 1e-3f * acc[2 * (16 + k) + 1])) code |= 1 << k;
#endif
#ifdef DBG_SHOW
    const float val = sqrtf(1000.f * acc[2 * DBG_SHOW] / acc[2 * DBG_SHOW + 1]);
    for (int i = blockIdx.x * blockDim.x + threadIdx.x; i < n; i += gridDim.x * blockDim.x) out[i] = val;
#else
    for (int i = blockIdx.x * blockDim.x + threadIdx.x; i < n; i += gridDim.x * blockDim.x) out[i] = (float)code;
#endif
}
static void dbg_run(void* const* d_in, float* d_out, unsigned char* ws, hipStream_t st, int stop) {
    float* PN = d_out; float* RN = PN + (size_t)NT * INC; float* CVN = RN + NT * 512; float* CN = CVN + NT * 512; float* MGN = CN + NT * 512; float* ZN = MGN + (size_t)NT * D; float* X1N = ZN + (size_t)NT * D; float* acc = X1N + (size_t)NT * D;
    const float* x = (const float*)d_in[0];
    hipMemsetAsync(acc, 0, 64 * 4, st);
    dbg_proj<<<2048, 256, 0, st>>>(x, (const float*)d_in[1], PN);
    dbg_mix1<<<1024, 256, 0, st>>>(PN, (const float*)d_in[4], RN, CVN);
    dbg_ln<<<NT / 64, 64, 0, st>>>(CVN, 512, (const float*)d_in[5], (const float*)d_in[6], CN, 1);
    dbg_mix3<<<2048, 256, 0, st>>>(PN, RN, CN, (const float*)d_in[2], (const float*)d_in[3], (const float*)d_in[7], MGN);
    dbg_mix4<<<2048, 256, 0, st>>>(MGN, (const float*)d_in[8], x, ZN);
    dbg_ln<<<NT / 64, 64, 0, st>>>(ZN, D, (const float*)d_in[9], (const float*)d_in[10], X1N, 0);
    if (stop <= 4) {
    dbg_cmp<<<256, 256, 0, st>>>(0, ws + WS_U, 0, 512, 512, PN, INC, 0, 0, PN, acc);
    dbg_cmp<<<256, 256, 0, st>>>(1, ws + WS_V, 0, 512, 512, PN, INC, 512, 2, PN, acc);
    dbg_cmp<<<256, 256, 0, st>>>(2, ws + WS_GP, 0, D, D, PN, INC, 1536, 1, PN, acc);
    dbg_cmp<<<256, 256, 0, st>>>(3, ws + WS_GC, 0, D, D, PN, INC, 2560, 1, PN, acc);
    }
    dbg_cmp<<<256, 256, 0, st>>>(4, ws + WS_R, 0, 512, 512, RN, 512, 0, 0, PN, acc);
    dbg_cmp<<<256, 256, 0, st>>>(5, ws + WS_C, 0, 512, 512, CN, 512, 0, 0, PN, acc);
    if (stop >= 7) {
    dbg_cmp<<<256, 256, 0, st>>>(6, ws + WS_MG, 0, D, D, MGN, D, 0, 0, PN, acc);
    dbg_cmp<<<256, 256, 0, st>>>(7, ws + WS_Z, 1, D, D, ZN, D, 0, 0, PN, acc);
    dbg_cmp<<<256, 256, 0, st>>>(8, ws + WS_X1, 0, D, D, X1N, D, 0, 0, PN, acc);
    }
#ifdef DBG_WT
    dbg_cmp_wt<<<256, 256, 0, st>>>(DBG_SHOW, (const unsigned short*)(ws + WS_WIN), (const float*)d_in[1], DBG_WT, acc);
#endif
#ifdef DBG_TILES
    for (int t = 0; t < 4; ++t) dbg_cmp_tile<<<64, 256, 0, st>>>(16 + t, ws + ((DBG_TILES & 2) ? WS_GC : WS_GP), D, (DBG_TILES & 1) * 256, t * 256, PN, INC, ((DBG_TILES & 2) ? 2560 : 1536), acc);
#endif
    hipMemcpyAsync(ws + WS_CTL + 65536, acc, 64 * 4, hipMemcpyDeviceToDevice, st);
    dbg_code<<<1024, 256, 0, st>>>((const float*)(ws + WS_CTL + 65536), 9, d_out, M * D);
}
#endif

#ifndef MK_N_LAUNCHES
#define MK_N_LAUNCHES 1
#endif
constexpr int N_PHASES = 12;
struct Args { const float* in[21]; float* out; unsigned char* ws; int ph_lo, ph_hi; };
__global__ void __launch_bounds__(NTHR, 2) mk_fwd(Args args) {
    extern __shared__ __attribute__((aligned(16))) unsigned char lds[];
    Frame F;
    F.lds = (LAS unsigned char*)lds;
    F.MISC = (volatile LAS unsigned*)(F.lds + MISC_OFF);
    F.wave = __builtin_amdgcn_readfirstlane((int)threadIdx.x >> 6);
    F.G = gridDim.x; { const int bx = blockIdx.x; F.vcu = (F.G % 8 == 0) ? (bx % 8) * (F.G / 8) + bx / 8 : bx; }
    F.ws = args.ws; F.ctl = (gu32*)(args.ws + WS_CTL); F.out = args.out;
#pragma unroll
    for (int i = 0; i < 21; ++i) F.in[i] = args.in[i];
    for (int u = threadIdx.x; u < (LDS_BYTES - TAB_OFF) / 4; u += NTHR) ((LAS unsigned*)(F.lds + TAB_OFF))[u] = 0u;
    __syncthreads();
    const int lo = args.ph_lo, hi = args.ph_hi;
    const bool multi = (hi - lo) > 1;
    XcdBarrier bar; bar.bar = (unsigned*)(F.ctl + CW_BAR); bar.x = 0; bar.st = nullptr;
    if (multi) bar = xcd_barrier_post((unsigned*)(F.ctl + CW_BAR), F.MISC + 8);
#ifndef PH_MASK
#define PH_MASK 0xFFF
#endif
#define IN(k) ((((PH_MASK) >> (k)) & 1) && lo <= (k) && (k) < hi)
#define SEAM(k) do { if (IN(k) && IN((k) + 1)) xcd_barrier(bar, F.wave); } while (0)
    unsigned char* ws = args.ws;
    LAS unsigned char* ring = F.lds + RING_OFF; LAS unsigned char* entl = F.lds + ENT_OFF;
    const int bx = (int)blockIdx.x;

#ifndef DUP_MASK
#define DUP_MASK 0
#endif
#define DUP(k) ((((DUP_MASK) >> (k)) & 1) != 0)
#define PHASE(k, BODY) do { if (IN(k)) { BODY; if (DUP(k)) { xcd_barrier(bar, F.wave); BODY; } } SEAM(k); } while (0)
    PHASE(0, p0_prologue(F));
#define P1_BODY { DenseOrder S; S.init((const bf16*)(ws + WS_XB), (const bf16*)(ws + WS_WIN), M, INC, D, D, D, 0, F.G, bx); \
        EpiProj E{(bf16*)(ws + WS_U), (bf16*)(ws + WS_V), (bf16*)(ws + WS_GP), (bf16*)(ws + WS_GC)}; \
        pg8::gemm_phase<EpiProj, DenseOrder>(ring, entl, S, E, F.wave); }
    PHASE(1, P1_BODY);
    PHASE(2, p2_mixer(F));
#define P3_BODY { DenseOrder S; S.init((const bf16*)(ws + WS_R), (const bf16*)(ws + WS_POOL), M, D, 128, PW, 128, 128, F.G, bx); \
        EpiPool E{F.in[3], (const bf16*)(ws + WS_GP), (bf16*)(ws + WS_T1)}; \
        pg8::gemm_phase<EpiPool, DenseOrder>(ring, entl, S, E, F.wave); }
    PHASE(3, P3_BODY);
#define P4_BODY { DenseOrder S; S.init((const bf16*)(ws + WS_C), (const bf16*)(ws + WS_CVO), M, D, CW, CW, CW, 0, F.G, bx); \
        EpiConvOut E{(const bf16*)(ws + WS_T1), (const bf16*)(ws + WS_GC), (bf16*)(ws + WS_MG)}; \
        pg8::gemm_phase<EpiConvOut, DenseOrder>(ring, entl, S, E, F.wave); }
    PHASE(4, P4_BODY);
#define P5_BODY { DenseOrder S; S.init((const bf16*)(ws + WS_MG), (const bf16*)(ws + WS_WOUT), M, D, D, D, D, 0, F.G, bx); \
        EpiWout E{F.in[0], (float*)(ws + WS_Z)}; \
        pg8::gemm_phase<EpiWout, DenseOrder>(ring, entl, S, E, F.wave); }
    PHASE(5, P5_BODY);
    PHASE(6, p6_ln1(F));
#define P7_BODY { DenseOrder S; S.init((const bf16*)(ws + WS_X1), (const bf16*)(ws + WS_RSH), M, 768, D, D, D, 0, F.G, bx); \
        EpiRSh E{(float*)(ws + WS_LOG), (bf16*)(ws + WS_HS)}; \
        pg8::gemm_phase<EpiRSh, DenseOrder>(ring, entl, S, E, F.wave); }
    PHASE(7, P7_BODY);
    if (IN(8)) { p8_route(F);
        { DenseOrder S; S.init((const bf16*)(ws + WS_HS), (const bf16*)(ws + WS_SDN), M, D, EH, EH, EH, 0, F.G, bx);
          EpiSDown E{(bf16*)(ws + WS_YSH)};
          pg8::gemm_phase<EpiSDown, DenseOrder>(ring, entl, S, E, F.wave); } } SEAM(8);
#define P9_BODY { const int tt = expert_table(F); \
        ExpertOrder<true> S; S.A = ws + WS_X18; S.Bt = ws + WS_EGU; S.ldaB = D; S.ldbB = D; S.nt = D / 128; S.bstride = (size_t)512 * D; S.scaleA = E8_X; S.scaleB = E8_W; \
        S.tstart = (const LAS int*)(F.lds + TAB_OFF); S.cntl = S.tstart + 260; S.list = (const int*)(ws + WS_LIST); S.nN = 2; S.nwg = tt * 2; S.G = F.G; S.c = bx; \
        EpiEGU E{ws + WS_HE}; \
        pg8::gemm_phase<EpiEGU, ExpertOrder<true>>(ring, entl, S, E, F.wave); }
    PHASE(9, P9_BODY);
#define P10_BODY { const int tt = expert_table(F); \
        { ExpertOrder<false> S; S.A = ws + WS_HE; S.Bt = ws + WS_EDN; S.ldaB = EH; S.ldbB = EH; S.nt = EH / 128; S.bstride = (size_t)D * EH; S.scaleA = E8_H; S.scaleB = E8_W; \
          S.tstart = (const LAS int*)(F.lds + TAB_OFF); S.cntl = S.tstart + 260; S.list = (const int*)(ws + WS_LIST); S.nN = 4; S.nwg = tt * 4; S.G = F.G; S.c = bx; \
          EpiEDown E{ws + WS_Y}; \
          pg8::gemm_phase<EpiEDown, ExpertOrder<false>>(ring, entl, S, E, F.wave); } }
    PHASE(10, P10_BODY);
    PHASE(11, p11_combine(F));
#undef IN
#undef SEAM
}

extern "C" void kernel_launch(void* const* d_in, const int* in_sizes, int n_in, void* d_out, int out_size, void* d_ws, size_t ws_size, hipStream_t stream) {
    static int grid = 0;
    if (grid == 0) {
        if (n_in != 21 || in_sizes[0] != M * D || out_size != M * D || ws_size < WS_END) { fprintf(stderr, "kernel_launch: unexpected shapes (n_in %d, in0 %d, out %d, ws %zu)\n", n_in, n_in > 0 ? in_sizes[0] : -1, out_size, ws_size); grid = -1; return; }
        int dev = 0, cus = 0;
        if (hipGetDevice(&dev) != hipSuccess || hipDeviceGetAttribute(&cus, hipDeviceAttributeMultiprocessorCount, dev) != hipSuccess) { grid = -1; return; }
        if (hipFuncSetAttribute((const void*)mk_fwd, hipFuncAttributeMaxDynamicSharedMemorySize, LDS_BYTES) != hipSuccess) { fprintf(stderr, "kernel_launch: hipFuncSetAttribute failed\n"); grid = -1; return; }
        (void)hipGetLastError();
        grid = cus;
    }
    if (grid < 0) return;
    (void)hipMemsetAsync((char*)d_ws + WS_CTL, 0, CTL_ZERO_BYTES, stream);
    Args a{};
    for (int i = 0; i < 21; ++i) a.in[i] = (const float*)d_in[i];
    a.out = (float*)d_out; a.ws = (unsigned char*)d_ws;
    constexpr int NL = MK_N_LAUNCHES;
    for (int li = 0; li < NL; ++li) {
        a.ph_lo = (NL == 1) ? 0 : li; a.ph_hi = (NL == 1) ? N_PHASES : li + 1;
        hipLaunchKernelGGL(mk_fwd, dim3(grid), dim3(NTHR), LDS_BYTES, stream, a);
#ifdef DBG_CHECK
        if (a.ph_hi == DBG_CHECK) { dbg_run(d_in, (float*)d_out, (unsigned char*)d_ws, stream, DBG_CHECK); return; }
#endif
    }
}
```

```cpp
#define MK_N_LAUNCHES 1

#include <hip/hip_runtime.h>
#include <cstdio>
#include <cstdint>

namespace pg8 {
#define PG8_LAS __attribute__((address_space(3)))
typedef unsigned short bf16_t;
typedef short bf16x8 __attribute__((ext_vector_type(8)));
typedef float f32x4 __attribute__((ext_vector_type(4)));
typedef float f32x2 __attribute__((ext_vector_type(2)));
typedef unsigned u32x4 __attribute__((ext_vector_type(4)));
typedef unsigned u32x2 __attribute__((ext_vector_type(2)));
typedef int i32x4 __attribute__((ext_vector_type(4)));
typedef int i32x8 __attribute__((ext_vector_type(8)));
constexpr int BM = 256, BK = 64, HALF = 128, HTB = HALF * BK * 2  , STAGE_BYTES = 8 * HTB, NXCD = 8, WGM = 8;

__host__ __device__ __forceinline__ int lds_byte(int r, int c) { const int st = (r >> 4) * 2 + (c >> 5), rr = r & 15, cc = c & 31, ob = rr * 64 + cc * 2; return st * 1024 + (ob ^ (((ob >> 9) & 1) << 5)); }
__host__ __device__ __forceinline__ void stage_rc(int b, int& R, int& C) { const int st = b / 1024, sb = b % 1024, swz = sb ^ (((sb >> 9) & 1) << 5); R = (st >> 1) * 16 + swz / 64; C = (st & 1) * 32 + (swz % 64) / 2; }
__host__ __device__ __forceinline__ int perm32(int rho) { const int n = rho >> 4, i = rho & 15; return 8 * (i >> 2) + 4 * n + (i & 3); }

struct Unit { int pm, pn, e, r0, nrow; };

typedef __bf16 bf16x2_t __attribute__((ext_vector_type(2)));
__device__ __forceinline__ unsigned cvt_pk_bf16(float lo, float hi) { f32x2 v = {lo, hi}; bf16x2_t b = __builtin_convertvector(v, bf16x2_t); return __builtin_bit_cast(unsigned, b); }
__device__ __forceinline__ u32x4 pack8(const f32x4 a, const f32x4 b) { u32x4 w; w.x = cvt_pk_bf16(a[0], a[1]); w.y = cvt_pk_bf16(a[2], a[3]); w.z = cvt_pk_bf16(b[0], b[1]); w.w = cvt_pk_bf16(b[2], b[3]); return w; }
__device__ __forceinline__ float bf_lo(unsigned w) { return __uint_as_float(w << 16); }
__device__ __forceinline__ float bf_hi(unsigned w) { return __uint_as_float(w & 0xffff0000u); }
__device__ __forceinline__ void unpack8(const u32x4 w, f32x4& a, f32x4& b) { a = (f32x4){bf_lo(w.x), bf_hi(w.x), bf_lo(w.y), bf_hi(w.y)}; b = (f32x4){bf_lo(w.z), bf_hi(w.z), bf_lo(w.w), bf_hi(w.w)}; }
__device__ __forceinline__ float sigmoidf_(float x) { return __builtin_amdgcn_rcpf(1.0f + __expf(-x)); }
__device__ __forceinline__ f32x4 sigmoid4(const f32x4 x) { return (f32x4){sigmoidf_(x[0]), sigmoidf_(x[1]), sigmoidf_(x[2]), sigmoidf_(x[3])}; }

template <class Epi, class Sched>
__device__ __forceinline__ void gemm_phase(PG8_LAS unsigned char* lds, PG8_LAS unsigned char* ent, const Sched& S, const Epi& E, int wid_) {
    int lane_; asm volatile("v_mbcnt_lo_u32_b32 %0, -1, 0\n\tv_mbcnt_hi_u32_b32 %0, -1, %0" : "=v"(lane_));
    const int wid = __builtin_amdgcn_readfirstlane(wid_), lane = lane_, tid = wid * 64 + lane, wr = wid >> 2, wc = wid & 3, fr = lane & 15, fq = lane >> 4;
    int nt_ = S.nt; asm volatile("" : "+s"(nt_));
    const int nt = nt_;
    int sR[2], sC[2]; unsigned voffB[2];
#pragma unroll
    for (int i = 0; i < 2; ++i) { int R, C; stage_rc(tid * 16 + i * 8192, R, C); const int Rb = Epi::PERM ? ((R & ~31) + perm32(R & 31)) : R;
        sR[i] = R; sC[i] = C; voffB[i] = (unsigned)(Rb * S.ldbB + C * 2); }
    const size_t kstep = (size_t)(BK * 2);
    const size_t hstepB = (size_t)HALF * S.ldbB;
    const unsigned ldsw = (unsigned)wid * 1024u;
    const int aoff = lds_byte(wr * 64 + fr, fq * 8), boff = lds_byte(wc * 32 + fr, fq * 8);
    PG8_LAS unsigned char* abase = lds + aoff; PG8_LAS unsigned char* bbase = lds + 4 * HTB + boff;
    asm volatile("" : "+v"(abase), "+v"(bbase));
#define PG8_SA(b, h) (((b) * 2 + (h)) * HTB)
#define PG8_SB(b, h) ((4 + (b) * 2 + (h)) * HTB)
#define PG8_STAGE(bufoff, gbase, voff) do { _Pragma("unroll") for (int _i = 0; _i < 2; ++_i) \
        __builtin_amdgcn_global_load_lds((const unsigned*)((const char*)(gbase) + (voff)[_i]), (PG8_LAS unsigned*)(lds + (bufoff) + ldsw + _i * 8192), 16, 0, 0); } while (0)
#define PG8_STAGE_A(bufoff, gbase, nrow_, e_, h) do { _Pragma("unroll") for (int _i = 0; _i < 2; ++_i) \
        __builtin_amdgcn_global_load_lds((const unsigned*)((const char*)(gbase) + S.a_voff((nrow_), (e_), (h) * 128 + sR[_i], sC[_i])), (PG8_LAS unsigned*)(lds + (bufoff) + ldsw + _i * 8192), 16, 0, 0); } while (0)
#define PG8_LD8(p) __builtin_shufflevector(*(const PG8_LAS i32x4*)(p), *(const PG8_LAS i32x4*)((p) + 1024), 0, 1, 2, 3, 4, 5, 6, 7)
#define PG8_LDA(dst, b, h) do { if constexpr (Sched::FP8) { _Pragma("unroll") for (int m = 0; m < 4; ++m) dst##8[m] = PG8_LD8(abase + PG8_SA(b, h) + m * 2048); } \
        else { _Pragma("unroll") for (int m = 0; m < 4; ++m) _Pragma("unroll") for (int k = 0; k < 2; ++k) dst[m][k] = *(const PG8_LAS bf16x8*)(abase + PG8_SA(b, h) + m * 2048 + k * 1024); } } while (0)
#define PG8_LDB(dst, b, h) do { if constexpr (Sched::FP8) { _Pragma("unroll") for (int n = 0; n < 2; ++n) dst##8[n] = PG8_LD8(bbase + PG8_SA(b, h) + n * 2048); } \
        else { _Pragma("unroll") for (int n = 0; n < 2; ++n) _Pragma("unroll") for (int k = 0; k < 2; ++k) dst[n][k] = *(const PG8_LAS bf16x8*)(bbase + PG8_SA(b, h) + n * 2048 + k * 1024); } } while (0)
#define PG8_MMA(ai, bj, At, Bt) do { __builtin_amdgcn_s_setprio(1); \
        if constexpr (Sched::FP8) { _Pragma("unroll") for (int m = 0; m < 4; ++m) _Pragma("unroll") for (int n = 0; n < 2; ++n) \
            asm volatile("v_mfma_scale_f32_16x16x128_f8f6f4 %0, %1, %2, %0, %3, %4 op_sel_hi:[0,0,0]" : "+v"(acc[ai][bj][m][n]) : "v"(Bt##8[n]), "v"(At##8[m]), "v"(scB), "v"(scA)); } \
        else { _Pragma("unroll") for (int m = 0; m < 4; ++m) _Pragma("unroll") for (int n = 0; n < 2; ++n) _Pragma("unroll") for (int k = 0; k < 2; ++k) \
            acc[ai][bj][m][n] = __builtin_amdgcn_mfma_f32_16x16x32_bf16(Bt[n][k], At[m][k], acc[ai][bj][m][n], 0, 0, 0); } \
        __builtin_amdgcn_s_setprio(0); } while (0)
#define PG8_WAIT_V(n) asm volatile("s_waitcnt vmcnt(" #n ")" ::: "memory")
#define PG8_WAIT_L(n) asm volatile("s_waitcnt lgkmcnt(" #n ")" ::: "memory")
#define PG8_BAR __builtin_amdgcn_s_barrier()
#define PG8_SCHED __builtin_amdgcn_sched_barrier(0)
    Unit cur, nxt; int ui = 0;
    if (!S.next(0, cur)) return;
    f32x4 acc[2][2][4][2];
#pragma unroll
    for (int a = 0; a < 2; ++a)
#pragma unroll
        for (int b = 0; b < 2; ++b)
#pragma unroll
            for (int m = 0; m < 4; ++m)
#pragma unroll
                for (int n = 0; n < 2; ++n) acc[a][b][m][n] = (f32x4){0.f, 0.f, 0.f, 0.f};
    const int scA = S.scaleA, scB = S.scaleB;
    bf16x8 At[4][2], B0[2][2], B1[2][2]; i32x8 At8[4], B08[2], B18[2];
    const char* cA = S.a_ptr(cur); const char* cB = S.b_ptr(cur);
    if constexpr (Sched::META) {
        S.meta_issue(cur, ent, wid, lane); if (S.next(1, nxt)) S.meta_issue(nxt, ent + 2048, wid, lane);
        PG8_WAIT_V(0); PG8_BAR;
    }
    PG8_STAGE(PG8_SB(0, 0), cB, voffB); PG8_STAGE(PG8_SB(0, 1), cB + hstepB, voffB); PG8_STAGE_A(PG8_SA(0, 0), cA, cur.nrow, ent, 0); PG8_STAGE_A(PG8_SA(0, 1), cA, cur.nrow, ent, 1);
    if (wr == 1) PG8_BAR;
    PG8_WAIT_V(2); PG8_BAR;
    PG8_STAGE(PG8_SB(1, 0), cB + kstep, voffB); PG8_STAGE_A(PG8_SA(1, 0), cA + kstep, cur.nrow, ent, 0); PG8_STAGE(PG8_SB(1, 1), cB + hstepB + kstep, voffB);
    PG8_WAIT_V(6); PG8_BAR;
    for (;;) {
        const bool has_next = S.next(ui + 1, nxt);
        const char* nA = cA; const char* nB = cB; int nnrow = cur.nrow; PG8_LAS unsigned char* const cent = ent + (ui & 3) * 2048; PG8_LAS unsigned char* nent = cent;
        if (has_next) { nA = S.a_ptr(nxt); nB = S.b_ptr(nxt); nnrow = nxt.nrow; nent = ent + ((ui + 1) & 3) * 2048; }
        if constexpr (Sched::META) { Unit u2; if (S.next(ui + 2, u2)) S.meta_issue(u2, ent + ((ui + 2) & 3) * 2048, wid, lane); }
        for (int t = 0; t < nt; t += 2) {
            const bool last = (t == nt - 2);
            const char* a1 = cA + (size_t)(t + 1) * kstep;
            const char* a2 = last ? nA : cA + (size_t)(t + 2) * kstep; const char* b2 = last ? nB : cB + (size_t)(t + 2) * kstep;
            const char* a3 = a2 + kstep; const char* b3 = b2 + kstep;
            const int xnrow = last ? nnrow : cur.nrow; PG8_LAS unsigned char* const xent = last ? nent : cent;
            PG8_LDB(B0, 0, 0); PG8_LDB(B1, 0, 1); PG8_SCHED; PG8_LDA(At, 0, 0); PG8_STAGE_A(PG8_SA(1, 1), a1, cur.nrow, cent, 1);
            PG8_WAIT_V(8); PG8_WAIT_L(0); PG8_BAR; PG8_MMA(0, 0, At, B0); PG8_MMA(0, 1, At, B1); PG8_BAR; PG8_SCHED;
            PG8_LDA(At, 0, 1); PG8_STAGE(PG8_SB(0, 0), b2, voffB); PG8_STAGE(PG8_SB(0, 1), b2 + hstepB, voffB); PG8_STAGE_A(PG8_SA(0, 0), a2, xnrow, xent, 0);
            PG8_WAIT_V(8); PG8_WAIT_L(0); PG8_BAR; PG8_MMA(1, 0, At, B0); PG8_MMA(1, 1, At, B1); PG8_BAR; PG8_SCHED;
            PG8_LDB(B0, 1, 0); PG8_LDB(B1, 1, 1); PG8_SCHED; PG8_LDA(At, 1, 0); PG8_STAGE_A(PG8_SA(0, 1), a2, xnrow, xent, 1);
            PG8_WAIT_V(8); PG8_WAIT_L(0); PG8_BAR; PG8_MMA(0, 0, At, B0); PG8_MMA(0, 1, At, B1); PG8_BAR; PG8_SCHED;
            PG8_LDA(At, 1, 1); PG8_STAGE(PG8_SB(1, 0), b3, voffB); PG8_STAGE(PG8_SB(1, 1), b3 + hstepB, voffB); PG8_STAGE_A(PG8_SA(1, 0), a3, xnrow, xent, 0);
            PG8_WAIT_V(8); PG8_WAIT_L(0); PG8_BAR; PG8_MMA(1, 0, At, B0); PG8_MMA(1, 1, At, B1); PG8_BAR; PG8_SCHED;
        }
        if (wr == 0) PG8_BAR;
        if constexpr (Sched::FP8) asm volatile("s_nop 15\n\ts_nop 15" ::: "memory");
        E(acc, cur, wr, wc, fr, fq, cent);
        if (!has_next) break;
#pragma unroll
        for (int a = 0; a < 2; ++a)
#pragma unroll
            for (int b = 0; b < 2; ++b)
#pragma unroll
                for (int m = 0; m < 4; ++m)
#pragma unroll
                    for (int n = 0; n < 2; ++n) acc[a][b][m][n] = (f32x4){0.f, 0.f, 0.f, 0.f};
        cur = nxt; cA = nA; cB = nB; ++ui;
        if (wr == 1) PG8_BAR;
    }
    PG8_WAIT_V(0);
    PG8_BAR;
#undef PG8_SA
#undef PG8_SB
#undef PG8_STAGE
#undef PG8_STAGE_A
#undef PG8_LDA
#undef PG8_LDB
#undef PG8_MMA
#undef PG8_WAIT_V
#undef PG8_WAIT_L
#undef PG8_BAR
#undef PG8_SCHED
}
}

constexpr int NWAVES = 8, NTHR = NWAVES * 64;
constexpr int D = 1024, BATCH = 4, SEQ = 8192, M = BATCH * SEQ;
constexpr int PW = 512, CW = 512, CK = 31, INC = 3584;
constexpr int NE = 256, TOPK = 8, NG = 8, EH = 256;
constexpr int ECAP = M;
constexpr int MAXT = (M * TOPK) / 256 + NE;
constexpr float XSCALE = 16.f, WSCALE = 128.f, HSCALE = 8.f, YSCALE = 64.f;
constexpr int E8_X = 0x7b7b7b7b, E8_W = 0x78787878, E8_H = 0x7c7c7c7c;
constexpr float LN_EPS = 1e-5f, ALPHA = 1.189207115002721f  , RSCALE = 2.5f;

constexpr size_t MiB = 1u << 20;
constexpr size_t WS_CTL = 0, CTL_ZERO_BYTES = 1 * MiB;
constexpr size_t WS_WIN = 1 * MiB;
constexpr size_t WS_POOL = 8 * MiB;
constexpr size_t WS_CVO = 8 * MiB + 512 * 1024;
constexpr size_t WS_WOUT = 10 * MiB;
constexpr size_t WS_RSH = 12 * MiB;
constexpr size_t WS_SDN = 14 * MiB;
constexpr size_t WS_EDN = 16 * MiB;
constexpr size_t WS_X18 = 96 * MiB;
constexpr size_t WS_X1 = 144 * MiB;
constexpr size_t WS_HS = 208 * MiB;
constexpr size_t WS_LIST = 224 * MiB;
constexpr size_t WS_HE = 288 * MiB;
constexpr size_t WS_EGU = 448 * MiB;
constexpr size_t WS_PH = 704 * MiB;
constexpr size_t WS_XB = WS_PH;
constexpr size_t WS_U = WS_PH + 64 * MiB, WS_V = WS_PH + 96 * MiB;
constexpr size_t WS_GP = WS_PH + 128 * MiB, WS_GC = WS_PH + 192 * MiB;
constexpr size_t WS_R = WS_PH + 256 * MiB, WS_C = WS_PH + 288 * MiB;
constexpr size_t WS_T1 = WS_XB;
constexpr size_t WS_MG = WS_U;
constexpr size_t WS_Z = WS_GP;
constexpr size_t WS_LOG = WS_HE;
constexpr size_t WS_END = 1024 * MiB;
constexpr size_t WS_Y = WS_EGU;
static_assert(WS_Y + (size_t)M * 8 * D * 2 <= WS_R, "Y slots end before R");
constexpr size_t WS_YSH = WS_R;
static_assert(WS_YSH + (size_t)M * D * 2 <= WS_END, "ws map");
static_assert(WS_HE + (size_t)MAXT * 256 * EH * 2 <= WS_EGU, "HE fits");
static_assert(WS_LIST + (size_t)NE * ECAP * 8 <= WS_HE, "LIST fits");

constexpr int CW_CNT = 32768;
constexpr int CW_BAR = 4096;

constexpr int RING_OFF = 0, RING_BYTES = 131072;
constexpr int TAB_OFF = RING_BYTES;
constexpr int ENT_OFF = TAB_OFF + 4096;
constexpr int MISC_OFF = ENT_OFF + 8192;
constexpr int LDS_BYTES = 147456;
static_assert(MISC_OFF + 128 <= LDS_BYTES, "LDS map");

#define GAS __attribute__((address_space(1)))
#define LAS __attribute__((address_space(3)))
typedef unsigned short bf16;
typedef unsigned v4u __attribute__((ext_vector_type(4)));
typedef unsigned v2u __attribute__((ext_vector_type(2)));
typedef float f32x4 __attribute__((ext_vector_type(4)));
typedef GAS unsigned gu32;
#define RLX_AGENT __ATOMIC_RELAXED, __HIP_MEMORY_SCOPE_AGENT
#define LDS_WAIT() asm volatile("s_waitcnt lgkmcnt(0)" ::: "memory")
#define VM_WAIT() asm volatile("s_waitcnt vmcnt(0)" ::: "memory")
__device__ __forceinline__ unsigned f2bf(float f) { unsigned u = __builtin_bit_cast(unsigned, f); return (u + 0x7fffu + ((u >> 16) & 1u)) >> 16; }
__device__ __forceinline__ unsigned pk2(float lo, float hi) { return pg8::cvt_pk_bf16(lo, hi); }

#define XB_TMO      128
#define XB_XCNT(j)  (256  + 64 * (j))
#define XB_XSUB(j)  (1280 + 64 * (j))
#define XB_XGEN(j)  (2304 + 64 * (j))
#define XB_TOP      3328
#define XB_TOPGEN   3392
#define XCD_BAR_WORDS 3456
#define XB_SPIN_CAP (1u << 20)
__device__ __forceinline__ unsigned xb_ld(unsigned* p)              { return __hip_atomic_load(p, __ATOMIC_RELAXED, __HIP_MEMORY_SCOPE_AGENT); }
__device__ __forceinline__ unsigned xb_add(unsigned* p, unsigned v) { return __hip_atomic_fetch_add(p, v, __ATOMIC_RELAXED, __HIP_MEMORY_SCOPE_AGENT); }
__device__ __forceinline__ unsigned xb_xcc_id() { return (unsigned)__builtin_amdgcn_s_getreg((3 << 11) | 20) & 0xFu; }
#define XB_SPIN(cond, bar) do { unsigned _sp = 0; while (cond) { __builtin_amdgcn_s_sleep(1); \
    if ((++_sp & 255u) == 0u) { if (xb_ld(&(bar)[XB_TMO])) break; if (_sp > XB_SPIN_CAP) { atomicAdd(&(bar)[XB_TMO], 1u); break; } } } } while (0)
struct XcdBarrier { unsigned* bar; unsigned x; volatile LAS unsigned* st; };
__device__ __forceinline__ XcdBarrier xcd_barrier_post(unsigned* bar, volatile LAS unsigned* st) {
    XcdBarrier b; b.bar = bar; b.x = xb_xcc_id(); b.st = st;
    if (threadIdx.x == 0) (void)xb_add(&bar[XB_XCNT(b.x)], 1u);
    return b;
}
__device__ __forceinline__ void xcd_barrier_complete(unsigned* bar, unsigned x, unsigned& nloc, unsigned& nx) {
    const unsigned G = gridDim.x * gridDim.y * gridDim.z;
    unsigned sum, cnt, mine, sp = 0u;
    for (;;) {
        sum = 0u; cnt = 0u; mine = 0u;
#pragma unroll
        for (unsigned j = 0; j < 16; ++j) { const unsigned c = xb_ld(&bar[XB_XCNT(j)]); sum += c; cnt += (c > 0u) ? 1u : 0u; mine = (j == x) ? c : mine; }
        if (sum == G) break;
        __builtin_amdgcn_s_sleep(1);
        if ((++sp & 255u) == 0u) { if (xb_ld(&bar[XB_TMO])) break; if (sp > XB_SPIN_CAP) { atomicAdd(&bar[XB_TMO], 1u); break; } }
    }
    nloc = mine > 0u ? mine : 1u; nx = cnt > 0u ? cnt : 1u;
}
__device__ __forceinline__ int lane_id();
__device__ __forceinline__ void xcd_barrier(const XcdBarrier& b, int wave) {
    asm volatile("s_waitcnt vmcnt(0)" ::: "memory");
    __syncthreads();
    if (wave == 0 && lane_id() == 0) {
        unsigned* bar = b.bar;
        __builtin_amdgcn_s_waitcnt(0);
        unsigned nloc = b.st[0], nx = b.st[1];
        if (nloc == 0u) { xcd_barrier_complete(bar, b.x, nloc, nx); b.st[0] = nloc; b.st[1] = nx; }
        const unsigned old = xb_add(&bar[XB_XSUB(b.x)], 1u);
        const unsigned gen = old / nloc;
        if (old + 1u == (gen + 1u) * nloc) {
            __builtin_amdgcn_fence(__ATOMIC_RELEASE, "agent");
            asm volatile("s_waitcnt vmcnt(0)" ::: "memory");
            const unsigned og = xb_add(&bar[XB_TOP], 1u);
            const unsigned tg = og / nx;
            if (og + 1u == (tg + 1u) * nx) xb_add(&bar[XB_TOPGEN], 1u);
            else XB_SPIN(xb_ld(&bar[XB_TOPGEN]) == tg, bar);
            __builtin_amdgcn_fence(__ATOMIC_ACQUIRE, "agent");
            xb_add(&bar[XB_XGEN(b.x)], 1u);
            asm volatile("s_waitcnt vmcnt(0)" ::: "memory");
        } else {
            XB_SPIN(xb_ld(&bar[XB_XGEN(b.x)]) == gen, bar);
            __builtin_amdgcn_fence(__ATOMIC_ACQUIRE, "agent");
            asm volatile("s_waitcnt vmcnt(0)" ::: "memory");
        }
    }
    __syncthreads();
}

struct Frame {
    LAS unsigned char* lds;
    volatile LAS unsigned* MISC;
    gu32* ctl;
    int wave;
    int vcu, G;
    const float* in[21]; float* out; unsigned char* ws;
};
__device__ __forceinline__ int lane_id() { int l; asm volatile("v_mbcnt_lo_u32_b32 %0, -1, 0\n\tv_mbcnt_hi_u32_b32 %0, -1, %0" : "=v"(l)); return l; }
__device__ __forceinline__ float wave_sum(float v) {
#pragma unroll
    for (int o = 1; o < 64; o <<= 1) v += __shfl_xor(v, o);
    return v;
}

__host__ __device__ __forceinline__ int xcd_chunk(int L, int nwg) {
    const int q = nwg / 8, r = nwg % 8, xcd = L % 8, off = L / 8;
    return (xcd < r ? xcd * (q + 1) : r * (q + 1) + (xcd - r) * q) + off;
}
struct DenseOrder {   static constexpr bool META = false, FP8 = false;
    const bf16* A; const bf16* Bt; int ldaB, ldbB, nt, acol_pn; int scaleA, scaleB;
    int nM, nN, nwg, G, c;
    __device__ __forceinline__ void init(const bf16* A_, const bf16* Bt_, int Mr, int N, int K, int lda_, int ldb_, int acol_pn_, int G_, int c_) {
        A = A_; Bt = Bt_; ldaB = lda_ * 2; ldbB = ldb_ * 2; nt = K / 64; acol_pn = acol_pn_; nM = Mr / 256; nN = N / 256; nwg = nM * nN; G = G_; c = c_; scaleA = 0; scaleB = 0; }
    __device__ __forceinline__ bool next(int i, pg8::Unit& u) const {
        const int L = i * G + c; if (L >= nwg) return false;
        const int wgid = xcd_chunk(L, nwg);
        const int nig = 8 * nN, gid = wgid / nig, fm = gid * 8, gsz = (nM - fm) < 8 ? (nM - fm) : 8;
        u.pm = fm + ((wgid % nig) % gsz); u.pn = (wgid % nig) / gsz; u.e = 0; u.r0 = 0; u.nrow = 256; return true;
    }
    __device__ __forceinline__ const char* a_ptr(const pg8::Unit& u) const { return (const char*)A + (size_t)u.pm * 256 * ldaB + u.pn * acol_pn * 2; }
    __device__ __forceinline__ const char* b_ptr(const pg8::Unit& u) const { return (const char*)Bt + (size_t)u.pn * 256 * ldbB; }
    __device__ __forceinline__ unsigned a_voff(int, const LAS unsigned char*, int rl, int C) const { return (unsigned)(rl * ldaB + C * 2); }
};
template <bool GATHER> struct ExpertOrder {
    static constexpr bool META = true, FP8 = true;
    const unsigned char* A; const unsigned char* Bt; int ldaB, ldbB, nt; size_t bstride;
    int scaleA, scaleB;
    const LAS int* tstart; const LAS int* cntl; const int* list;
    int nN, nwg, G, c;
    __device__ __forceinline__ bool next(int i, pg8::Unit& u) const {
        const int L = i * G + c; if (L >= nwg) return false;
        const int wgid = xcd_chunk(L, nwg);
        const int t = wgid / nN; u.pn = wgid % nN; u.pm = t;
        int lo = 0, hi = NE;
#pragma unroll
        for (int s = 0; s < 8; ++s) { const int mid = (lo + hi) >> 1; if (tstart[mid] <= t) lo = mid; else hi = mid; }
        u.e = lo; u.r0 = (t - tstart[lo]) * 256; u.nrow = cntl[lo] - u.r0; return true;
    }
    __device__ __forceinline__ const char* a_ptr(const pg8::Unit& u) const { return GATHER ? (const char*)A : (const char*)A + (size_t)u.pm * 256 * ldaB; }
    __device__ __forceinline__ const char* b_ptr(const pg8::Unit& u) const { return (const char*)Bt + (size_t)u.e * bstride + (size_t)u.pn * 256 * ldbB; }
    __device__ __forceinline__ void meta_issue(const pg8::Unit& u, LAS unsigned char* dst, int wid, int lane) const {
        const char* src = (const char*)(list + ((size_t)u.e * ECAP + u.r0) * 2) + wid * 256 + lane * 4;
        __builtin_amdgcn_global_load_lds((const unsigned*)src, (LAS unsigned*)(dst + wid * 256), 4, 0, 0);
    }
    __device__ __forceinline__ unsigned a_voff(int nrow, const LAS unsigned char* ent, int rl, int C) const {
        if (GATHER) { int slot = *(const volatile LAS int*)(ent + rl * 8); if (rl >= nrow) slot = 0; return (unsigned)((slot >> 3) * ldaB + C * 2); }
        return (unsigned)(rl * ldaB + C * 2);
    }
};

using pg8::f32x4; using pg8::u32x4; using pg8::pack8; using pg8::unpack8; using pg8::sigmoid4;
#define EPI_ROWS_BEGIN _Pragma("unroll") for (int ai = 0; ai < 2; ++ai) _Pragma("unroll") for (int m = 0; m < 4; ++m) { const int row = u.pm * 256 + ai * 128 + wr * 64 + m * 16 + fr;
#define EPI_ROWS_END }
#define UNROLL _Pragma("unroll")
typedef const pg8::f32x4 (&AccRef)[2][2][4][2];
__device__ __forceinline__ v2u pack8_fp8(f32x4 a, f32x4 b) {
    UNROLL for (int i = 0; i < 4; ++i) { a[i] = fminf(fmaxf(a[i], -448.f), 448.f); b[i] = fminf(fmaxf(b[i], -448.f), 448.f); }
    int p0 = __builtin_amdgcn_cvt_pk_fp8_f32(a[0], a[1], 0, false); p0 = __builtin_amdgcn_cvt_pk_fp8_f32(a[2], a[3], p0, true);
    int p1 = __builtin_amdgcn_cvt_pk_fp8_f32(b[0], b[1], 0, false); p1 = __builtin_amdgcn_cvt_pk_fp8_f32(b[2], b[3], p1, true);
    v2u r; r.x = (unsigned)p0; r.y = (unsigned)p1; return r; }
__device__ __forceinline__ f32x4 unpack4_fp8(unsigned w) { const auto lo = __builtin_amdgcn_cvt_pk_f32_fp8((int)w, false), hi = __builtin_amdgcn_cvt_pk_f32_fp8((int)w, true); return (f32x4){lo[0], lo[1], hi[0], hi[1]}; }
struct EpiProj { static constexpr bool PERM = true; bf16 *U, *V, *GP, *GC;
    __device__ __forceinline__ void operator()(AccRef acc, const pg8::Unit& u, int wr, int wc, int fr, int fq, const LAS unsigned char* ent) const {
        const int cb = wc * 32 + 8 * fq;
        if (u.pn < 2) {
            EPI_ROWS_BEGIN
                bf16* p = U + (size_t)row * PW + u.pn * 256 + cb;
                UNROLL for (int bj = 0; bj < 2; ++bj) *(u32x4*)(p + bj * 128) = pack8(acc[ai][bj][m][0], acc[ai][bj][m][1]);
            EPI_ROWS_END
        } else if (u.pn < 6) {
            const int j = u.pn - 2;
            EPI_ROWS_BEGIN
                bf16* p = V + (size_t)row * CW + j * 128 + cb;
                *(u32x4*)p = pack8(acc[ai][0][m][0] * sigmoid4(acc[ai][1][m][0]), acc[ai][0][m][1] * sigmoid4(acc[ai][1][m][1]));
            EPI_ROWS_END
        } else {
            bf16* Gt = (u.pn < 10) ? GP : GC; const int t = (u.pn - 6) & 3;
            EPI_ROWS_BEGIN
                bf16* p = Gt + (size_t)row * D + t * 256 + cb;
                UNROLL for (int bj = 0; bj < 2; ++bj) *(u32x4*)(p + bj * 128) = pack8(sigmoid4(acc[ai][bj][m][0]), sigmoid4(acc[ai][bj][m][1]));
            EPI_ROWS_END
        }
    }
};
struct EpiPool { static constexpr bool PERM = true; const float* scale; const bf16* GP; bf16* T1;
    __device__ __forceinline__ void operator()(AccRef acc, const pg8::Unit& u, int wr, int wc, int fr, int fq, const LAS unsigned char* ent) const {
        const int c0 = u.pn * 256 + wc * 32 + 8 * fq; const int row0 = u.pm * 256 + wr * 64 + fr;
        UNROLL for (int bj = 0; bj < 2; ++bj) {
            const f32x4 sc0 = *(const f32x4*)(scale + c0 + bj * 128), sc1 = *(const f32x4*)(scale + c0 + bj * 128 + 4);
            u32x4 g[2][4];
            UNROLL for (int ai = 0; ai < 2; ++ai) UNROLL for (int m = 0; m < 4; ++m) g[ai][m] = *(const u32x4*)(GP + (size_t)(row0 + ai * 128 + m * 16) * D + c0 + bj * 128);
            UNROLL for (int ai = 0; ai < 2; ++ai) UNROLL for (int m = 0; m < 4; ++m) { f32x4 g0, g1; unpack8(g[ai][m], g0, g1);
                *(u32x4*)(T1 + (size_t)(row0 + ai * 128 + m * 16) * D + c0 + bj * 128) = pack8(acc[ai][bj][m][0] * sc0 * g0, acc[ai][bj][m][1] * sc1 * g1); }
        }
    }
};
struct EpiConvOut { static constexpr bool PERM = true; const bf16* T1; const bf16* GC; bf16* MG;
    __device__ __forceinline__ void operator()(AccRef acc, const pg8::Unit& u, int wr, int wc, int fr, int fq, const LAS unsigned char* ent) const {
        const int c0 = u.pn * 256 + wc * 32 + 8 * fq; const int row0 = u.pm * 256 + wr * 64 + fr;
        UNROLL for (int bj = 0; bj < 2; ++bj)
            UNROLL for (int ai = 0; ai < 2; ++ai) {
                u32x4 g[4], t[4];
                UNROLL for (int m = 0; m < 4; ++m) { const size_t o = (size_t)(row0 + ai * 128 + m * 16) * D + c0 + bj * 128; g[m] = *(const u32x4*)(GC + o); t[m] = *(const u32x4*)(T1 + o); }
                UNROLL for (int m = 0; m < 4; ++m) { const size_t o = (size_t)(row0 + ai * 128 + m * 16) * D + c0 + bj * 128; f32x4 g0, g1, t0, t1; unpack8(g[m], g0, g1); unpack8(t[m], t0, t1);
                    *(u32x4*)(MG + o) = pack8(t0 + acc[ai][bj][m][0] * g0, t1 + acc[ai][bj][m][1] * g1); }
                asm volatile("" ::: "memory");
            }
    }
};
struct EpiWout { static constexpr bool PERM = true; const float* X; float* Z;
    __device__ __forceinline__ void operator()(AccRef acc, const pg8::Unit& u, int wr, int wc, int fr, int fq, const LAS unsigned char* ent) const {
        const int c0 = u.pn * 256 + wc * 32 + 8 * fq; const int row0 = u.pm * 256 + wr * 64 + fr;
        UNROLL for (int bj = 0; bj < 2; ++bj)
            UNROLL for (int ai = 0; ai < 2; ++ai) {
                f32x4 x0[4], x1[4];
                UNROLL for (int m = 0; m < 4; ++m) { const size_t o = (size_t)(row0 + ai * 128 + m * 16) * D + c0 + bj * 128; x0[m] = *(const f32x4*)(X + o); x1[m] = *(const f32x4*)(X + o + 4); }
                UNROLL for (int m = 0; m < 4; ++m) { const size_t o = (size_t)(row0 + ai * 128 + m * 16) * D + c0 + bj * 128;
                    *(f32x4*)(Z + o) = x0[m] * ALPHA + acc[ai][bj][m][0]; *(f32x4*)(Z + o + 4) = x1[m] * ALPHA + acc[ai][bj][m][1]; }
                asm volatile("" ::: "memory");
            }
    }
};
__device__ __forceinline__ f32x4 silu_mul4(const f32x4 g, const f32x4 v) { return g * sigmoid4(g) * v; }
struct EpiRSh { static constexpr bool PERM = true; float* LOG; bf16* HS;
    __device__ __forceinline__ void operator()(AccRef acc, const pg8::Unit& u, int wr, int wc, int fr, int fq, const LAS unsigned char* ent) const {
        const int cb = wc * 32 + 8 * fq;
        if (u.pn == 0) {
            EPI_ROWS_BEGIN
                float* p = LOG + (size_t)row * NE + cb;
                UNROLL for (int bj = 0; bj < 2; ++bj) { *(f32x4*)(p + bj * 128) = acc[ai][bj][m][0]; *(f32x4*)(p + bj * 128 + 4) = acc[ai][bj][m][1]; }
            EPI_ROWS_END
        } else {
            const int j = u.pn - 1;
            EPI_ROWS_BEGIN
                bf16* p = HS + (size_t)row * EH + j * 128 + cb;
                *(u32x4*)p = pack8(silu_mul4(acc[ai][0][m][0], acc[ai][1][m][0]), silu_mul4(acc[ai][0][m][1], acc[ai][1][m][1]));
            EPI_ROWS_END
        }
    }
};
struct EpiEGU { static constexpr bool PERM = true; unsigned char* HE;
    __device__ __forceinline__ void operator()(AccRef acc, const pg8::Unit& u, int wr, int wc, int fr, int fq, const LAS unsigned char* ent) const {
        const int cb = wc * 32 + 8 * fq;
        EPI_ROWS_BEGIN
            unsigned char* p = HE + (size_t)row * EH + u.pn * 128 + cb;
            *(v2u*)p = pack8_fp8(silu_mul4(acc[ai][0][m][0], acc[ai][1][m][0]) * HSCALE, silu_mul4(acc[ai][0][m][1], acc[ai][1][m][1]) * HSCALE);
        EPI_ROWS_END
    }
};
struct EpiEDown { static constexpr bool PERM = true; unsigned char* Y;
    __device__ __forceinline__ void operator()(AccRef acc, const pg8::Unit& u, int wr, int wc, int fr, int fq, const LAS unsigned char* ent) const {
        const unsigned cbyte = (unsigned)(u.pn * 256 + wc * 32 + 8 * fq);
        UNROLL for (int ai = 0; ai < 2; ++ai)
            UNROLL for (int m = 0; m < 4; ++m) { const int rl = ai * 128 + wr * 64 + m * 16 + fr;
                if (rl < u.nrow) { const v2u e2 = *(const LAS v2u*)(ent + rl * 8); const float w = __uint_as_float(e2.y) * YSCALE;
                    const unsigned off = e2.x * (unsigned)D + cbyte;
                    UNROLL for (int bj = 0; bj < 2; ++bj) *(v2u*)(Y + off + bj * 128) = pack8_fp8(acc[ai][bj][m][0] * w, acc[ai][bj][m][1] * w); }
                asm volatile("" ::: "memory"); }
    }
};
struct EpiSDown { static constexpr bool PERM = true; bf16* YS;
    __device__ __forceinline__ void operator()(AccRef acc, const pg8::Unit& u, int wr, int wc, int fr, int fq, const LAS unsigned char* ent) const {
        const int c0 = u.pn * 256 + wc * 32 + 8 * fq;
        EPI_ROWS_BEGIN
            bf16* p = YS + (size_t)row * D + c0;
            UNROLL for (int bj = 0; bj < 2; ++bj) *(u32x4*)(p + bj * 128) = pack8(acc[ai][bj][m][0], acc[ai][bj][m][1]);
        EPI_ROWS_END
    }
};

__device__ __forceinline__ void p0_item(const float* W, int N, bf16* WT, int ldw, int k0, int n0, int drow0, LAS float* scr, int lane) {
#pragma unroll 8
    for (int i = 0; i < 32; ++i) { const int kk = 2 * i + (lane >> 5); scr[kk * 33 + (lane & 31)] = W[(size_t)(k0 + kk) * N + n0 + (lane & 31)]; }
    LDS_WAIT(); asm volatile("" ::: "memory");
    const int c = lane & 7;
#pragma unroll
    for (int j = 0; j < 4; ++j) { const int n = (lane >> 3) + 8 * j; const LAS float* s = scr + (8 * c) * 33 + n;
        v4u o; o.x = pk2(s[0 * 33], s[1 * 33]); o.y = pk2(s[2 * 33], s[3 * 33]); o.z = pk2(s[4 * 33], s[5 * 33]); o.w = pk2(s[6 * 33], s[7 * 33]);
        *(GAS v4u*)(WT + (size_t)(drow0 + n) * ldw + k0 + 8 * c) = o; }
    LDS_WAIT(); asm volatile("" ::: "memory");
}
__device__ __forceinline__ void p0_item_fp8(const float* W, int N, unsigned char* WT, int ldw, int k0, int n0, int drow0, LAS float* scr, int lane) {
#pragma unroll 8
    for (int i = 0; i < 32; ++i) { const int kk = 2 * i + (lane >> 5); scr[kk * 33 + (lane & 31)] = W[(size_t)(k0 + kk) * N + n0 + (lane & 31)]; }
    LDS_WAIT(); asm volatile("" ::: "memory");
    const int c = lane & 3;
#pragma unroll
    for (int j = 0; j < 2; ++j) { const int n = (lane >> 2) + 16 * j; const LAS float* s = scr + (16 * c) * 33 + n;
        f32x4 a, b, c2, d;
        a = (f32x4){s[0 * 33], s[1 * 33], s[2 * 33], s[3 * 33]} * WSCALE; b = (f32x4){s[4 * 33], s[5 * 33], s[6 * 33], s[7 * 33]} * WSCALE;
        c2 = (f32x4){s[8 * 33], s[9 * 33], s[10 * 33], s[11 * 33]} * WSCALE; d = (f32x4){s[12 * 33], s[13 * 33], s[14 * 33], s[15 * 33]} * WSCALE;
        const v2u lo = pack8_fp8(a, b), hi = pack8_fp8(c2, d); v4u o; o.x = lo.x; o.y = lo.y; o.z = hi.x; o.w = hi.y;
        *(GAS v4u*)(WT + (size_t)(drow0 + n) * ldw + k0 + 16 * c) = o; }
    LDS_WAIT(); asm volatile("" ::: "memory");
}
__device__ __forceinline__ int win_row(int n0) {
    if (n0 < 512) return n0;
    if (n0 < 1024) { const int q = n0 - 512; return 512 + (q >> 7) * 256 + (q & 127); }
    if (n0 < 1536) { const int q = n0 - 1024; return 512 + (q >> 7) * 256 + 128 + (q & 127); }
    return n0;
}
__device__ __forceinline__ int gu_row(int n0, int up) { return (n0 >> 7) * 256 + up * 128 + (n0 & 127); }
__device__ __forceinline__ void p0_prologue(Frame& F) {
    LAS float* scr = (LAS float*)(F.lds + RING_OFF + F.wave * 16384);
    const int lane = lane_id(), tid = F.wave * 64 + lane;
    const int gw = F.vcu * NWAVES + F.wave, NGW = F.G * NWAVES;
    unsigned char* ws = F.ws;
    constexpr int I_WIN = 16 * 112, I_POOL = 4 * 16, I_CVO = 8 * 32, I_WOUT = 16 * 32, I_RT = 16 * 8, I_SG = 128, I_SU = 128, I_SD = 4 * 32, I_EG = NE * 128, I_EU = NE * 128, I_ED = NE * 128;
    constexpr int NITEMS = I_WIN + I_POOL + I_CVO + I_WOUT + I_RT + I_SG + I_SU + I_SD + I_EG + I_EU + I_ED;
    for (int it = gw; it < NITEMS; it += NGW) {
        int r = it;
        if (r < I_EG) { const int e = r >> 7, rr = r & 127, kb = rr >> 3, nb = rr & 7;
            p0_item_fp8(F.in[13] + (size_t)e * D * EH, EH, ws + WS_EGU + (size_t)e * 512 * D, D, 64 * kb, 32 * nb, gu_row(32 * nb, 0), scr, lane); continue; } r -= I_EG;
        if (r < I_EU) { const int e = r >> 7, rr = r & 127, kb = rr >> 3, nb = rr & 7;
            p0_item_fp8(F.in[14] + (size_t)e * D * EH, EH, ws + WS_EGU + (size_t)e * 512 * D, D, 64 * kb, 32 * nb, gu_row(32 * nb, 1), scr, lane); continue; } r -= I_EU;
        if (r < I_ED) { const int e = r >> 7, rr = r & 127, kb = rr >> 5, nb = rr & 31;
            p0_item_fp8(F.in[15] + (size_t)e * EH * D, D, ws + WS_EDN + (size_t)e * D * EH, EH, 64 * kb, 32 * nb, 32 * nb, scr, lane); continue; } r -= I_ED;
        if (r < I_WIN) { const int kb = r / 112, nb = r % 112; p0_item(F.in[1], INC, (bf16*)(ws + WS_WIN), D, 64 * kb, 32 * nb, win_row(32 * nb), scr, lane); continue; } r -= I_WIN;
        if (r < I_POOL) { const int g = r >> 4, rr = r & 15, kb = rr >> 3, nb = rr & 7;
            p0_item(F.in[2] + (size_t)g * 128 * 256, 256, (bf16*)(ws + WS_POOL) + (size_t)g * 256 * 128, 128, 64 * kb, 32 * nb, 32 * nb, scr, lane); continue; } r -= I_POOL;
        if (r < I_CVO) { const int kb = r >> 5, nb = r & 31; p0_item(F.in[7], D, (bf16*)(ws + WS_CVO), CW, 64 * kb, 32 * nb, 32 * nb, scr, lane); continue; } r -= I_CVO;
        if (r < I_WOUT) { const int kb = r >> 5, nb = r & 31; p0_item(F.in[8], D, (bf16*)(ws + WS_WOUT), D, 64 * kb, 32 * nb, 32 * nb, scr, lane); continue; } r -= I_WOUT;
        if (r < I_RT) { const int kb = r >> 3, nb = r & 7; p0_item(F.in[11], NE, (bf16*)(ws + WS_RSH), D, 64 * kb, 32 * nb, 32 * nb, scr, lane); continue; } r -= I_RT;
        if (r < I_SG) { const int kb = r >> 3, nb = r & 7; p0_item(F.in[16], EH, (bf16*)(ws + WS_RSH), D, 64 * kb, 32 * nb, 256 + gu_row(32 * nb, 0), scr, lane); continue; } r -= I_SG;
        if (r < I_SU) { const int kb = r >> 3, nb = r & 7; p0_item(F.in[17], EH, (bf16*)(ws + WS_RSH), D, 64 * kb, 32 * nb, 256 + gu_row(32 * nb, 1), scr, lane); continue; } r -= I_SU;
        { const int kb = r >> 5, nb = r & 31; p0_item(F.in[18], D, (bf16*)(ws + WS_SDN), EH, 64 * kb, 32 * nb, 32 * nb, scr, lane); }
    }
    const GAS f32x4* x4 = (const GAS f32x4*)F.in[0]; GAS v4u* xb = (GAS v4u*)(ws + WS_XB);
    for (int i = (int)blockIdx.x * NTHR + tid; i < M * D / 8; i += F.G * NTHR) { const f32x4 a = x4[2 * i], b = x4[2 * i + 1];
        v4u o; o.x = pk2(a.x, a.y); o.y = pk2(a.z, a.w); o.z = pk2(b.x, b.y); o.w = pk2(b.z, b.w); xb[i] = o; }
}

__device__ __forceinline__ void ld8(const LAS unsigned char* p, float (&v)[8]) { const v4u w = *(const LAS v4u*)p;
    v[0] = pg8::bf_lo(w.x); v[1] = pg8::bf_hi(w.x); v[2] = pg8::bf_lo(w.y); v[3] = pg8::bf_hi(w.y); v[4] = pg8::bf_lo(w.z); v[5] = pg8::bf_hi(w.z); v[6] = pg8::bf_lo(w.w); v[7] = pg8::bf_hi(w.w); }
__device__ __forceinline__ void p2_mixer(Frame& F) {
    constexpr int TT = 32, VR = TT + CK - 1  , UR = TT + 15  , DW_BYTES = CK * CW * 4  ;
    LAS unsigned char* ldw = F.lds; LAS unsigned char* lrow = F.lds + DW_BYTES;
    const bf16* U = (const bf16*)(F.ws + WS_U); const bf16* V = (const bf16*)(F.ws + WS_V); bf16* Rb = (bf16*)(F.ws + WS_R); bf16* Cb = (bf16*)(F.ws + WS_C);
    const int lane = lane_id(), w = F.wave, tid = w * 64 + lane;
    for (int i = tid; i < CK * CW / 4; i += NTHR) *(LAS f32x4*)(ldw + 16 * i) = *(const GAS f32x4*)(F.in[4] + 4 * i);
    for (int i = tid; i < 128; i += NTHR) *(LAS v4u*)(lrow + 62 * 1024 + 16 * i) = (v4u){0u, 0u, 0u, 0u};
    float lg[8], lb[8];
#pragma unroll
    for (int k = 0; k < 8; ++k) { lg[k] = F.in[5][lane * 8 + k]; lb[k] = F.in[6][lane * 8 + k]; }
    const int W = 2 << (lane >> 4);
    for (int unit = F.vcu; unit < M / TT; unit += F.G) {
        const int t0 = unit * TT, s0 = t0 % SEQ;
        __syncthreads();
        for (int c = tid; c < VR * 64; c += NTHR) { const int row = c >> 6, q = c & 63; const int s = s0 - (CK - 1) + row;
            v4u val = (v4u){0u, 0u, 0u, 0u}; if (s >= 0) val = *(const GAS v4u*)(V + (size_t)(t0 - (CK - 1) + row) * CW + q * 8);
            *(LAS v4u*)(lrow + row * 1024 + q * 16) = val; }
        __syncthreads();
        {
            float acc[4][8], wr_[4][8];
#pragma unroll
            for (int q = 0; q < 4; ++q)
#pragma unroll
                for (int k = 0; k < 8; ++k) { acc[q][k] = 0.f; wr_[q][k] = 0.f; }
#pragma unroll 1
            for (int i4 = 0; i4 < 9; ++i4) {
#pragma unroll
                for (int ii = 0; ii < 4; ++ii) { const int i = 4 * i4 + ii;
                    f32x4 a = (f32x4){0.f, 0.f, 0.f, 0.f}, b = a;
                    if (i <= 30) { a = *(const LAS f32x4*)(ldw + i * 2048 + lane * 32); b = *(const LAS f32x4*)(ldw + i * 2048 + lane * 32 + 16); }
                    wr_[ii][0] = a.x; wr_[ii][1] = a.y; wr_[ii][2] = a.z; wr_[ii][3] = a.w; wr_[ii][4] = b.x; wr_[ii][5] = b.y; wr_[ii][6] = b.z; wr_[ii][7] = b.w;
                    float v[8]; ld8(lrow + (4 * w + i) * 1024 + lane * 16, v);
#pragma unroll
                    for (int q = 0; q < 4; ++q) {
#pragma unroll
                        for (int k = 0; k < 8; ++k) acc[q][k] = fmaf(v[k], wr_[(ii - q) & 3][k], acc[q][k]); }
                }
            }
#pragma unroll
            for (int q = 0; q < 4; ++q) {
                float s = 0.f;
#pragma unroll
                for (int k = 0; k < 8; ++k) s += acc[q][k];
                const float mean = wave_sum(s) * (1.f / CW); float s2 = 0.f;
#pragma unroll
                for (int k = 0; k < 8; ++k) { acc[q][k] -= mean; s2 += acc[q][k] * acc[q][k]; }
                const float rstd = 1.f / sqrtf(wave_sum(s2) * (1.f / CW) + LN_EPS);
                float y[8];
#pragma unroll
                for (int k = 0; k < 8; ++k) { const float z = acc[q][k] * rstd * lg[k] + lb[k]; y[k] = z * pg8::sigmoidf_(z); }
                v4u o; o.x = pk2(y[0], y[1]); o.y = pk2(y[2], y[3]); o.z = pk2(y[4], y[5]); o.w = pk2(y[6], y[7]);
                *(GAS v4u*)(Cb + (size_t)(t0 + 4 * w + q) * CW + lane * 8) = o;
            }
        }
        __syncthreads();
        for (int c = tid; c < UR * 64; c += NTHR) { const int row = c >> 6, q = c & 63; const int s = s0 - 15 + row;
            v4u val = (v4u){0u, 0u, 0u, 0u}; if (s >= 0) val = *(const GAS v4u*)(U + (size_t)(t0 - 15 + row) * PW + q * 8);
            *(LAS v4u*)(lrow + row * 1024 + q * 16) = val; }
        __syncthreads();
        {
            float acc[4][8], own[4][8];
#pragma unroll
            for (int q = 0; q < 4; ++q)
#pragma unroll
                for (int k = 0; k < 8; ++k) { acc[q][k] = 0.f; own[q][k] = 0.f; }
#pragma unroll
            for (int i = 0; i < 19; ++i) {
                float v[8]; ld8(lrow + (4 * w + i) * 1024 + lane * 16, v);
#pragma unroll
                for (int q = 0; q < 4; ++q) { const int d = q + 15 - i; if (d >= 0 && d <= 15) { const bool in = d < W;
#pragma unroll
                    for (int k = 0; k < 8; ++k) { acc[q][k] += in ? v[k] : 0.f; if (d == 0) own[q][k] = v[k]; } } }
            }
#pragma unroll
            for (int q = 0; q < 4; ++q) { const int s = s0 + 4 * w + q; const int cnt = (s + 1) < W ? (s + 1) : W; const float inv = 1.f / (float)cnt;
                float y[8];
#pragma unroll
                for (int k = 0; k < 8; ++k) y[k] = acc[q][k] * inv - own[q][k];
                v4u o; o.x = pk2(y[0], y[1]); o.y = pk2(y[2], y[3]); o.z = pk2(y[4], y[5]); o.w = pk2(y[6], y[7]);
                *(GAS v4u*)(Rb + (size_t)(t0 + 4 * w + q) * PW + lane * 8) = o; }
        }
    }
    __syncthreads();
}

__device__ __forceinline__ void p6_ln1(Frame& F) {
    const int lane = lane_id();
    const int gw = F.vcu * NWAVES + F.wave, NGW = F.G * NWAVES;
    const float* Z = (const float*)(F.ws + WS_Z); bf16* X1 = (bf16*)(F.ws + WS_X1); unsigned char* X18 = F.ws + WS_X18;
    f32x4 g[4], b[4];
#pragma unroll
    for (int j = 0; j < 4; ++j) { g[j] = *(const GAS f32x4*)(F.in[9] + 4 * lane + 256 * j); b[j] = *(const GAS f32x4*)(F.in[10] + 4 * lane + 256 * j); }
    for (int m = gw; m < M; m += NGW) {
        const GAS f32x4* zr = (const GAS f32x4*)(Z + (size_t)m * D) + lane;
        f32x4 v[4]; float s = 0.f;
#pragma unroll
        for (int j = 0; j < 4; ++j) { v[j] = zr[64 * j]; s += (v[j].x + v[j].y) + (v[j].z + v[j].w); }
        const float mean = wave_sum(s) * (1.f / D); float s2 = 0.f;
#pragma unroll
        for (int j = 0; j < 4; ++j) { v[j] = v[j] - mean; s2 += (v[j].x * v[j].x + v[j].y * v[j].y) + (v[j].z * v[j].z + v[j].w * v[j].w); }
        const float rstd = 1.f / sqrtf(wave_sum(s2) * (1.f / D) + LN_EPS);
        GAS v2u* o8 = (GAS v2u*)(X1 + (size_t)m * D) + lane;
#pragma unroll
        for (int j = 0; j < 4; ++j) { const f32x4 y = v[j] * rstd * g[j] + b[j]; v2u o; o.x = pk2(y.x, y.y); o.y = pk2(y.z, y.w); o8[64 * j] = o;
            const v2u q = pack8_fp8(y * XSCALE, y * XSCALE); *(GAS unsigned*)(X18 + (size_t)m * D + 4 * lane + 256 * j) = q.x; }
    }
}

__device__ __forceinline__ void route_token(const f32x4 lg, const f32x4 bias, int lane, int& myidx, float& wgt) {
    const float NEG = -__builtin_inff();
    const float sc0 = 1.f / (1.f + __expf(-lg.x)), sc1 = 1.f / (1.f + __expf(-lg.y)), sc2 = 1.f / (1.f + __expf(-lg.z)), sc3 = 1.f / (1.f + __expf(-lg.w));
    float c0 = sc0 + bias.x, c1 = sc1 + bias.y, c2 = sc2 + bias.z, c3 = sc3 + bias.w;
    const float h01 = fmaxf(c0, c1), l01 = fminf(c0, c1), h23 = fmaxf(c2, c3), l23 = fminf(c2, c3);
    float m1 = fmaxf(h01, h23), m2 = fmaxf(fminf(h01, h23), fmaxf(l01, l23));
#pragma unroll
    for (int o = 1; o < 8; o <<= 1) { const float b1 = __shfl_xor(m1, o), b2 = __shfl_xor(m2, o); const float n1 = fmaxf(m1, b1), n2 = fmaxf(fminf(m1, b1), fmaxf(m2, b2)); m1 = n1; m2 = n2; }
    const float gs = m1 + m2; const int mygrp = lane >> 3; int rank = 0;
#pragma unroll
    for (int g = 0; g < NG; ++g) { const float og = __shfl(gs, g * 8); rank += (og > gs || (og == gs && g < mygrp)) ? 1 : 0; }
    if (rank >= 4) { c0 = NEG; c1 = NEG; c2 = NEG; c3 = NEG; }
    float sumw = 0.f, mysc = 0.f; myidx = 0;
#pragma unroll
    for (int r = 0; r < TOPK; ++r) {
        float bv = c0, bs = sc0; int gi = 4 * lane;
        if (c1 > bv) { bv = c1; bs = sc1; gi = 4 * lane + 1; }
        if (c2 > bv) { bv = c2; bs = sc2; gi = 4 * lane + 2; }
        if (c3 > bv) { bv = c3; bs = sc3; gi = 4 * lane + 3; }
#pragma unroll
        for (int o = 32; o >= 1; o >>= 1) { const float ov = __shfl_xor(bv, o), os = __shfl_xor(bs, o); const int oi = __shfl_xor(gi, o);
            const bool take = (ov > bv) || (ov == bv && oi < gi); if (take) { bv = ov; bs = os; gi = oi; } }
        if (lane == r) { myidx = gi; mysc = bs; }
        sumw += bs;
        if (gi == 4 * lane) c0 = NEG; if (gi == 4 * lane + 1) c1 = NEG; if (gi == 4 * lane + 2) c2 = NEG; if (gi == 4 * lane + 3) c3 = NEG;
    }
    wgt = mysc / sumw * RSCALE;
}
__device__ __forceinline__ void p8_route(Frame& F, int dummy = 0) {
    const int lane = lane_id(), tid = F.wave * 64 + lane;
    const int gw = F.vcu * NWAVES + F.wave, NGW = F.G * NWAVES;
    const float* LOG = (const float*)(F.ws + WS_LOG); int* list = (int*)(F.ws + (dummy ? WS_HE + 96 * MiB : WS_LIST)); unsigned* cnt = (unsigned*)F.ctl + (dummy ? CW_CNT + 32768 : CW_CNT);
    LAS unsigned* lcnt = (LAS unsigned*)(F.lds + TAB_OFF); LAS unsigned* lbase = lcnt + NE;
    const f32x4 bias = *(const GAS f32x4*)(F.in[12] + 4 * lane);
    constexpr int NB = 4, NTW = 16;
    if (tid < NE) lcnt[tid] = 0u;
    __syncthreads();
    int idx[NTW]; float wg[NTW]; unsigned rk[NTW];
#pragma unroll
    for (int g = 0; g < NTW / NB; ++g) {
        f32x4 lg[NB];
#pragma unroll
        for (int b = 0; b < NB; ++b) { const int tok = gw * NTW + g * NB + b; lg[b] = *(const GAS f32x4*)(LOG + (size_t)(tok < M ? tok : 0) * NE + 4 * lane); }
#pragma unroll
        for (int b = 0; b < NB; ++b) { route_token(lg[b], bias, lane, idx[g * NB + b], wg[g * NB + b]);
            rk[g * NB + b] = 0u; if (lane < TOPK && gw * NTW + g * NB + b < M) rk[g * NB + b] = __hip_atomic_fetch_add(&lcnt[idx[g * NB + b]], 1u, __ATOMIC_RELAXED, __HIP_MEMORY_SCOPE_WORKGROUP); }
    }
    __syncthreads();
    if (tid < NE) { const unsigned c = lcnt[tid]; unsigned base = 0u; if (c) base = atomicAdd(&cnt[tid * 64], c); lbase[tid] = base; }
    __syncthreads();
    if (lane < TOPK) {
#pragma unroll
        for (int b = 0; b < NTW; ++b) { const int tok = gw * NTW + b;
            if (tok < M) { v2u ent; ent.x = (unsigned)(tok * TOPK + lane); ent.y = __float_as_uint(wg[b]); *(GAS v2u*)(list + ((size_t)idx[b] * ECAP + lbase[idx[b]] + rk[b]) * 2) = ent; } }
    }
    __syncthreads();
}

__device__ __forceinline__ int expert_table(Frame& F) {
    LAS int* tstart = (LAS int*)(F.lds + TAB_OFF); LAS int* cntl = tstart + 260; LAS int* wtot = tstart + 520;
    const unsigned* cnt = (const unsigned*)F.ctl + CW_CNT;
    const int lane = lane_id(), tid = F.wave * 64 + lane;
    __syncthreads();
    int c = 0, incl = 0;
    if (tid < NE) { c = (int)__hip_atomic_load(cnt + tid * 64, RLX_AGENT); incl = (c + 255) >> 8;
#pragma unroll
        for (int o = 1; o < 64; o <<= 1) { const int up = __shfl_up(incl, o); if (lane >= o) incl += up; }
        if (lane == 63) wtot[F.wave] = incl; cntl[tid] = c; }
    __syncthreads();
    if (tid < NE) { int base = 0;
#pragma unroll
        for (int k = 0; k < 4; ++k) if (k < F.wave) base += wtot[k];
        tstart[tid + 1] = base + incl; if (tid == 0) tstart[0] = 0; }
    __syncthreads();
    return tstart[NE];
}

__device__ __forceinline__ void p11_combine(Frame& F) {
    const int lane = lane_id();
    const int gw = F.vcu * NWAVES + F.wave, NGW = F.G * NWAVES;
    const unsigned char* Y = F.ws + WS_Y; const bf16* YS = (const bf16*)(F.ws + WS_YSH); const bf16* X1 = (const bf16*)(F.ws + WS_X1);
    for (int tok = gw; tok < M; tok += NGW) {
        f32x4 a[4];
#pragma unroll
        for (int j = 0; j < 2; ++j) { f32x4 x0, x1; unpack8(*(const GAS v4u*)(X1 + (size_t)tok * D + lane * 16 + 8 * j), x0, x1); a[2 * j] = x0 * ALPHA; a[2 * j + 1] = x1 * ALPHA;
            f32x4 s0, s1; unpack8(*(const GAS v4u*)(YS + (size_t)tok * D + lane * 16 + 8 * j), s0, s1); a[2 * j] += s0; a[2 * j + 1] += s1; }
#if !(defined(DBG_COMBINE) && (DBG_COMBINE & 1))
        f32x4 r[4] = {(f32x4){0.f, 0.f, 0.f, 0.f}, (f32x4){0.f, 0.f, 0.f, 0.f}, (f32x4){0.f, 0.f, 0.f, 0.f}, (f32x4){0.f, 0.f, 0.f, 0.f}};
#pragma unroll
        for (int k = 0; k < TOPK; ++k) { const v4u q = *(const GAS v4u*)(Y + ((size_t)tok * TOPK + k) * D + lane * 16);
            r[0] += unpack4_fp8(q.x); r[1] += unpack4_fp8(q.y); r[2] += unpack4_fp8(q.z); r[3] += unpack4_fp8(q.w); }
#pragma unroll
        for (int j = 0; j < 4; ++j) a[j] += r[j] * (1.f / YSCALE);
#endif
        float s = 0.f;
#pragma unroll
        for (int j = 0; j < 4; ++j) s += (a[j].x + a[j].y) + (a[j].z + a[j].w);
        const float mean = wave_sum(s) * (1.f / D); float s2 = 0.f;
#pragma unroll
        for (int j = 0; j < 4; ++j) { a[j] = a[j] - mean; s2 += (a[j].x * a[j].x + a[j].y * a[j].y) + (a[j].z * a[j].z + a[j].w * a[j].w); }
        const float rstd = 1.f / sqrtf(wave_sum(s2) * (1.f / D) + LN_EPS);
#pragma unroll
        for (int j = 0; j < 4; ++j) { const int col = lane * 16 + 4 * j;
            const f32x4 g = *(const GAS f32x4*)(F.in[19] + col), b = *(const GAS f32x4*)(F.in[20] + col);
            *(GAS f32x4*)(F.out + (size_t)tok * D + col) = a[j] * rstd * g + b; }
    }
}
#ifdef DBG_CHECK
constexpr int NT = 512;
constexpr size_t DBG_OFF = 448 * MiB;
__device__ __forceinline__ float dsig(float x) { return 1.f / (1.f + expf(-x)); }
__device__ __forceinline__ float bf2f(unsigned short h) { return __uint_as_float((unsigned)h << 16); }
__global__ void dbg_proj(const float* x, const float* w_in, float* PN) {
    for (int i = blockIdx.x * blockDim.x + threadIdx.x; i < NT * INC; i += gridDim.x * blockDim.x) { const int tok = i / INC, col = i % INC; float a = 0.f;
        for (int k = 0; k < D; ++k) a = fmaf(x[(size_t)tok * D + k], w_in[(size_t)k * INC + col], a); PN[i] = a; }
}
__global__ void dbg_mix1(const float* PN, const float* dw, float* RN, float* CVN) {
    for (int i = blockIdx.x * blockDim.x + threadIdx.x; i < NT * 512; i += gridDim.x * blockDim.x) { const int tok = i / 512, ch = i % 512; const int g = ch / 128, W = 2 << g;
        float s = 0.f; int cnt = 0; for (int j = 0; j < W; ++j) if (tok - j >= 0) { s += PN[(size_t)(tok - j) * INC + ch]; ++cnt; }
        RN[i] = s / (float)cnt - PN[(size_t)tok * INC + ch];
        float c = 0.f; for (int j = 0; j < CK; ++j) { const int t = tok - (CK - 1) + j; if (t >= 0) c += PN[(size_t)t * INC + 512 + ch] * dsig(PN[(size_t)t * INC + 1024 + ch]) * dw[j * 512 + ch]; }
        CVN[i] = c; }
}
__global__ void dbg_ln(const float* IN, int n, const float* g, const float* b, float* OUT, int act) {
    const int tok = blockIdx.x * blockDim.x + threadIdx.x; if (tok >= NT) return;
    float m = 0.f; for (int k = 0; k < n; ++k) m += IN[(size_t)tok * n + k]; m /= n; float v = 0.f; for (int k = 0; k < n; ++k) { const float d = IN[(size_t)tok * n + k] - m; v += d * d; } v /= n;
    const float r = 1.f / sqrtf(v + LN_EPS); for (int k = 0; k < n; ++k) { float y = (IN[(size_t)tok * n + k] - m) * r * g[k] + b[k]; if (act) y = y * dsig(y); OUT[(size_t)tok * n + k] = y; }
}
__global__ void dbg_mix3(const float* PN, const float* RN, const float* CN, const float* pool_w, const float* scale, const float* cwo, float* MGN) {
    for (int i = blockIdx.x * blockDim.x + threadIdx.x; i < NT * D; i += gridDim.x * blockDim.x) { const int tok = i / D, d = i % D, g = d / 256, dd = d % 256;
        float yp = 0.f; for (int c = 0; c < 128; ++c) yp = fmaf(RN[(size_t)tok * 512 + g * 128 + c], pool_w[((size_t)g * 128 + c) * 256 + dd], yp); yp *= scale[d];
        float yc = 0.f; for (int c = 0; c < 512; ++c) yc = fmaf(CN[(size_t)tok * 512 + c], cwo[(size_t)c * D + d], yc);
        MGN[i] = dsig(PN[(size_t)tok * INC + 1536 + d]) * yp + dsig(PN[(size_t)tok * INC + 2560 + d]) * yc; }
}
__global__ void dbg_mix4(const float* MGN, const float* w_out, const float* x, float* ZN) {
    for (int i = blockIdx.x * blockDim.x + threadIdx.x; i < NT * D; i += gridDim.x * blockDim.x) { const int tok = i / D, e = i % D; float a = 0.f;
        for (int d = 0; d < D; ++d) a = fmaf(MGN[(size_t)tok * D + d], w_out[(size_t)d * D + e], a); ZN[i] = ALPHA * x[(size_t)tok * D + e] + a; }
}
__global__ void dbg_cmp(int k, const void* buf, int kind, int ld, int n, const float* NV, int nld, int ncol0, int fn, const float* PN, float* acc) {
    float e2 = 0.f, r2 = 0.f;
    for (int i = blockIdx.x * blockDim.x + threadIdx.x; i < NT * n; i += gridDim.x * blockDim.x) { const int tok = i / n, c = i % n;
        const float a = kind ? ((const float*)buf)[(size_t)tok * ld + c] : bf2f(((const unsigned short*)buf)[(size_t)tok * ld + c]);
        float b = NV[(size_t)tok * nld + ncol0 + c];
        if (fn == 1) b = dsig(b);
        if (fn == 2) b = b * dsig(PN[(size_t)tok * INC + 1024 + c]);
        e2 += (a - b) * (a - b); r2 += b * b; }
    atomicAdd(acc + 2 * k, e2); atomicAdd(acc + 2 * k + 1, r2);
}
__global__ void dbg_cmp_tile(int k, const void* buf, int ld, int r0, int c0, const float* NV, int nld, int ncol0, float* acc) {
    float e2 = 0.f, r2 = 0.f;
    for (int i = blockIdx.x * blockDim.x + threadIdx.x; i < 256 * 256; i += gridDim.x * blockDim.x) { const int tok = r0 + i / 256, c = c0 + i % 256;
        const float a = bf2f(((const unsigned short*)buf)[(size_t)tok * ld + c]); const float b = dsig(NV[(size_t)tok * nld + ncol0 + c]);
        e2 += (a - b) * (a - b); r2 += b * b; }
    atomicAdd(acc + 2 * k, e2); atomicAdd(acc + 2 * k + 1, r2);
}
__global__ void dbg_cmp_wt(int k, const unsigned short* WT, const float* W, int n0, float* acc) {
    float e2 = 0.f, r2 = 0.f;
    for (int i = blockIdx.x * blockDim.x + threadIdx.x; i < 256 * 1024; i += gridDim.x * blockDim.x) { const int n = n0 + i / 1024, kk = i % 1024;
        const float a = bf2f(WT[(size_t)n * 1024 + kk]); const float b = W[(size_t)kk * INC + n];
        e2 += (a - b) * (a - b); r2 += b * b; }
    atomicAdd(acc + 2 * k, e2); atomicAdd(acc + 2 * k + 1, r2);
}
__global__ void dbg_code(const float* acc, int nchk, float* out, int n) {
    int code = 0; for (int k = nchk - 1; k >= 0; --k) if (!(acc[2 * k] <= 1e-3f * acc[2 * k + 1])) code = k + 1;
#ifdef DBG_TILES
    code = 0; for (int k = 0; k < 4; ++k) if (!(acc[2 * (16 + k)] <= 1e-3f * acc[2 * (16 + k) + 1])) code |= 1 << k;
#endif
#ifdef DBG_SHOW
    const float val = sqrtf(1000.f * acc[2 * DBG_SHOW] / acc[2 * DBG_SHOW + 1]);
    for (int i = blockIdx.x * blockDim.x + threadIdx.x; i < n; i += gridDim.x * blockDim.x) out[i] = val;
#else
    for (int i = blockIdx.x * blockDim.x + threadIdx.x; i < n; i += gridDim.x * blockDim.x) out[i] = (float)code;
#endif
}
static void dbg_run(void* const* d_in, float* d_out, unsigned char* ws, hipStream_t st, int stop) {
    float* PN = d_out; float* RN = PN + (size_t)NT * INC; float* CVN = RN + NT * 512; float* CN = CVN + NT * 512; float* MGN = CN + NT * 512; float* ZN = MGN + (size_t)NT * D; float* X1N = ZN + (size_t)NT * D; float* acc = X1N + (size_t)NT * D;
    const float* x = (const float*)d_in[0];
    hipMemsetAsync(acc, 0, 64 * 4, st);
    dbg_proj<<<2048, 256, 0, st>>>(x, (const float*)d_in[1], PN);
    dbg_mix1<<<1024, 256, 0, st>>>(PN, (const float*)d_in[4], RN, CVN);
    dbg_ln<<<NT / 64, 64, 0, st>>>(CVN, 512, (const float*)d_in[5], (const float*)d_in[6], CN, 1);
    dbg_mix3<<<2048, 256, 0, st>>>(PN, RN, CN, (const float*)d_in[2], (const float*)d_in[3], (const float*)d_in[7], MGN);
    dbg_mix4<<<2048, 256, 0, st>>>(MGN, (const float*)d_in[8], x, ZN);
    dbg_ln<<<NT / 64, 64, 0, st>>>(ZN, D, (const float*)d_in[9], (const float*)d_in[10], X1N, 0);
    if (stop <= 4) {
    dbg_cmp<<<256, 256, 0, st>>>(0, ws + WS_U, 0, 512, 512, PN, INC, 0, 0, PN, acc);
    dbg_cmp<<<256, 256, 0, st>>>(1, ws + WS_V, 0, 512, 512, PN, INC, 512, 2, PN, acc);
    dbg_cmp<<<256, 256, 0, st>>>(2, ws + WS_GP, 0, D, D, PN, INC, 1536, 1, PN, acc);
    dbg_cmp<<<256, 256, 0, st>>>(3, ws + WS_GC, 0, D, D, PN, INC, 2560, 1, PN, acc);
    }
    dbg_cmp<<<256, 256, 0, st>>>(4, ws + WS_R, 0, 512, 512, RN, 512, 0, 0, PN, acc);
    dbg_cmp<<<256, 256, 0, st>>>(5, ws + WS_C, 0, 512, 512, CN, 512, 0, 0, PN, acc);
    if (stop >= 7) {
    dbg_cmp<<<256, 256, 0, st>>>(6, ws + WS_MG, 0, D, D, MGN, D, 0, 0, PN, acc);
    dbg_cmp<<<256, 256, 0, st>>>(7, ws + WS_Z, 1, D, D, ZN, D, 0, 0, PN, acc);
    dbg_cmp<<<256, 256, 0, st>>>(8, ws + WS_X1, 0, D, D, X1N, D, 0, 0, PN, acc);
    }
#ifdef DBG_WT
    dbg_cmp_wt<<<256, 256, 0, st>>>(DBG_SHOW, (const unsigned short*)(ws + WS_WIN), (const float*)d_in[1], DBG_WT, acc);
#endif
#ifdef DBG_TILES
    for (int t = 0; t < 4; ++t) dbg_cmp_tile<<<64, 256, 0, st>>>(16 + t, ws + ((DBG_TILES & 2) ? WS_GC : WS_GP), D, (DBG_TILES & 1) * 256, t * 256, PN, INC, ((DBG_TILES & 2) ? 2560 : 1536), acc);
#endif
    hipMemcpyAsync(ws + WS_CTL + 65536, acc, 64 * 4, hipMemcpyDeviceToDevice, st);
    dbg_code<<<1024, 256, 0, st>>>((const float*)(ws + WS_CTL + 65536), 9, d_out, M * D);
}
#endif

#ifndef MK_N_LAUNCHES
#define MK_N_LAUNCHES 1
#endif
constexpr int N_PHASES = 12;
struct Args { const float* in[21]; float* out; unsigned char* ws; int ph_lo, ph_hi; };
__global__ void __launch_bounds__(NTHR, 2) mk_fwd(Args args) {
    extern __shared__ __attribute__((aligned(16))) unsigned char lds[];
    Frame F;
    F.lds = (LAS unsigned char*)lds;
    F.MISC = (volatile LAS unsigned*)(F.lds + MISC_OFF);
    F.wave = __builtin_amdgcn_readfirstlane((int)threadIdx.x >> 6);
    F.G = gridDim.x; { const int bx = blockIdx.x; F.vcu = (F.G % 8 == 0) ? (bx % 8) * (F.G / 8) + bx / 8 : bx; }
    F.ws = args.ws; F.ctl = (gu32*)(args.ws + WS_CTL); F.out = args.out;
#pragma unroll
    for (int i = 0; i < 21; ++i) F.in[i] = args.in[i];
    for (int u = threadIdx.x; u < (LDS_BYTES - TAB_OFF) / 4; u += NTHR) ((LAS unsigned*)(F.lds + TAB_OFF))[u] = 0u;
    __syncthreads();
    const int lo = args.ph_lo, hi = args.ph_hi;
    const bool multi = (hi - lo) > 1;
    XcdBarrier bar; bar.bar = (unsigned*)(F.ctl + CW_BAR); bar.x = 0; bar.st = nullptr;
    if (multi) bar = xcd_barrier_post((unsigned*)(F.ctl + CW_BAR), F.MISC + 8);
#ifndef PH_MASK
#define PH_MASK 0xFFF
#endif
#define IN(k) ((((PH_MASK) >> (k)) & 1) && lo <= (k) && (k) < hi)
#define SEAM(k) do { if (IN(k) && IN((k) + 1)) xcd_barrier(bar, F.wave); } while (0)
    unsigned char* ws = args.ws;
    LAS unsigned char* ring = F.lds + RING_OFF; LAS unsigned char* entl = F.lds + ENT_OFF;
    const int bx = (int)blockIdx.x;

#ifndef DUP_MASK
#define DUP_MASK 0
#endif
#define DUP(k) ((((DUP_MASK) >> (k)) & 1) != 0)
#define PHASE(k, BODY) do { if (IN(k)) { BODY; if (DUP(k)) { xcd_barrier(bar, F.wave); BODY; } } SEAM(k); } while (0)
    PHASE(0, p0_prologue(F));
#define P1_BODY { DenseOrder S; S.init((const bf16*)(ws + WS_XB), (const bf16*)(ws + WS_WIN), M, INC, D, D, D, 0, F.G, bx); \
        EpiProj E{(bf16*)(ws + WS_U), (bf16*)(ws + WS_V), (bf16*)(ws + WS_GP), (bf16*)(ws + WS_GC)}; \
        pg8::gemm_phase<EpiProj, DenseOrder>(ring, entl, S, E, F.wave); }
    PHASE(1, P1_BODY);
    PHASE(2, p2_mixer(F));
#define P3_BODY { DenseOrder S; S.init((const bf16*)(ws + WS_R), (const bf16*)(ws + WS_POOL), M, D, 128, PW, 128, 128, F.G, bx); \
        EpiPool E{F.in[3], (const bf16*)(ws + WS_GP), (bf16*)(ws + WS_T1)}; \
        pg8::gemm_phase<EpiPool, DenseOrder>(ring, entl, S, E, F.wave); }
    PHASE(3, P3_BODY);
#define P4_BODY { DenseOrder S; S.init((const bf16*)(ws + WS_C), (const bf16*)(ws + WS_CVO), M, D, CW, CW, CW, 0, F.G, bx); \
        EpiConvOut E{(const bf16*)(ws + WS_T1), (const bf16*)(ws + WS_GC), (bf16*)(ws + WS_MG)}; \
        pg8::gemm_phase<EpiConvOut, DenseOrder>(ring, entl, S, E, F.wave); }
    PHASE(4, P4_BODY);
#define P5_BODY { DenseOrder S; S.init((const bf16*)(ws + WS_MG), (const bf16*)(ws + WS_WOUT), M, D, D, D, D, 0, F.G, bx); \
        EpiWout E{F.in[0], (float*)(ws + WS_Z)}; \
        pg8::gemm_phase<EpiWout, DenseOrder>(ring, entl, S, E, F.wave); }
    PHASE(5, P5_BODY);
    PHASE(6, p6_ln1(F));
#define P7_BODY { DenseOrder S; S.init((const bf16*)(ws + WS_X1), (const bf16*)(ws + WS_RSH), M, 768, D, D, D, 0, F.G, bx); \
        EpiRSh E{(float*)(ws + WS_LOG), (bf16*)(ws + WS_HS)}; \
        pg8::gemm_phase<EpiRSh, DenseOrder>(ring, entl, S, E, F.wave); }
    PHASE(7, P7_BODY);
    if (IN(8)) { p8_route(F);
#ifdef ROUTE_DUP
        xcd_barrier(bar, F.wave); p8_route(F, 1);
#endif
        { DenseOrder S; S.init((const bf16*)(ws + WS_HS), (const bf16*)(ws + WS_SDN), M, D, EH, EH, EH, 0, F.G, bx);
          EpiSDown E{(bf16*)(ws + WS_YSH)};
          pg8::gemm_phase<EpiSDown, DenseOrder>(ring, entl, S, E, F.wave); } } SEAM(8);
#define P9_BODY { const int tt = expert_table(F); \
        ExpertOrder<true> S; S.A = ws + WS_X18; S.Bt = ws + WS_EGU; S.ldaB = D; S.ldbB = D; S.nt = D / 128; S.bstride = (size_t)512 * D; S.scaleA = E8_X; S.scaleB = E8_W; \
        S.tstart = (const LAS int*)(F.lds + TAB_OFF); S.cntl = S.tstart + 260; S.list = (const int*)(ws + WS_LIST); S.nN = 2; S.nwg = tt * 2; S.G = F.G; S.c = bx; \
        EpiEGU E{ws + WS_HE}; \
        pg8::gemm_phase<EpiEGU, ExpertOrder<true>>(ring, entl, S, E, F.wave); }
    PHASE(9, P9_BODY);
#define P10_BODY { const int tt = expert_table(F); \
        { ExpertOrder<false> S; S.A = ws + WS_HE; S.Bt = ws + WS_EDN; S.ldaB = EH; S.ldbB = EH; S.nt = EH / 128; S.bstride = (size_t)D * EH; S.scaleA = E8_H; S.scaleB = E8_W; \
          S.tstart = (const LAS int*)(F.lds + TAB_OFF); S.cntl = S.tstart + 260; S.list = (const int*)(ws + WS_LIST); S.nN = 4; S.nwg = tt * 4; S.G = F.G; S.c = bx; \
          EpiEDown E{ws + WS_Y}; \
          pg8::gemm_phase<EpiEDown, ExpertOrder<false>>(ring, entl, S, E, F.wave); } }
    PHASE(10, P10_BODY);
    PHASE(11, p11_combine(F));
#undef IN
#undef SEAM
}

extern "C" void kernel_launch(void* const* d_in, const int* in_sizes, int n_in, void* d_out, int out_size, void* d_ws, size_t ws_size, hipStream_t stream) {
    static int grid = 0;
    if (grid == 0) {
        if (n_in != 21 || in_sizes[0] != M * D || out_size != M * D || ws_size < WS_END) { fprintf(stderr, "kernel_launch: unexpected shapes (n_in %d, in0 %d, out %d, ws %zu)\n", n_in, n_in > 0 ? in_sizes[0] : -1, out_size, ws_size); grid = -1; return; }
        int dev = 0, cus = 0;
        if (hipGetDevice(&dev) != hipSuccess || hipDeviceGetAttribute(&cus, hipDeviceAttributeMultiprocessorCount, dev) != hipSuccess) { grid = -1; return; }
        if (hipFuncSetAttribute((const void*)mk_fwd, hipFuncAttributeMaxDynamicSharedMemorySize, LDS_BYTES) != hipSuccess) { fprintf(stderr, "kernel_launch: hipFuncSetAttribute failed\n"); grid = -1; return; }
        (void)hipGetLastError();
        grid = cus;
    }
    if (grid < 0) return;
    (void)hipMemsetAsync((char*)d_ws + WS_CTL, 0, CTL_ZERO_BYTES, stream);
    Args a{};
    for (int i = 0; i < 21; ++i) a.in[i] = (const float*)d_in[i];
    a.out = (float*)d_out; a.ws = (unsigned char*)d_ws;
    constexpr int NL = MK_N_LAUNCHES;
    for (int li = 0; li < NL; ++li) {
        a.ph_lo = (NL == 1) ? 0 : li; a.ph_hi = (NL == 1) ? N_PHASES : li + 1;
        hipLaunchKernelGGL(mk_fwd, dim3(grid), dim3(NTHR), LDS_BYTES, stream, a);
#ifdef DBG_CHECK
        if (a.ph_hi == DBG_CHECK) { dbg_run(d_in, (float*)d_out, (unsigned char*)d_ws, stream, DBG_CHECK); return; }
#endif
    }
}
```

```cpp
#define MK_N_LAUNCHES 1

#include <hip/hip_runtime.h>
#include <cstdio>
#include <cstdint>

namespace pg8 {
#define PG8_LAS __attribute__((address_space(3)))
typedef unsigned short bf16_t;
typedef short bf16x8 __attribute__((ext_vector_type(8)));
typedef float f32x4 __attribute__((ext_vector_type(4)));
typedef float f32x2 __attribute__((ext_vector_type(2)));
typedef unsigned u32x4 __attribute__((ext_vector_type(4)));
typedef unsigned u32x2 __attribute__((ext_vector_type(2)));
typedef int i32x4 __attribute__((ext_vector_type(4)));
typedef int i32x8 __attribute__((ext_vector_type(8)));
constexpr int BM = 256, BK = 64, HALF = 128, HTB = HALF * BK * 2  , STAGE_BYTES = 8 * HTB, NXCD = 8, WGM = 8;

__host__ __device__ __forceinline__ int lds_byte(int r, int c) { const int st = (r >> 4) * 2 + (c >> 5), rr = r & 15, cc = c & 31, ob = rr * 64 + cc * 2; return st * 1024 + (ob ^ (((ob >> 9) & 1) << 5)); }
__host__ __device__ __forceinline__ void stage_rc(int b, int& R, int& C) { const int st = b / 1024, sb = b % 1024, swz = sb ^ (((sb >> 9) & 1) << 5); R = (st >> 1) * 16 + swz / 64; C = (st & 1) * 32 + (swz % 64) / 2; }
__host__ __device__ __forceinline__ int perm32(int rho) { const int n = rho >> 4, i = rho & 15; return 8 * (i >> 2) + 4 * n + (i & 3); }

struct Unit { int pm, pn, e, r0, nrow; };

typedef __bf16 bf16x2_t __attribute__((ext_vector_type(2)));
__device__ __forceinline__ unsigned cvt_pk_bf16(float lo, float hi) { f32x2 v = {lo, hi}; bf16x2_t b = __builtin_convertvector(v, bf16x2_t); return __builtin_bit_cast(unsigned, b); }
__device__ __forceinline__ u32x4 pack8(const f32x4 a, const f32x4 b) { u32x4 w; w.x = cvt_pk_bf16(a[0], a[1]); w.y = cvt_pk_bf16(a[2], a[3]); w.z = cvt_pk_bf16(b[0], b[1]); w.w = cvt_pk_bf16(b[2], b[3]); return w; }
__device__ __forceinline__ float bf_lo(unsigned w) { return __uint_as_float(w << 16); }
__device__ __forceinline__ float bf_hi(unsigned w) { return __uint_as_float(w & 0xffff0000u); }
__device__ __forceinline__ void unpack8(const u32x4 w, f32x4& a, f32x4& b) { a = (f32x4){bf_lo(w.x), bf_hi(w.x), bf_lo(w.y), bf_hi(w.y)}; b = (f32x4){bf_lo(w.z), bf_hi(w.z), bf_lo(w.w), bf_hi(w.w)}; }
__device__ __forceinline__ float sigmoidf_(float x) { return __builtin_amdgcn_rcpf(1.0f + __expf(-x)); }
__device__ __forceinline__ f32x4 sigmoid4(const f32x4 x) { return (f32x4){sigmoidf_(x[0]), sigmoidf_(x[1]), sigmoidf_(x[2]), sigmoidf_(x[3])}; }

template <class Epi, class Sched>
__device__ __forceinline__ void gemm_phase(PG8_LAS unsigned char* lds, PG8_LAS unsigned char* ent, const Sched& S, const Epi& E, int wid_) {
    int lane_; asm volatile("v_mbcnt_lo_u32_b32 %0, -1, 0\n\tv_mbcnt_hi_u32_b32 %0, -1, %0" : "=v"(lane_));
    const int wid = __builtin_amdgcn_readfirstlane(wid_), lane = lane_, tid = wid * 64 + lane, wr = wid >> 2, wc = wid & 3, fr = lane & 15, fq = lane >> 4;
    int nt_ = S.nt; asm volatile("" : "+s"(nt_));
    const int nt = nt_;
    int sR[2], sC[2]; unsigned voffB[2];
#pragma unroll
    for (int i = 0; i < 2; ++i) { int R, C; stage_rc(tid * 16 + i * 8192, R, C); const int Rb = Epi::PERM ? ((R & ~31) + perm32(R & 31)) : R;
        sR[i] = R; sC[i] = C; voffB[i] = (unsigned)(Rb * S.ldbB + C * 2); }
    const size_t kstep = (size_t)(BK * 2);
    const size_t hstepB = (size_t)HALF * S.ldbB;
    const unsigned ldsw = (unsigned)wid * 1024u;
    const int aoff = lds_byte(wr * 64 + fr, fq * 8), boff = lds_byte(wc * 32 + fr, fq * 8);
    PG8_LAS unsigned char* abase = lds + aoff; PG8_LAS unsigned char* bbase = lds + 4 * HTB + boff;
    asm volatile("" : "+v"(abase), "+v"(bbase));
#define PG8_SA(b, h) (((b) * 2 + (h)) * HTB)
#define PG8_SB(b, h) ((4 + (b) * 2 + (h)) * HTB)
#define PG8_STAGE(bufoff, gbase, voff) do { _Pragma("unroll") for (int _i = 0; _i < 2; ++_i) \
        __builtin_amdgcn_global_load_lds((const unsigned*)((const char*)(gbase) + (voff)[_i]), (PG8_LAS unsigned*)(lds + (bufoff) + ldsw + _i * 8192), 16, 0, 0); } while (0)
#define PG8_STAGE_A(bufoff, gbase, nrow_, e_, h) do { _Pragma("unroll") for (int _i = 0; _i < 2; ++_i) \
        __builtin_amdgcn_global_load_lds((const unsigned*)((const char*)(gbase) + S.a_voff((nrow_), (e_), (h) * 128 + sR[_i], sC[_i])), (PG8_LAS unsigned*)(lds + (bufoff) + ldsw + _i * 8192), 16, 0, 0); } while (0)
#define PG8_LD8(p) __builtin_shufflevector(*(const PG8_LAS i32x4*)(p), *(const PG8_LAS i32x4*)((p) + 1024), 0, 1, 2, 3, 4, 5, 6, 7)
#define PG8_LDA(dst, b, h) do { if constexpr (Sched::FP8) { _Pragma("unroll") for (int m = 0; m < 4; ++m) dst##8[m] = PG8_LD8(abase + PG8_SA(b, h) + m * 2048); } \
        else { _Pragma("unroll") for (int m = 0; m < 4; ++m) _Pragma("unroll") for (int k = 0; k < 2; ++k) dst[m][k] = *(const PG8_LAS bf16x8*)(abase + PG8_SA(b, h) + m * 2048 + k * 1024); } } while (0)
#define PG8_LDB(dst, b, h) do { if constexpr (Sched::FP8) { _Pragma("unroll") for (int n = 0; n < 2; ++n) dst##8[n] = PG8_LD8(bbase + PG8_SA(b, h) + n * 2048); } \
        else { _Pragma("unroll") for (int n = 0; n < 2; ++n) _Pragma("unroll") for (int k = 0; k < 2; ++k) dst[n][k] = *(const PG8_LAS bf16x8*)(bbase + PG8_SA(b, h) + n * 2048 + k * 1024); } } while (0)
#define PG8_MMA(ai, bj, At, Bt) do { __builtin_amdgcn_s_setprio(1); \
        if constexpr (Sched::FP8) { _Pragma("unroll") for (int m = 0; m < 4; ++m) _Pragma("unroll") for (int n = 0; n < 2; ++n) \
            asm volatile("v_mfma_scale_f32_16x16x128_f8f6f4 %0, %1, %2, %0, %3, %4 op_sel_hi:[0,0,0]" : "+v"(acc[ai][bj][m][n]) : "v"(Bt##8[n]), "v"(At##8[m]), "v"(scB), "v"(scA)); } \
        else { _Pragma("unroll") for (int m = 0; m < 4; ++m) _Pragma("unroll") for (int n = 0; n < 2; ++n) _Pragma("unroll") for (int k = 0; k < 2; ++k) \
            acc[ai][bj][m][n] = __builtin_amdgcn_mfma_f32_16x16x32_bf16(Bt[n][k], At[m][k], acc[ai][bj][m][n], 0, 0, 0); } \
        __builtin_amdgcn_s_setprio(0); } while (0)
#define PG8_WAIT_V(n) asm volatile("s_waitcnt vmcnt(" #n ")" ::: "memory")
#define PG8_WAIT_L(n) asm volatile("s_waitcnt lgkmcnt(" #n ")" ::: "memory")
#define PG8_BAR __builtin_amdgcn_s_barrier()
#define PG8_SCHED __builtin_amdgcn_sched_barrier(0)
    Unit cur, nxt; int ui = 0;
    if (!S.next(0, cur)) return;
    f32x4 acc[2][2][4][2];
#pragma unroll
    for (int a = 0; a < 2; ++a)
#pragma unroll
        for (int b = 0; b < 2; ++b)
#pragma unroll
            for (int m = 0; m < 4; ++m)
#pragma unroll
                for (int n = 0; n < 2; ++n) acc[a][b][m][n] = (f32x4){0.f, 0.f, 0.f, 0.f};
    const int scA = S.scaleA, scB = S.scaleB;
    bf16x8 At[4][2], B0[2][2], B1[2][2]; i32x8 At8[4], B08[2], B18[2];
    const char* cA = S.a_ptr(cur); const char* cB = S.b_ptr(cur);
    if constexpr (Sched::META) {
        S.meta_issue(cur, ent, wid, lane); if (S.next(1, nxt)) S.meta_issue(nxt, ent + 2048, wid, lane);
        PG8_WAIT_V(0); PG8_BAR;
    }
    PG8_STAGE(PG8_SB(0, 0), cB, voffB); PG8_STAGE(PG8_SB(0, 1), cB + hstepB, voffB); PG8_STAGE_A(PG8_SA(0, 0), cA, cur.nrow, ent, 0); PG8_STAGE_A(PG8_SA(0, 1), cA, cur.nrow, ent, 1);
    if (wr == 1) PG8_BAR;
    PG8_WAIT_V(2); PG8_BAR;
    PG8_STAGE(PG8_SB(1, 0), cB + kstep, voffB); PG8_STAGE_A(PG8_SA(1, 0), cA + kstep, cur.nrow, ent, 0); PG8_STAGE(PG8_SB(1, 1), cB + hstepB + kstep, voffB);
    PG8_WAIT_V(6); PG8_BAR;
    for (;;) {
        const bool has_next = S.next(ui + 1, nxt);
        const char* nA = cA; const char* nB = cB; int nnrow = cur.nrow; PG8_LAS unsigned char* const cent = ent + (ui & 3) * 2048; PG8_LAS unsigned char* nent = cent;
        if (has_next) { nA = S.a_ptr(nxt); nB = S.b_ptr(nxt); nnrow = nxt.nrow; nent = ent + ((ui + 1) & 3) * 2048; }
        if constexpr (Sched::META) { Unit u2; if (S.next(ui + 2, u2)) S.meta_issue(u2, ent + ((ui + 2) & 3) * 2048, wid, lane); }
        for (int t = 0; t < nt; t += 2) {
            const bool last = (t == nt - 2);
            const char* a1 = cA + (size_t)(t + 1) * kstep;
            const char* a2 = last ? nA : cA + (size_t)(t + 2) * kstep; const char* b2 = last ? nB : cB + (size_t)(t + 2) * kstep;
            const char* a3 = a2 + kstep; const char* b3 = b2 + kstep;
            const int xnrow = last ? nnrow : cur.nrow; PG8_LAS unsigned char* const xent = last ? nent : cent;
            PG8_LDB(B0, 0, 0); PG8_LDB(B1, 0, 1); PG8_SCHED; PG8_LDA(At, 0, 0); PG8_STAGE_A(PG8_SA(1, 1), a1, cur.nrow, cent, 1);
            PG8_WAIT_V(8); PG8_WAIT_L(0); PG8_BAR; PG8_MMA(0, 0, At, B0); PG8_MMA(0, 1, At, B1); PG8_BAR; PG8_SCHED;
            PG8_LDA(At, 0, 1); PG8_STAGE(PG8_SB(0, 0), b2, voffB); PG8_STAGE(PG8_SB(0, 1), b2 + hstepB, voffB); PG8_STAGE_A(PG8_SA(0, 0), a2, xnrow, xent, 0);
            PG8_WAIT_V(8); PG8_WAIT_L(0); PG8_BAR; PG8_MMA(1, 0, At, B0); PG8_MMA(1, 1, At, B1); PG8_BAR; PG8_SCHED;
            PG8_LDB(B0, 1, 0); PG8_LDB(B1, 1, 1); PG8_SCHED; PG8_LDA(At, 1, 0); PG8_STAGE_A(PG8_SA(0, 1), a2, xnrow, xent, 1);
            PG8_WAIT_V(8); PG8_WAIT_L(0); PG8_BAR; PG8_MMA(0, 0, At, B0); PG8_MMA(0, 1, At, B1); PG8_BAR; PG8_SCHED;
            PG8_LDA(At, 1, 1); PG8_STAGE(PG8_SB(1, 0), b3, voffB); PG8_STAGE(PG8_SB(1, 1), b3 + hstepB, voffB); PG8_STAGE_A(PG8_SA(1, 0), a3, xnrow, xent, 0);
            PG8_WAIT_V(8); PG8_WAIT_L(0); PG8_BAR; PG8_MMA(1, 0, At, B0); PG8_MMA(1, 1, At, B1); PG8_BAR; PG8_SCHED;
        }
        if (wr == 0) PG8_BAR;
        if constexpr (Sched::FP8) asm volatile("s_nop 15\n\ts_nop 15" ::: "memory");
        E(acc, cur, wr, wc, fr, fq, cent);
        if (!has_next) break;
#pragma unroll
        for (int a = 0; a < 2; ++a)
#pragma unroll
            for (int b = 0; b < 2; ++b)
#pragma unroll
                for (int m = 0; m < 4; ++m)
#pragma unroll
                    for (int n = 0; n < 2; ++n) acc[a][b][m][n] = (f32x4){0.f, 0.f, 0.f, 0.f};
        cur = nxt; cA = nA; cB = nB; ++ui;
        if (wr == 1) PG8_BAR;
    }
    PG8_WAIT_V(0);
    PG8_BAR;
#undef PG8_SA
#undef PG8_SB
#undef PG8_STAGE
#undef PG8_STAGE_A
#undef PG8_LDA
#undef PG8_LDB
#undef PG8_MMA
#undef PG8_WAIT_V
#undef PG8_WAIT_L
#undef PG8_BAR
#undef PG8_SCHED
}
}

constexpr int NWAVES = 8, NTHR = NWAVES * 64;
constexpr int D = 1024, BATCH = 4, SEQ = 8192, M = BATCH * SEQ;
constexpr int PW = 512, CW = 512, CK = 31, INC = 3584;
constexpr int NE = 256, TOPK = 8, NG = 8, EH = 256;
constexpr int ECAP = M;
constexpr int MAXT = (M * TOPK) / 256 + NE;
constexpr float XSCALE = 16.f, WSCALE = 128.f, HSCALE = 8.f, YSCALE = 64.f;
constexpr int E8_X = 0x7b7b7b7b, E8_W = 0x78787878, E8_H = 0x7c7c7c7c;
constexpr float LN_EPS = 1e-5f, ALPHA = 1.189207115002721f  , RSCALE = 2.5f;

constexpr size_t MiB = 1u << 20;
constexpr size_t WS_CTL = 0, CTL_ZERO_BYTES = 1 * MiB;
constexpr size_t WS_WIN = 1 * MiB;
constexpr size_t WS_POOL = 8 * MiB;
constexpr size_t WS_CVO = 8 * MiB + 512 * 1024;
constexpr size_t WS_WOUT = 10 * MiB;
constexpr size_t WS_RSH = 12 * MiB;
constexpr size_t WS_SDN = 14 * MiB;
constexpr size_t WS_EDN = 16 * MiB;
constexpr size_t WS_X18 = 96 * MiB;
constexpr size_t WS_X1 = 144 * MiB;
constexpr size_t WS_HS = 208 * MiB;
constexpr size_t WS_LIST = 224 * MiB;
constexpr size_t WS_HE = 288 * MiB;
constexpr size_t WS_EGU = 448 * MiB;
constexpr size_t WS_PH = 704 * MiB;
constexpr size_t WS_XB = WS_PH;
constexpr size_t WS_U = WS_PH + 64 * MiB, WS_V = WS_PH + 96 * MiB;
constexpr size_t WS_GP = WS_PH + 128 * MiB, WS_GC = WS_PH + 192 * MiB;
constexpr size_t WS_R = WS_PH + 256 * MiB, WS_C = WS_PH + 288 * MiB;
constexpr size_t WS_T1 = WS_XB;
constexpr size_t WS_MG = WS_U;
constexpr size_t WS_Z = WS_GP;
constexpr size_t WS_LOG = WS_HE;
constexpr size_t WS_END = 1024 * MiB;
constexpr size_t WS_Y = WS_EGU;
static_assert(WS_Y + (size_t)M * 8 * D * 2 <= WS_R, "Y slots end before R");
constexpr size_t WS_YSH = WS_R;
static_assert(WS_YSH + (size_t)M * D * 2 <= WS_END, "ws map");
static_assert(WS_HE + (size_t)MAXT * 256 * EH * 2 <= WS_EGU, "HE fits");
static_assert(WS_LIST + (size_t)NE * ECAP * 8 <= WS_HE, "LIST fits");

constexpr int CW_CNT = 32768;
constexpr int CW_BAR = 4096;

constexpr int RING_OFF = 0, RING_BYTES = 131072;
constexpr int TAB_OFF = RING_BYTES;
constexpr int ENT_OFF = TAB_OFF + 4096;
constexpr int MISC_OFF = ENT_OFF + 8192;
constexpr int LDS_BYTES = 147456;
static_assert(MISC_OFF + 128 <= LDS_BYTES, "LDS map");

#define GAS __attribute__((address_space(1)))
#define LAS __attribute__((address_space(3)))
typedef unsigned short bf16;
typedef unsigned v4u __attribute__((ext_vector_type(4)));
typedef unsigned v2u __attribute__((ext_vector_type(2)));
typedef float f32x4 __attribute__((ext_vector_type(4)));
typedef GAS unsigned gu32;
#define RLX_AGENT __ATOMIC_RELAXED, __HIP_MEMORY_SCOPE_AGENT
#define LDS_WAIT() asm volatile("s_waitcnt lgkmcnt(0)" ::: "memory")
#define VM_WAIT() asm volatile("s_waitcnt vmcnt(0)" ::: "memory")
__device__ __forceinline__ unsigned f2bf(float f) { unsigned u = __builtin_bit_cast(unsigned, f); return (u + 0x7fffu + ((u >> 16) & 1u)) >> 16; }
__device__ __forceinline__ unsigned pk2(float lo, float hi) { return pg8::cvt_pk_bf16(lo, hi); }

#define XB_TMO      128
#define XB_XCNT(j)  (256  + 64 * (j))
#define XB_XSUB(j)  (1280 + 64 * (j))
#define XB_XGEN(j)  (2304 + 64 * (j))
#define XB_TOP      3328
#define XB_TOPGEN   3392
#define XCD_BAR_WORDS 3456
#define XB_SPIN_CAP (1u << 20)
__device__ __forceinline__ unsigned xb_ld(unsigned* p)              { return __hip_atomic_load(p, __ATOMIC_RELAXED, __HIP_MEMORY_SCOPE_AGENT); }
__device__ __forceinline__ unsigned xb_add(unsigned* p, unsigned v) { return __hip_atomic_fetch_add(p, v, __ATOMIC_RELAXED, __HIP_MEMORY_SCOPE_AGENT); }
__device__ __forceinline__ unsigned xb_xcc_id() { return (unsigned)__builtin_amdgcn_s_getreg((3 << 11) | 20) & 0xFu; }
#define XB_SPIN(cond, bar) do { unsigned _sp = 0; while (cond) { __builtin_amdgcn_s_sleep(1); \
    if ((++_sp & 255u) == 0u) { if (xb_ld(&(bar)[XB_TMO])) break; if (_sp > XB_SPIN_CAP) { atomicAdd(&(bar)[XB_TMO], 1u); break; } } } } while (0)
struct XcdBarrier { unsigned* bar; unsigned x; volatile LAS unsigned* st; };
__device__ __forceinline__ XcdBarrier xcd_barrier_post(unsigned* bar, volatile LAS unsigned* st) {
    XcdBarrier b; b.bar = bar; b.x = xb_xcc_id(); b.st = st;
    if (threadIdx.x == 0) (void)xb_add(&bar[XB_XCNT(b.x)], 1u);
    return b;
}
__device__ __forceinline__ void xcd_barrier_complete(unsigned* bar, unsigned x, unsigned& nloc, unsigned& nx) {
    const unsigned G = gridDim.x * gridDim.y * gridDim.z;
    unsigned sum, cnt, mine, sp = 0u;
    for (;;) {
        sum = 0u; cnt = 0u; mine = 0u;
#pragma unroll
        for (unsigned j = 0; j < 16; ++j) { const unsigned c = xb_ld(&bar[XB_XCNT(j)]); sum += c; cnt += (c > 0u) ? 1u : 0u; mine = (j == x) ? c : mine; }
        if (sum == G) break;
        __builtin_amdgcn_s_sleep(1);
        if ((++sp & 255u) == 0u) { if (xb_ld(&bar[XB_TMO])) break; if (sp > XB_SPIN_CAP) { atomicAdd(&bar[XB_TMO], 1u); break; } }
    }
    nloc = mine > 0u ? mine : 1u; nx = cnt > 0u ? cnt : 1u;
}
__device__ __forceinline__ int lane_id();
__device__ __forceinline__ void xcd_barrier(const XcdBarrier& b, int wave) {
    asm volatile("s_waitcnt vmcnt(0)" ::: "memory");
    __syncthreads();
    if (wave == 0 && lane_id() == 0) {
        unsigned* bar = b.bar;
        __builtin_amdgcn_s_waitcnt(0);
        unsigned nloc = b.st[0], nx = b.st[1];
        if (nloc == 0u) { xcd_barrier_complete(bar, b.x, nloc, nx); b.st[0] = nloc; b.st[1] = nx; }
        const unsigned old = xb_add(&bar[XB_XSUB(b.x)], 1u);
        const unsigned gen = old / nloc;
        if (old + 1u == (gen + 1u) * nloc) {
            __builtin_amdgcn_fence(__ATOMIC_RELEASE, "agent");
            asm volatile("s_waitcnt vmcnt(0)" ::: "memory");
            const unsigned og = xb_add(&bar[XB_TOP], 1u);
            const unsigned tg = og / nx;
            if (og + 1u == (tg + 1u) * nx) xb_add(&bar[XB_TOPGEN], 1u);
            else XB_SPIN(xb_ld(&bar[XB_TOPGEN]) == tg, bar);
            __builtin_amdgcn_fence(__ATOMIC_ACQUIRE, "agent");
            xb_add(&bar[XB_XGEN(b.x)], 1u);
            asm volatile("s_waitcnt vmcnt(0)" ::: "memory");
        } else {
            XB_SPIN(xb_ld(&bar[XB_XGEN(b.x)]) == gen, bar);
            __builtin_amdgcn_fence(__ATOMIC_ACQUIRE, "agent");
            asm volatile("s_waitcnt vmcnt(0)" ::: "memory");
        }
    }
    __syncthreads();
}

struct Frame {
    LAS unsigned char* lds;
    volatile LAS unsigned* MISC;
    gu32* ctl;
    int wave;
    int vcu, G;
    const float* in[21]; float* out; unsigned char* ws;
};
__device__ __forceinline__ int lane_id() { int l; asm volatile("v_mbcnt_lo_u32_b32 %0, -1, 0\n\tv_mbcnt_hi_u32_b32 %0, -1, %0" : "=v"(l)); return l; }
__device__ __forceinline__ float wave_sum(float v) {
#pragma unroll
    for (int o = 1; o < 64; o <<= 1) v += __shfl_xor(v, o);
    return v;
}

__host__ __device__ __forceinline__ int xcd_chunk(int L, int nwg) {
    const int q = nwg / 8, r = nwg % 8, xcd = L % 8, off = L / 8;
    return (xcd < r ? xcd * (q + 1) : r * (q + 1) + (xcd - r) * q) + off;
}
struct DenseOrder {   static constexpr bool META = false, FP8 = false;
    const bf16* A; const bf16* Bt; int ldaB, ldbB, nt, acol_pn; int scaleA, scaleB;
    int nM, nN, nwg, G, c;
    __device__ __forceinline__ void init(const bf16* A_, const bf16* Bt_, int Mr, int N, int K, int lda_, int ldb_, int acol_pn_, int G_, int c_) {
        A = A_; Bt = Bt_; ldaB = lda_ * 2; ldbB = ldb_ * 2; nt = K / 64; acol_pn = acol_pn_; nM = Mr / 256; nN = N / 256; nwg = nM * nN; G = G_; c = c_; scaleA = 0; scaleB = 0; }
    __device__ __forceinline__ bool next(int i, pg8::Unit& u) const {
        const int L = i * G + c; if (L >= nwg) return false;
        const int wgid = xcd_chunk(L, nwg);
        const int nig = 8 * nN, gid = wgid / nig, fm = gid * 8, gsz = (nM - fm) < 8 ? (nM - fm) : 8;
        u.pm = fm + ((wgid % nig) % gsz); u.pn = (wgid % nig) / gsz; u.e = 0; u.r0 = 0; u.nrow = 256; return true;
    }
    __device__ __forceinline__ const char* a_ptr(const pg8::Unit& u) const { return (const char*)A + (size_t)u.pm * 256 * ldaB + u.pn * acol_pn * 2; }
    __device__ __forceinline__ const char* b_ptr(const pg8::Unit& u) const { return (const char*)Bt + (size_t)u.pn * 256 * ldbB; }
    __device__ __forceinline__ unsigned a_voff(int, const LAS unsigned char*, int rl, int C) const { return (unsigned)(rl * ldaB + C * 2); }
};
template <bool GATHER> struct ExpertOrder {
    static constexpr bool META = true, FP8 = true;
    const unsigned char* A; const unsigned char* Bt; int ldaB, ldbB, nt; size_t bstride;
    int scaleA, scaleB;
    const LAS int* tstart; const LAS int* cntl; const int* list;
    int nN, nwg, G, c;
    __device__ __forceinline__ bool next(int i, pg8::Unit& u) const {
        const int L = i * G + c; if (L >= nwg) return false;
        const int wgid = xcd_chunk(L, nwg);
        const int t = wgid / nN; u.pn = wgid % nN; u.pm = t;
        int lo = 0, hi = NE;
#pragma unroll
        for (int s = 0; s < 8; ++s) { const int mid = (lo + hi) >> 1; if (tstart[mid] <= t) lo = mid; else hi = mid; }
        u.e = lo; u.r0 = (t - tstart[lo]) * 256; u.nrow = cntl[lo] - u.r0; return true;
    }
    __device__ __forceinline__ const char* a_ptr(const pg8::Unit& u) const { return GATHER ? (const char*)A : (const char*)A + (size_t)u.pm * 256 * ldaB; }
    __device__ __forceinline__ const char* b_ptr(const pg8::Unit& u) const { return (const char*)Bt + (size_t)u.e * bstride + (size_t)u.pn * 256 * ldbB; }
    __device__ __forceinline__ void meta_issue(const pg8::Unit& u, LAS unsigned char* dst, int wid, int lane) const {
        const char* src = (const char*)(list + ((size_t)u.e * ECAP + u.r0) * 2) + wid * 256 + lane * 4;
        __builtin_amdgcn_global_load_lds((const unsigned*)src, (LAS unsigned*)(dst + wid * 256), 4, 0, 0);
    }
    __device__ __forceinline__ unsigned a_voff(int nrow, const LAS unsigned char* ent, int rl, int C) const {
        if (GATHER) { int slot = *(const volatile LAS int*)(ent + rl * 8); if (rl >= nrow) slot = 0; return (unsigned)((slot >> 3) * ldaB + C * 2); }
        return (unsigned)(rl * ldaB + C * 2);
    }
};

using pg8::f32x4; using pg8::u32x4; using pg8::pack8; using pg8::unpack8; using pg8::sigmoid4;
#define EPI_ROWS_BEGIN _Pragma("unroll") for (int ai = 0; ai < 2; ++ai) _Pragma("unroll") for (int m = 0; m < 4; ++m) { const int row = u.pm * 256 + ai * 128 + wr * 64 + m * 16 + fr;
#define EPI_ROWS_END }
#define UNROLL _Pragma("unroll")
typedef const pg8::f32x4 (&AccRef)[2][2][4][2];
__device__ __forceinline__ v2u pack8_fp8(f32x4 a, f32x4 b) {
    UNROLL for (int i = 0; i < 4; ++i) { a[i] = fminf(fmaxf(a[i], -448.f), 448.f); b[i] = fminf(fmaxf(b[i], -448.f), 448.f); }
    int p0 = __builtin_amdgcn_cvt_pk_fp8_f32(a[0], a[1], 0, false); p0 = __builtin_amdgcn_cvt_pk_fp8_f32(a[2], a[3], p0, true);
    int p1 = __builtin_amdgcn_cvt_pk_fp8_f32(b[0], b[1], 0, false); p1 = __builtin_amdgcn_cvt_pk_fp8_f32(b[2], b[3], p1, true);
    v2u r; r.x = (unsigned)p0; r.y = (unsigned)p1; return r; }
__device__ __forceinline__ f32x4 unpack4_fp8(unsigned w) { const auto lo = __builtin_amdgcn_cvt_pk_f32_fp8((int)w, false), hi = __builtin_amdgcn_cvt_pk_f32_fp8((int)w, true); return (f32x4){lo[0], lo[1], hi[0], hi[1]}; }
struct EpiProj { static constexpr bool PERM = true; bf16 *U, *V, *GP, *GC;
    __device__ __forceinline__ void operator()(AccRef acc, const pg8::Unit& u, int wr, int wc, int fr, int fq, const LAS unsigned char* ent) const {
        const int cb = wc * 32 + 8 * fq;
        if (u.pn < 2) {
            EPI_ROWS_BEGIN
                bf16* p = U + (size_t)row * PW + u.pn * 256 + cb;
                UNROLL for (int bj = 0; bj < 2; ++bj) *(u32x4*)(p + bj * 128) = pack8(acc[ai][bj][m][0], acc[ai][bj][m][1]);
            EPI_ROWS_END
        } else if (u.pn < 6) {
            const int j = u.pn - 2;
            EPI_ROWS_BEGIN
                bf16* p = V + (size_t)row * CW + j * 128 + cb;
                *(u32x4*)p = pack8(acc[ai][0][m][0] * sigmoid4(acc[ai][1][m][0]), acc[ai][0][m][1] * sigmoid4(acc[ai][1][m][1]));
            EPI_ROWS_END
        } else {
            bf16* Gt = (u.pn < 10) ? GP : GC; const int t = (u.pn - 6) & 3;
            EPI_ROWS_BEGIN
                bf16* p = Gt + (size_t)row * D + t * 256 + cb;
                UNROLL for (int bj = 0; bj < 2; ++bj) *(u32x4*)(p + bj * 128) = pack8(sigmoid4(acc[ai][bj][m][0]), sigmoid4(acc[ai][bj][m][1]));
            EPI_ROWS_END
        }
    }
};
struct EpiPool { static constexpr bool PERM = true; const float* scale; const bf16* GP; bf16* T1;
    __device__ __forceinline__ void operator()(AccRef acc, const pg8::Unit& u, int wr, int wc, int fr, int fq, const LAS unsigned char* ent) const {
        const int c0 = u.pn * 256 + wc * 32 + 8 * fq; const int row0 = u.pm * 256 + wr * 64 + fr;
        UNROLL for (int bj = 0; bj < 2; ++bj) {
            const f32x4 sc0 = *(const f32x4*)(scale + c0 + bj * 128), sc1 = *(const f32x4*)(scale + c0 + bj * 128 + 4);
            u32x4 g[2][4];
            UNROLL for (int ai = 0; ai < 2; ++ai) UNROLL for (int m = 0; m < 4; ++m) g[ai][m] = *(const u32x4*)(GP + (size_t)(row0 + ai * 128 + m * 16) * D + c0 + bj * 128);
            UNROLL for (int ai = 0; ai < 2; ++ai) UNROLL for (int m = 0; m < 4; ++m) { f32x4 g0, g1; unpack8(g[ai][m], g0, g1);
                *(u32x4*)(T1 + (size_t)(row0 + ai * 128 + m * 16) * D + c0 + bj * 128) = pack8(acc[ai][bj][m][0] * sc0 * g0, acc[ai][bj][m][1] * sc1 * g1); }
        }
    }
};
struct EpiConvOut { static constexpr bool PERM = true; const bf16* T1; const bf16* GC; bf16* MG;
    __device__ __forceinline__ void operator()(AccRef acc, const pg8::Unit& u, int wr, int wc, int fr, int fq, const LAS unsigned char* ent) const {
        const int c0 = u.pn * 256 + wc * 32 + 8 * fq; const int row0 = u.pm * 256 + wr * 64 + fr;
        UNROLL for (int bj = 0; bj < 2; ++bj)
            UNROLL for (int ai = 0; ai < 2; ++ai) {
                u32x4 g[4], t[4];
                UNROLL for (int m = 0; m < 4; ++m) { const size_t o = (size_t)(row0 + ai * 128 + m * 16) * D + c0 + bj * 128; g[m] = *(const u32x4*)(GC + o); t[m] = *(const u32x4*)(T1 + o); }
                UNROLL for (int m = 0; m < 4; ++m) { const size_t o = (size_t)(row0 + ai * 128 + m * 16) * D + c0 + bj * 128; f32x4 g0, g1, t0, t1; unpack8(g[m], g0, g1); unpack8(t[m], t0, t1);
                    *(u32x4*)(MG + o) = pack8(t0 + acc[ai][bj][m][0] * g0, t1 + acc[ai][bj][m][1] * g1); }
                asm volatile("" ::: "memory");
            }
    }
};
struct EpiWout { static constexpr bool PERM = true; const float* X; float* Z;
    __device__ __forceinline__ void operator()(AccRef acc, const pg8::Unit& u, int wr, int wc, int fr, int fq, const LAS unsigned char* ent) const {
        const int c0 = u.pn * 256 + wc * 32 + 8 * fq; const int row0 = u.pm * 256 + wr * 64 + fr;
        UNROLL for (int bj = 0; bj < 2; ++bj)
            UNROLL for (int ai = 0; ai < 2; ++ai) {
                f32x4 x0[4], x1[4];
                UNROLL for (int m = 0; m < 4; ++m) { const size_t o = (size_t)(row0 + ai * 128 + m * 16) * D + c0 + bj * 128; x0[m] = *(const f32x4*)(X + o); x1[m] = *(const f32x4*)(X + o + 4); }
                UNROLL for (int m = 0; m < 4; ++m) { const size_t o = (size_t)(row0 + ai * 128 + m * 16) * D + c0 + bj * 128;
                    *(f32x4*)(Z + o) = x0[m] * ALPHA + acc[ai][bj][m][0]; *(f32x4*)(Z + o + 4) = x1[m] * ALPHA + acc[ai][bj][m][1]; }
                asm volatile("" ::: "memory");
            }
    }
};
__device__ __forceinline__ f32x4 silu_mul4(const f32x4 g, const f32x4 v) { return g * sigmoid4(g) * v; }
struct EpiRSh { static constexpr bool PERM = true; float* LOG; bf16* HS;
    __device__ __forceinline__ void operator()(AccRef acc, const pg8::Unit& u, int wr, int wc, int fr, int fq, const LAS unsigned char* ent) const {
        const int cb = wc * 32 + 8 * fq;
        if (u.pn == 0) {
            EPI_ROWS_BEGIN
                float* p = LOG + (size_t)row * NE + cb;
                UNROLL for (int bj = 0; bj < 2; ++bj) { *(f32x4*)(p + bj * 128) = acc[ai][bj][m][0]; *(f32x4*)(p + bj * 128 + 4) = acc[ai][bj][m][1]; }
            EPI_ROWS_END
        } else {
            const int j = u.pn - 1;
            EPI_ROWS_BEGIN
                bf16* p = HS + (size_t)row * EH + j * 128 + cb;
                *(u32x4*)p = pack8(silu_mul4(acc[ai][0][m][0], acc[ai][1][m][0]), silu_mul4(acc[ai][0][m][1], acc[ai][1][m][1]));
            EPI_ROWS_END
        }
    }
};
struct EpiEGU { static constexpr bool PERM = true; unsigned char* HE;
    __device__ __forceinline__ void operator()(AccRef acc, const pg8::Unit& u, int wr, int wc, int fr, int fq, const LAS unsigned char* ent) const {
        const int cb = wc * 32 + 8 * fq;
        EPI_ROWS_BEGIN
            unsigned char* p = HE + (size_t)row * EH + u.pn * 128 + cb;
            *(v2u*)p = pack8_fp8(silu_mul4(acc[ai][0][m][0], acc[ai][1][m][0]) * HSCALE, silu_mul4(acc[ai][0][m][1], acc[ai][1][m][1]) * HSCALE);
        EPI_ROWS_END
    }
};
struct EpiEDown { static constexpr bool PERM = true; unsigned char* Y;
    __device__ __forceinline__ void operator()(AccRef acc, const pg8::Unit& u, int wr, int wc, int fr, int fq, const LAS unsigned char* ent) const {
        const unsigned cbyte = (unsigned)(u.pn * 256 + wc * 32 + 8 * fq);
        UNROLL for (int ai = 0; ai < 2; ++ai)
            UNROLL for (int m = 0; m < 4; ++m) { const int rl = ai * 128 + wr * 64 + m * 16 + fr;
                if (rl < u.nrow) { const v2u e2 = *(const LAS v2u*)(ent + rl * 8); const float w = __uint_as_float(e2.y) * YSCALE;
                    const unsigned off = e2.x * (unsigned)D + cbyte;
                    UNROLL for (int bj = 0; bj < 2; ++bj) *(v2u*)(Y + off + bj * 128) = pack8_fp8(acc[ai][bj][m][0] * w, acc[ai][bj][m][1] * w); }
                asm volatile("" ::: "memory"); }
    }
};
struct EpiSDown { static constexpr bool PERM = true; bf16* YS;
    __device__ __forceinline__ void operator()(AccRef acc, const pg8::Unit& u, int wr, int wc, int fr, int fq, const LAS unsigned char* ent) const {
        const int c0 = u.pn * 256 + wc * 32 + 8 * fq;
        EPI_ROWS_BEGIN
            bf16* p = YS + (size_t)row * D + c0;
            UNROLL for (int bj = 0; bj < 2; ++bj) *(u32x4*)(p + bj * 128) = pack8(acc[ai][bj][m][0], acc[ai][bj][m][1]);
        EPI_ROWS_END
    }
};

__device__ __forceinline__ void p0_item(const float* W, int N, bf16* WT, int ldw, int k0, int n0, int drow0, LAS float* scr, int lane) {
#pragma unroll 8
    for (int i = 0; i < 32; ++i) { const int kk = 2 * i + (lane >> 5); scr[kk * 33 + (lane & 31)] = W[(size_t)(k0 + kk) * N + n0 + (lane & 31)]; }
    LDS_WAIT(); asm volatile("" ::: "memory");
    const int c = lane & 7;
#pragma unroll
    for (int j = 0; j < 4; ++j) { const int n = (lane >> 3) + 8 * j; const LAS float* s = scr + (8 * c) * 33 + n;
        v4u o; o.x = pk2(s[0 * 33], s[1 * 33]); o.y = pk2(s[2 * 33], s[3 * 33]); o.z = pk2(s[4 * 33], s[5 * 33]); o.w = pk2(s[6 * 33], s[7 * 33]);
        *(GAS v4u*)(WT + (size_t)(drow0 + n) * ldw + k0 + 8 * c) = o; }
    LDS_WAIT(); asm volatile("" ::: "memory");
}
__device__ __forceinline__ void p0_item_fp8(const float* W, int N, unsigned char* WT, int ldw, int k0, int n0, int drow0, LAS float* scr, int lane) {
#pragma unroll 8
    for (int i = 0; i < 32; ++i) { const int kk = 2 * i + (lane >> 5); scr[kk * 33 + (lane & 31)] = W[(size_t)(k0 + kk) * N + n0 + (lane & 31)]; }
    LDS_WAIT(); asm volatile("" ::: "memory");
    const int c = lane & 3;
#pragma unroll
    for (int j = 0; j < 2; ++j) { const int n = (lane >> 2) + 16 * j; const LAS float* s = scr + (16 * c) * 33 + n;
        f32x4 a, b, c2, d;
        a = (f32x4){s[0 * 33], s[1 * 33], s[2 * 33], s[3 * 33]} * WSCALE; b = (f32x4){s[4 * 33], s[5 * 33], s[6 * 33], s[7 * 33]} * WSCALE;
        c2 = (f32x4){s[8 * 33], s[9 * 33], s[10 * 33], s[11 * 33]} * WSCALE; d = (f32x4){s[12 * 33], s[13 * 33], s[14 * 33], s[15 * 33]} * WSCALE;
        const v2u lo = pack8_fp8(a, b), hi = pack8_fp8(c2, d); v4u o; o.x = lo.x; o.y = lo.y; o.z = hi.x; o.w = hi.y;
        *(GAS v4u*)(WT + (size_t)(drow0 + n) * ldw + k0 + 16 * c) = o; }
    LDS_WAIT(); asm volatile("" ::: "memory");
}
__device__ __forceinline__ int win_row(int n0) {
    if (n0 < 512) return n0;
    if (n0 < 1024) { const int q = n0 - 512; return 512 + (q >> 7) * 256 + (q & 127); }
    if (n0 < 1536) { const int q = n0 - 1024; return 512 + (q >> 7) * 256 + 128 + (q & 127); }
    return n0;
}
__device__ __forceinline__ int gu_row(int n0, int up) { return (n0 >> 7) * 256 + up * 128 + (n0 & 127); }
__device__ __forceinline__ void p0_prologue(Frame& F) {
    LAS float* scr = (LAS float*)(F.lds + RING_OFF + F.wave * 16384);
    const int lane = lane_id(), tid = F.wave * 64 + lane;
    const int gw = F.vcu * NWAVES + F.wave, NGW = F.G * NWAVES;
    unsigned char* ws = F.ws;
    constexpr int I_WIN = 16 * 112, I_POOL = 4 * 16, I_CVO = 8 * 32, I_WOUT = 16 * 32, I_RT = 16 * 8, I_SG = 128, I_SU = 128, I_SD = 4 * 32, I_EG = NE * 128, I_EU = NE * 128, I_ED = NE * 128;
    constexpr int NITEMS = I_WIN + I_POOL + I_CVO + I_WOUT + I_RT + I_SG + I_SU + I_SD + I_EG + I_EU + I_ED;
    for (int it = gw; it < NITEMS; it += NGW) {
        int r = it;
        if (r < I_EG) { const int e = r >> 7, rr = r & 127, kb = rr >> 3, nb = rr & 7;
            p0_item_fp8(F.in[13] + (size_t)e * D * EH, EH, ws + WS_EGU + (size_t)e * 512 * D, D, 64 * kb, 32 * nb, gu_row(32 * nb, 0), scr, lane); continue; } r -= I_EG;
        if (r < I_EU) { const int e = r >> 7, rr = r & 127, kb = rr >> 3, nb = rr & 7;
            p0_item_fp8(F.in[14] + (size_t)e * D * EH, EH, ws + WS_EGU + (size_t)e * 512 * D, D, 64 * kb, 32 * nb, gu_row(32 * nb, 1), scr, lane); continue; } r -= I_EU;
        if (r < I_ED) { const int e = r >> 7, rr = r & 127, kb = rr >> 5, nb = rr & 31;
            p0_item_fp8(F.in[15] + (size_t)e * EH * D, D, ws + WS_EDN + (size_t)e * D * EH, EH, 64 * kb, 32 * nb, 32 * nb, scr, lane); continue; } r -= I_ED;
        if (r < I_WIN) { const int kb = r / 112, nb = r % 112; p0_item(F.in[1], INC, (bf16*)(ws + WS_WIN), D, 64 * kb, 32 * nb, win_row(32 * nb), scr, lane); continue; } r -= I_WIN;
        if (r < I_POOL) { const int g = r >> 4, rr = r & 15, kb = rr >> 3, nb = rr & 7;
            p0_item(F.in[2] + (size_t)g * 128 * 256, 256, (bf16*)(ws + WS_POOL) + (size_t)g * 256 * 128, 128, 64 * kb, 32 * nb, 32 * nb, scr, lane); continue; } r -= I_POOL;
        if (r < I_CVO) { const int kb = r >> 5, nb = r & 31; p0_item(F.in[7], D, (bf16*)(ws + WS_CVO), CW, 64 * kb, 32 * nb, 32 * nb, scr, lane); continue; } r -= I_CVO;
        if (r < I_WOUT) { const int kb = r >> 5, nb = r & 31; p0_item(F.in[8], D, (bf16*)(ws + WS_WOUT), D, 64 * kb, 32 * nb, 32 * nb, scr, lane); continue; } r -= I_WOUT;
        if (r < I_RT) { const int kb = r >> 3, nb = r & 7; p0_item(F.in[11], NE, (bf16*)(ws + WS_RSH), D, 64 * kb, 32 * nb, 32 * nb, scr, lane); continue; } r -= I_RT;
        if (r < I_SG) { const int kb = r >> 3, nb = r & 7; p0_item(F.in[16], EH, (bf16*)(ws + WS_RSH), D, 64 * kb, 32 * nb, 256 + gu_row(32 * nb, 0), scr, lane); continue; } r -= I_SG;
        if (r < I_SU) { const int kb = r >> 3, nb = r & 7; p0_item(F.in[17], EH, (bf16*)(ws + WS_RSH), D, 64 * kb, 32 * nb, 256 + gu_row(32 * nb, 1), scr, lane); continue; } r -= I_SU;
        { const int kb = r >> 5, nb = r & 31; p0_item(F.in[18], D, (bf16*)(ws + WS_SDN), EH, 64 * kb, 32 * nb, 32 * nb, scr, lane); }
    }
    const GAS f32x4* x4 = (const GAS f32x4*)F.in[0]; GAS v4u* xb = (GAS v4u*)(ws + WS_XB);
    for (int i = (int)blockIdx.x * NTHR + tid; i < M * D / 8; i += F.G * NTHR) { const f32x4 a = x4[2 * i], b = x4[2 * i + 1];
        v4u o; o.x = pk2(a.x, a.y); o.y = pk2(a.z, a.w); o.z = pk2(b.x, b.y); o.w = pk2(b.z, b.w); xb[i] = o; }
}

__device__ __forceinline__ void ld8(const LAS unsigned char* p, float (&v)[8]) { const v4u w = *(const LAS v4u*)p;
    v[0] = pg8::bf_lo(w.x); v[1] = pg8::bf_hi(w.x); v[2] = pg8::bf_lo(w.y); v[3] = pg8::bf_hi(w.y); v[4] = pg8::bf_lo(w.z); v[5] = pg8::bf_hi(w.z); v[6] = pg8::bf_lo(w.w); v[7] = pg8::bf_hi(w.w); }
__device__ __forceinline__ void p2_mixer(Frame& F) {
    constexpr int TT = 32, VR = TT + CK - 1  , UR = TT + 15  , DW_BYTES = CK * CW * 4  ;
    LAS unsigned char* ldw = F.lds; LAS unsigned char* lrow = F.lds + DW_BYTES;
    const bf16* U = (const bf16*)(F.ws + WS_U); const bf16* V = (const bf16*)(F.ws + WS_V); bf16* Rb = (bf16*)(F.ws + WS_R); bf16* Cb = (bf16*)(F.ws + WS_C);
    const int lane = lane_id(), w = F.wave, tid = w * 64 + lane;
    for (int i = tid; i < CK * CW / 4; i += NTHR) *(LAS f32x4*)(ldw + 16 * i) = *(const GAS f32x4*)(F.in[4] + 4 * i);
    for (int i = tid; i < 128; i += NTHR) *(LAS v4u*)(lrow + 62 * 1024 + 16 * i) = (v4u){0u, 0u, 0u, 0u};
    float lg[8], lb[8];
#pragma unroll
    for (int k = 0; k < 8; ++k) { lg[k] = F.in[5][lane * 8 + k]; lb[k] = F.in[6][lane * 8 + k]; }
    const int W = 2 << (lane >> 4);
    for (int unit = F.vcu; unit < M / TT; unit += F.G) {
        const int t0 = unit * TT, s0 = t0 % SEQ;
        __syncthreads();
        for (int c = tid; c < VR * 64; c += NTHR) { const int row = c >> 6, q = c & 63; const int s = s0 - (CK - 1) + row;
            v4u val = (v4u){0u, 0u, 0u, 0u}; if (s >= 0) val = *(const GAS v4u*)(V + (size_t)(t0 - (CK - 1) + row) * CW + q * 8);
            *(LAS v4u*)(lrow + row * 1024 + q * 16) = val; }
        __syncthreads();
        {
            float acc[4][8], wr_[4][8];
#pragma unroll
            for (int q = 0; q < 4; ++q)
#pragma unroll
                for (int k = 0; k < 8; ++k) { acc[q][k] = 0.f; wr_[q][k] = 0.f; }
#pragma unroll 1
            for (int i4 = 0; i4 < 9; ++i4) {
#pragma unroll
                for (int ii = 0; ii < 4; ++ii) { const int i = 4 * i4 + ii;
                    f32x4 a = (f32x4){0.f, 0.f, 0.f, 0.f}, b = a;
                    if (i <= 30) { a = *(const LAS f32x4*)(ldw + i * 2048 + lane * 32); b = *(const LAS f32x4*)(ldw + i * 2048 + lane * 32 + 16); }
                    wr_[ii][0] = a.x; wr_[ii][1] = a.y; wr_[ii][2] = a.z; wr_[ii][3] = a.w; wr_[ii][4] = b.x; wr_[ii][5] = b.y; wr_[ii][6] = b.z; wr_[ii][7] = b.w;
                    float v[8]; ld8(lrow + (4 * w + i) * 1024 + lane * 16, v);
#pragma unroll
                    for (int q = 0; q < 4; ++q) {
#pragma unroll
                        for (int k = 0; k < 8; ++k) acc[q][k] = fmaf(v[k], wr_[(ii - q) & 3][k], acc[q][k]); }
                }
            }
#pragma unroll
            for (int q = 0; q < 4; ++q) {
                float s = 0.f;
#pragma unroll
                for (int k = 0; k < 8; ++k) s += acc[q][k];
                const float mean = wave_sum(s) * (1.f / CW); float s2 = 0.f;
#pragma unroll
                for (int k = 0; k < 8; ++k) { acc[q][k] -= mean; s2 += acc[q][k] * acc[q][k]; }
                const float rstd = 1.f / sqrtf(wave_sum(s2) * (1.f / CW) + LN_EPS);
                float y[8];
#pragma unroll
                for (int k = 0; k < 8; ++k) { const float z = acc[q][k] * rstd * lg[k] + lb[k]; y[k] = z * pg8::sigmoidf_(z); }
                v4u o; o.x = pk2(y[0], y[1]); o.y = pk2(y[2], y[3]); o.z = pk2(y[4], y[5]); o.w = pk2(y[6], y[7]);
                *(GAS v4u*)(Cb + (size_t)(t0 + 4 * w + q) * CW + lane * 8) = o;
            }
        }
        __syncthreads();
        for (int c = tid; c < UR * 64; c += NTHR) { const int row = c >> 6, q = c & 63; const int s = s0 - 15 + row;
            v4u val = (v4u){0u, 0u, 0u, 0u}; if (s >= 0) val = *(const GAS v4u*)(U + (size_t)(t0 - 15 + row) * PW + q * 8);
            *(LAS v4u*)(lrow + row * 1024 + q * 16) = val; }
        __syncthreads();
        {
            float acc[4][8], own[4][8];
#pragma unroll
            for (int q = 0; q < 4; ++q)
#pragma unroll
                for (int k = 0; k < 8; ++k) { acc[q][k] = 0.f; own[q][k] = 0.f; }
#pragma unroll
            for (int i = 0; i < 19; ++i) {
                float v[8]; ld8(lrow + (4 * w + i) * 1024 + lane * 16, v);
#pragma unroll
                for (int q = 0; q < 4; ++q) { const int d = q + 15 - i; if (d >= 0 && d <= 15) { const bool in = d < W;
#pragma unroll
                    for (int k = 0; k < 8; ++k) { acc[q][k] += in ? v[k] : 0.f; if (d == 0) own[q][k] = v[k]; } } }
            }
#pragma unroll
            for (int q = 0; q < 4; ++q) { const int s = s0 + 4 * w + q; const int cnt = (s + 1) < W ? (s + 1) : W; const float inv = 1.f / (float)cnt;
                float y[8];
#pragma unroll
                for (int k = 0; k < 8; ++k) y[k] = acc[q][k] * inv - own[q][k];
                v4u o; o.x = pk2(y[0], y[1]); o.y = pk2(y[2], y[3]); o.z = pk2(y[4], y[5]); o.w = pk2(y[6], y[7]);
                *(GAS v4u*)(Rb + (size_t)(t0 + 4 * w + q) * PW + lane * 8) = o; }
        }
    }
    __syncthreads();
}

__device__ __forceinline__ void p6_ln1(Frame& F) {
    const int lane = lane_id();
    const int gw = F.vcu * NWAVES + F.wave, NGW = F.G * NWAVES;
    const float* Z = (const float*)(F.ws + WS_Z); bf16* X1 = (bf16*)(F.ws + WS_X1); unsigned char* X18 = F.ws + WS_X18;
    f32x4 g[4], b[4];
#pragma unroll
    for (int j = 0; j < 4; ++j) { g[j] = *(const GAS f32x4*)(F.in[9] + 4 * lane + 256 * j); b[j] = *(const GAS f32x4*)(F.in[10] + 4 * lane + 256 * j); }
    for (int m = gw; m < M; m += NGW) {
        const GAS f32x4* zr = (const GAS f32x4*)(Z + (size_t)m * D) + lane;
        f32x4 v[4]; float s = 0.f;
#pragma unroll
        for (int j = 0; j < 4; ++j) { v[j] = zr[64 * j]; s += (v[j].x + v[j].y) + (v[j].z + v[j].w); }
        const float mean = wave_sum(s) * (1.f / D); float s2 = 0.f;
#pragma unroll
        for (int j = 0; j < 4; ++j) { v[j] = v[j] - mean; s2 += (v[j].x * v[j].x + v[j].y * v[j].y) + (v[j].z * v[j].z + v[j].w * v[j].w); }
        const float rstd = 1.f / sqrtf(wave_sum(s2) * (1.f / D) + LN_EPS);
        GAS v2u* o8 = (GAS v2u*)(X1 + (size_t)m * D) + lane;
#pragma unroll
        for (int j = 0; j < 4; ++j) { const f32x4 y = v[j] * rstd * g[j] + b[j]; v2u o; o.x = pk2(y.x, y.y); o.y = pk2(y.z, y.w); o8[64 * j] = o;
            const v2u q = pack8_fp8(y * XSCALE, y * XSCALE); *(GAS unsigned*)(X18 + (size_t)m * D + 4 * lane + 256 * j) = q.x; }
    }
}

#define DPP_U(v, ctrl, rmask) ((unsigned)__builtin_amdgcn_update_dpp((int)(v), (int)(v), (ctrl), (rmask), 0xf, false))
#define DPP_F(v, ctrl) __builtin_bit_cast(float, __builtin_amdgcn_update_dpp(__builtin_bit_cast(int, (v)), __builtin_bit_cast(int, (v)), (ctrl), 0xf, 0xf, false))
__device__ __forceinline__ unsigned wave_max_u32(unsigned v) {
    v = max(v, DPP_U(v, 0xB1, 0xf)); v = max(v, DPP_U(v, 0x4E, 0xf)); v = max(v, DPP_U(v, 0x141, 0xf)); v = max(v, DPP_U(v, 0x140, 0xf));
    v = max(v, DPP_U(v, 0x142, 0xa)); v = max(v, DPP_U(v, 0x143, 0xc));
    return (unsigned)__builtin_amdgcn_readlane((int)v, 63);
}
__device__ __forceinline__ void route_token(const f32x4 lg, const f32x4 bias, int lane, int& myidx, float& wgt) {
    const float sc0 = 1.f / (1.f + __expf(-lg.x)), sc1 = 1.f / (1.f + __expf(-lg.y)), sc2 = 1.f / (1.f + __expf(-lg.z)), sc3 = 1.f / (1.f + __expf(-lg.w));
    const float c0 = sc0 + bias.x, c1 = sc1 + bias.y, c2 = sc2 + bias.z, c3 = sc3 + bias.w;
    const float h01 = fmaxf(c0, c1), l01 = fminf(c0, c1), h23 = fmaxf(c2, c3), l23 = fminf(c2, c3);
    float m1 = fmaxf(h01, h23), m2 = fmaxf(fminf(h01, h23), fmaxf(l01, l23));
    { float b1 = DPP_F(m1, 0xB1), b2 = DPP_F(m2, 0xB1); float n1 = fmaxf(m1, b1), n2 = fmaxf(fminf(m1, b1), fmaxf(m2, b2)); m1 = n1; m2 = n2;
      b1 = DPP_F(m1, 0x4E); b2 = DPP_F(m2, 0x4E); n1 = fmaxf(m1, b1); n2 = fmaxf(fminf(m1, b1), fmaxf(m2, b2)); m1 = n1; m2 = n2;
      b1 = DPP_F(m1, 0x141); b2 = DPP_F(m2, 0x141); n1 = fmaxf(m1, b1); n2 = fmaxf(fminf(m1, b1), fmaxf(m2, b2)); m1 = n1; m2 = n2; }
    const float gs = m1 + m2; const int mygrp = lane >> 3; int rank = 0;
#pragma unroll
    for (int g = 0; g < NG; ++g) { const float og = __builtin_bit_cast(float, __builtin_amdgcn_readlane(__builtin_bit_cast(int, gs), g * 8)); rank += (og > gs || (og == gs && g < mygrp)) ? 1 : 0; }
    const unsigned e0 = 255u - 4u * (unsigned)lane;
    unsigned k0 = (__float_as_uint(c0 + 1.f) & ~255u) | e0, k1 = (__float_as_uint(c1 + 1.f) & ~255u) | (e0 - 1u), k2 = (__float_as_uint(c2 + 1.f) & ~255u) | (e0 - 2u), k3 = (__float_as_uint(c3 + 1.f) & ~255u) | (e0 - 3u);
    if (rank >= 4) { k0 = 0u; k1 = 0u; k2 = 0u; k3 = 0u; }
    float sumw = 0.f, mysc = 0.f; myidx = 0;
#pragma unroll
    for (int r = 0; r < TOPK; ++r) {
        const unsigned win = wave_max_u32(max(max(k0, k1), max(k2, k3)));
        const int gi = 255 - (int)(win & 255u), owner = gi >> 2, kk = gi & 3;
        const float s0 = __builtin_bit_cast(float, __builtin_amdgcn_readlane(__builtin_bit_cast(int, sc0), owner)), s1 = __builtin_bit_cast(float, __builtin_amdgcn_readlane(__builtin_bit_cast(int, sc1), owner));
        const float s2 = __builtin_bit_cast(float, __builtin_amdgcn_readlane(__builtin_bit_cast(int, sc2), owner)), s3 = __builtin_bit_cast(float, __builtin_amdgcn_readlane(__builtin_bit_cast(int, sc3), owner));
        const float bs = kk == 0 ? s0 : (kk == 1 ? s1 : (kk == 2 ? s2 : s3));
        if (lane == r) { myidx = gi; mysc = bs; }
        sumw += bs;
        if (k0 == win) k0 = 0u; if (k1 == win) k1 = 0u; if (k2 == win) k2 = 0u; if (k3 == win) k3 = 0u;
    }
    wgt = mysc / sumw * RSCALE;
}
__device__ __forceinline__ void p8_route(Frame& F, int dummy = 0) {
    const int lane = lane_id(), tid = F.wave * 64 + lane;
    const int gw = F.vcu * NWAVES + F.wave, NGW = F.G * NWAVES;
    const float* LOG = (const float*)(F.ws + WS_LOG); int* list = (int*)(F.ws + (dummy ? WS_HE + 96 * MiB : WS_LIST)); unsigned* cnt = (unsigned*)F.ctl + (dummy ? CW_CNT + 32768 : CW_CNT);
    LAS unsigned* lcnt = (LAS unsigned*)(F.lds + TAB_OFF); LAS unsigned* lbase = lcnt + NE;
    const f32x4 bias = *(const GAS f32x4*)(F.in[12] + 4 * lane);
    constexpr int NB = 4, NTW = 16;
    if (tid < NE) lcnt[tid] = 0u;
    __syncthreads();
    int idx[NTW]; float wg[NTW]; unsigned rk[NTW];
#pragma unroll
    for (int g = 0; g < NTW / NB; ++g) {
        f32x4 lg[NB];
#pragma unroll
        for (int b = 0; b < NB; ++b) { const int tok = gw * NTW + g * NB + b; lg[b] = *(const GAS f32x4*)(LOG + (size_t)(tok < M ? tok : 0) * NE + 4 * lane); }
#pragma unroll
        for (int b = 0; b < NB; ++b) { route_token(lg[b], bias, lane, idx[g * NB + b], wg[g * NB + b]);
            rk[g * NB + b] = 0u; if (lane < TOPK && gw * NTW + g * NB + b < M) rk[g * NB + b] = __hip_atomic_fetch_add(&lcnt[idx[g * NB + b]], 1u, __ATOMIC_RELAXED, __HIP_MEMORY_SCOPE_WORKGROUP); }
    }
    __syncthreads();
    if (tid < NE) { const unsigned c = lcnt[tid]; unsigned base = 0u; if (c) base = atomicAdd(&cnt[tid * 64], c); lbase[tid] = base; }
    __syncthreads();
    if (lane < TOPK) {
#pragma unroll
        for (int b = 0; b < NTW; ++b) { const int tok = gw * NTW + b;
            if (tok < M) { v2u ent; ent.x = (unsigned)(tok * TOPK + lane); ent.y = __float_as_uint(wg[b]); *(GAS v2u*)(list + ((size_t)idx[b] * ECAP + lbase[idx[b]] + rk[b]) * 2) = ent; } }
    }
    __syncthreads();
}

__device__ __forceinline__ int expert_table(Frame& F) {
    LAS int* tstart = (LAS int*)(F.lds + TAB_OFF); LAS int* cntl = tstart + 260; LAS int* wtot = tstart + 520;
    const unsigned* cnt = (const unsigned*)F.ctl + CW_CNT;
    const int lane = lane_id(), tid = F.wave * 64 + lane;
    __syncthreads();
    int c = 0, incl = 0;
    if (tid < NE) { c = (int)__hip_atomic_load(cnt + tid * 64, RLX_AGENT); incl = (c + 255) >> 8;
#pragma unroll
        for (int o = 1; o < 64; o <<= 1) { const int up = __shfl_up(incl, o); if (lane >= o) incl += up; }
        if (lane == 63) wtot[F.wave] = incl; cntl[tid] = c; }
    __syncthreads();
    if (tid < NE) { int base = 0;
#pragma unroll
        for (int k = 0; k < 4; ++k) if (k < F.wave) base += wtot[k];
        tstart[tid + 1] = base + incl; if (tid == 0) tstart[0] = 0; }
    __syncthreads();
    return tstart[NE];
}

__device__ __forceinline__ void p11_combine(Frame& F) {
    const int lane = lane_id();
    const int gw = F.vcu * NWAVES + F.wave, NGW = F.G * NWAVES;
    const unsigned char* Y = F.ws + WS_Y; const bf16* YS = (const bf16*)(F.ws + WS_YSH); const bf16* X1 = (const bf16*)(F.ws + WS_X1);
    for (int tok = gw; tok < M; tok += NGW) {
        f32x4 a[4];
#pragma unroll
        for (int j = 0; j < 2; ++j) { f32x4 x0, x1; unpack8(*(const GAS v4u*)(X1 + (size_t)tok * D + lane * 16 + 8 * j), x0, x1); a[2 * j] = x0 * ALPHA; a[2 * j + 1] = x1 * ALPHA;
            f32x4 s0, s1; unpack8(*(const GAS v4u*)(YS + (size_t)tok * D + lane * 16 + 8 * j), s0, s1); a[2 * j] += s0; a[2 * j + 1] += s1; }
#if !(defined(DBG_COMBINE) && (DBG_COMBINE & 1))
        f32x4 r[4] = {(f32x4){0.f, 0.f, 0.f, 0.f}, (f32x4){0.f, 0.f, 0.f, 0.f}, (f32x4){0.f, 0.f, 0.f, 0.f}, (f32x4){0.f, 0.f, 0.f, 0.f}};
#pragma unroll
        for (int k = 0; k < TOPK; ++k) { const v4u q = *(const GAS v4u*)(Y + ((size_t)tok * TOPK + k) * D + lane * 16);
            r[0] += unpack4_fp8(q.x); r[1] += unpack4_fp8(q.y); r[2] += unpack4_fp8(q.z); r[3] += unpack4_fp8(q.w); }
#pragma unroll
        for (int j = 0; j < 4; ++j) a[j] += r[j] * (1.f / YSCALE);
#endif
        float s = 0.f;
#pragma unroll
        for (int j = 0; j < 4; ++j) s += (a[j].x + a[j].y) + (a[j].z + a[j].w);
        const float mean = wave_sum(s) * (1.f / D); float s2 = 0.f;
#pragma unroll
        for (int j = 0; j < 4; ++j) { a[j] = a[j] - mean; s2 += (a[j].x * a[j].x + a[j].y * a[j].y) + (a[j].z * a[j].z + a[j].w * a[j].w); }
        const float rstd = 1.f / sqrtf(wave_sum(s2) * (1.f / D) + LN_EPS);
#pragma unroll
        for (int j = 0; j < 4; ++j) { const int col = lane * 16 + 4 * j;
            const f32x4 g = *(const GAS f32x4*)(F.in[19] + col), b = *(const GAS f32x4*)(F.in[20] + col);
            *(GAS f32x4*)(F.out + (size_t)tok * D + col) = a[j] * rstd * g + b; }
    }
}
#ifdef DBG_CHECK
constexpr int NT = 512;
constexpr size_t DBG_OFF = 448 * MiB;
__device__ __forceinline__ float dsig(float x) { return 1.f / (1.f + expf(-x)); }
__device__ __forceinline__ float bf2f(unsigned short h) { return __uint_as_float((unsigned)h << 16); }
__global__ void dbg_proj(const float* x, const float* w_in, float* PN) {
    for (int i = blockIdx.x * blockDim.x + threadIdx.x; i < NT * INC; i += gridDim.x * blockDim.x) { const int tok = i / INC, col = i % INC; float a = 0.f;
        for (int k = 0; k < D; ++k) a = fmaf(x[(size_t)tok * D + k], w_in[(size_t)k * INC + col], a); PN[i] = a; }
}
__global__ void dbg_mix1(const float* PN, const float* dw, float* RN, float* CVN) {
    for (int i = blockIdx.x * blockDim.x + threadIdx.x; i < NT * 512; i += gridDim.x * blockDim.x) { const int tok = i / 512, ch = i % 512; const int g = ch / 128, W = 2 << g;
        float s = 0.f; int cnt = 0; for (int j = 0; j < W; ++j) if (tok - j >= 0) { s += PN[(size_t)(tok - j) * INC + ch]; ++cnt; }
        RN[i] = s / (float)cnt - PN[(size_t)tok * INC + ch];
        float c = 0.f; for (int j = 0; j < CK; ++j) { const int t = tok - (CK - 1) + j; if (t >= 0) c += PN[(size_t)t * INC + 512 + ch] * dsig(PN[(size_t)t * INC + 1024 + ch]) * dw[j * 512 + ch]; }
        CVN[i] = c; }
}
__global__ void dbg_ln(const float* IN, int n, const float* g, const float* b, float* OUT, int act) {
    const int tok = blockIdx.x * blockDim.x + threadIdx.x; if (tok >= NT) return;
    float m = 0.f; for (int k = 0; k < n; ++k) m += IN[(size_t)tok * n + k]; m /= n; float v = 0.f; for (int k = 0; k < n; ++k) { const float d = IN[(size_t)tok * n + k] - m; v += d * d; } v /= n;
    const float r = 1.f / sqrtf(v + LN_EPS); for (int k = 0; k < n; ++k) { float y = (IN[(size_t)tok * n + k] - m) * r * g[k] + b[k]; if (act) y = y * dsig(y); OUT[(size_t)tok * n + k] = y; }
}
__global__ void dbg_mix3(const float* PN, const float* RN, const float* CN, const float* pool_w, const float* scale, const float* cwo, float* MGN) {
    for (int i = blockIdx.x * blockDim.x + threadIdx.x; i < NT * D; i += gridDim.x * blockDim.x) { const int tok = i / D, d = i % D, g = d / 256, dd = d % 256;
        float yp = 0.f; for (int c = 0; c < 128; ++c) yp = fmaf(RN[(size_t)tok * 512 + g * 128 + c], pool_w[((size_t)g * 128 + c) * 256 + dd], yp); yp *= scale[d];
        float yc = 0.f; for (int c = 0; c < 512; ++c) yc = fmaf(CN[(size_t)tok * 512 + c], cwo[(size_t)c * D + d], yc);
        MGN[i] = dsig(PN[(size_t)tok * INC + 1536 + d]) * yp + dsig(PN[(size_t)tok * INC + 2560 + d]) * yc; }
}
__global__ void dbg_mix4(const float* MGN, const float* w_out, const float* x, float* ZN) {
    for (int i = blockIdx.x * blockDim.x + threadIdx.x; i < NT * D; i += gridDim.x * blockDim.x) { const int tok = i / D, e = i % D; float a = 0.f;
        for (int d = 0; d < D; ++d) a = fmaf(MGN[(size_t)tok * D + d], w_out[(size_t)d * D + e], a); ZN[i] = ALPHA * x[(size_t)tok * D + e] + a; }
}
__global__ void dbg_cmp(int k, const void* buf, int kind, int ld, int n, const float* NV, int nld, int ncol0, int fn, const float* PN, float* acc) {
    float e2 = 0.f, r2 = 0.f;
    for (int i = blockIdx.x * blockDim.x + threadIdx.x; i < NT * n; i += gridDim.x * blockDim.x) { const int tok = i / n, c = i % n;
        const float a = kind ? ((const float*)buf)[(size_t)tok * ld + c] : bf2f(((const unsigned short*)buf)[(size_t)tok * ld + c]);
        float b = NV[(size_t)tok * nld + ncol0 + c];
        if (fn == 1) b = dsig(b);
        if (fn == 2) b = b * dsig(PN[(size_t)tok * INC + 1024 + c]);
        e2 += (a - b) * (a - b); r2 += b * b; }
    atomicAdd(acc + 2 * k, e2); atomicAdd(acc + 2 * k + 1, r2);
}
__global__ void dbg_cmp_tile(int k, const void* buf, int ld, int r0, int c0, const float* NV, int nld, int ncol0, float* acc) {
    float e2 = 0.f, r2 = 0.f;
    for (int i = blockIdx.x * blockDim.x + threadIdx.x; i < 256 * 256; i += gridDim.x * blockDim.x) { const int tok = r0 + i / 256, c = c0 + i % 256;
        const float a = bf2f(((const unsigned short*)buf)[(size_t)tok * ld + c]); const float b = dsig(NV[(size_t)tok * nld + ncol0 + c]);
        e2 += (a - b) * (a - b); r2 += b * b; }
    atomicAdd(acc + 2 * k, e2); atomicAdd(acc + 2 * k + 1, r2);
}
__global__ void dbg_cmp_wt(int k, const unsigned short* WT, const float* W, int n0, float* acc) {
    float e2 = 0.f, r2 = 0.f;
    for (int i = blockIdx.x * blockDim.x + threadIdx.x; i < 256 * 1024; i += gridDim.x * blockDim.x) { const int n = n0 + i / 1024, kk = i % 1024;
        const float a = bf2f(WT[(size_t)n * 1024 + kk]); const float b = W[(size_t)kk * INC + n];
        e2 += (a - b) * (a - b); r2 += b * b; }
    atomicAdd(acc + 2 * k, e2); atomicAdd(acc + 2 * k + 1, r2);
}
__global__ void dbg_code(const float* acc, int nchk, float* out, int n) {
    int code = 0; for (int k = nchk - 1; k >= 0; --k) if (!(acc[2 * k] <= 1e-3f * acc[2 * k + 1])) code = k + 1;
#ifdef DBG_TILES
    code = 0; for (int k = 0; k < 4; ++k) if (!(acc[2 * (16 + k)] <= 1e-3f * acc[2 * (16 + k) + 1])) code |= 1 << k;
#endif
#ifdef DBG_SHOW
    const float val = sqrtf(1000.f * acc[2 * DBG_SHOW] / acc[2 * DBG_SHOW + 1]);
    for (int i = blockIdx.x * blockDim.x + threadIdx.x; i < n; i += gridDim.x * blockDim.x) out[i] = val;
#else
    for (int i = blockIdx.x * blockDim.x + threadIdx.x; i < n; i += gridDim.x * blockDim.x) out[i] = (float)code;
#endif
}
static void dbg_run(void* const* d_in, float* d_out, unsigned char* ws, hipStream_t st, int stop) {
    float* PN = d_out; float* RN = PN + (size_t)NT * INC; float* CVN = RN + NT * 512; float* CN = CVN + NT * 512; float* MGN = CN + NT * 512; float* ZN = MGN + (size_t)NT * D; float* X1N = ZN + (size_t)NT * D; float* acc = X1N + (size_t)NT * D;
    const float* x = (const float*)d_in[0];
    hipMemsetAsync(acc, 0, 64 * 4, st);
    dbg_proj<<<2048, 256, 0, st>>>(x, (const float*)d_in[1], PN);
    dbg_mix1<<<1024, 256, 0, st>>>(PN, (const float*)d_in[4], RN, CVN);
    dbg_ln<<<NT / 64, 64, 0, st>>>(CVN, 512, (const float*)d_in[5], (const float*)d_in[6], CN, 1);
    dbg_mix3<<<2048, 256, 0, st>>>(PN, RN, CN, (const float*)d_in[2], (const float*)d_in[3], (const float*)d_in[7], MGN);
    dbg_mix4<<<2048, 256, 0, st>>>(MGN, (const float*)d_in[8], x, ZN);
    dbg_ln<<<NT / 64, 64, 0, st>>>(ZN, D, (const float*)d_in[9], (const float*)d_in[10], X1N, 0);
    if (stop <= 4) {
    dbg_cmp<<<256, 256, 0, st>>>(0, ws + WS_U, 0, 512, 512, PN, INC, 0, 0, PN, acc);
    dbg_cmp<<<256, 256, 0, st>>>(1, ws + WS_V, 0, 512, 512, PN, INC, 512, 2, PN, acc);
    dbg_cmp<<<256, 256, 0, st>>>(2, ws + WS_GP, 0, D, D, PN, INC, 1536, 1, PN, acc);
    dbg_cmp<<<256, 256, 0, st>>>(3, ws + WS_GC, 0, D, D, PN, INC, 2560, 1, PN, acc);
    }
    dbg_cmp<<<256, 256, 0, st>>>(4, ws + WS_R, 0, 512, 512, RN, 512, 0, 0, PN, acc);
    dbg_cmp<<<256, 256, 0, st>>>(5, ws + WS_C, 0, 512, 512, CN, 512, 0, 0, PN, acc);
    if (stop >= 7) {
    dbg_cmp<<<256, 256, 0, st>>>(6, ws + WS_MG, 0, D, D, MGN, D, 0, 0, PN, acc);
    dbg_cmp<<<256, 256, 0, st>>>(7, ws + WS_Z, 1, D, D, ZN, D, 0, 0, PN, acc);
    dbg_cmp<<<256, 256, 0, st>>>(8, ws + WS_X1, 0, D, D, X1N, D, 0, 0, PN, acc);
    }
#ifdef DBG_WT
    dbg_cmp_wt<<<256, 256, 0, st>>>(DBG_SHOW, (const unsigned short*)(ws + WS_WIN), (const float*)d_in[1], DBG_WT, acc);
#endif
#ifdef DBG_TILES
    for (int t = 0; t < 4; ++t) dbg_cmp_tile<<<64, 256, 0, st>>>(16 + t, ws + ((DBG_TILES & 2) ? WS_GC : WS_GP), D, (DBG_TILES & 1) * 256, t * 256, PN, INC, ((DBG_TILES & 2) ? 2560 : 1536), acc);
#endif
    hipMemcpyAsync(ws + WS_CTL + 65536, acc, 64 * 4, hipMemcpyDeviceToDevice, st);
    dbg_code<<<1024, 256, 0, st>>>((const float*)(ws + WS_CTL + 65536), 9, d_out, M * D);
}
#endif

#ifndef MK_N_LAUNCHES
#define MK_N_LAUNCHES 1
#endif
constexpr int N_PHASES = 12;
struct Args { const float* in[21]; float* out; unsigned char* ws; int ph_lo, ph_hi; };
__global__ void __launch_bounds__(NTHR, 2) mk_fwd(Args args) {
    extern __shared__ __attribute__((aligned(16))) unsigned char lds[];
    Frame F;
    F.lds = (LAS unsigned char*)lds;
    F.MISC = (volatile LAS unsigned*)(F.lds + MISC_OFF);
    F.wave = __builtin_amdgcn_readfirstlane((int)threadIdx.x >> 6);
    F.G = gridDim.x; { const int bx = blockIdx.x; F.vcu = (F.G % 8 == 0) ? (bx % 8) * (F.G / 8) + bx / 8 : bx; }
    F.ws = args.ws; F.ctl = (gu32*)(args.ws + WS_CTL); F.out = args.out;
#pragma unroll
    for (int i = 0; i < 21; ++i) F.in[i] = args.in[i];
    for (int u = threadIdx.x; u < (LDS_BYTES - TAB_OFF) / 4; u += NTHR) ((LAS unsigned*)(F.lds + TAB_OFF))[u] = 0u;
    __syncthreads();
    const int lo = args.ph_lo, hi = args.ph_hi;
    const bool multi = (hi - lo) > 1;
    XcdBarrier bar; bar.bar = (unsigned*)(F.ctl + CW_BAR); bar.x = 0; bar.st = nullptr;
    if (multi) bar = xcd_barrier_post((unsigned*)(F.ctl + CW_BAR), F.MISC + 8);
#ifndef PH_MASK
#define PH_MASK 0xFFF
#endif
#define IN(k) ((((PH_MASK) >> (k)) & 1) && lo <= (k) && (k) < hi)
#define SEAM(k) do { if (IN(k) && IN((k) + 1)) xcd_barrier(bar, F.wave); } while (0)
    unsigned char* ws = args.ws;
    LAS unsigned char* ring = F.lds + RING_OFF; LAS unsigned char* entl = F.lds + ENT_OFF;
    const int bx = (int)blockIdx.x;

#ifndef DUP_MASK
#define DUP_MASK 0
#endif
#define DUP(k) ((((DUP_MASK) >> (k)) & 1) != 0)
#define PHASE(k, BODY) do { if (IN(k)) { BODY; if (DUP(k)) { xcd_barrier(bar, F.wave); BODY; } } SEAM(k); } while (0)
    PHASE(0, p0_prologue(F));
#define P1_BODY { DenseOrder S; S.init((const bf16*)(ws + WS_XB), (const bf16*)(ws + WS_WIN), M, INC, D, D, D, 0, F.G, bx); \
        EpiProj E{(bf16*)(ws + WS_U), (bf16*)(ws + WS_V), (bf16*)(ws + WS_GP), (bf16*)(ws + WS_GC)}; \
        pg8::gemm_phase<EpiProj, DenseOrder>(ring, entl, S, E, F.wave); }
    PHASE(1, P1_BODY);
    PHASE(2, p2_mixer(F));
#define P3_BODY { DenseOrder S; S.init((const bf16*)(ws + WS_R), (const bf16*)(ws + WS_POOL), M, D, 128, PW, 128, 128, F.G, bx); \
        EpiPool E{F.in[3], (const bf16*)(ws + WS_GP), (bf16*)(ws + WS_T1)}; \
        pg8::gemm_phase<EpiPool, DenseOrder>(ring, entl, S, E, F.wave); }
    PHASE(3, P3_BODY);
#define P4_BODY { DenseOrder S; S.init((const bf16*)(ws + WS_C), (const bf16*)(ws + WS_CVO), M, D, CW, CW, CW, 0, F.G, bx); \
        EpiConvOut E{(const bf16*)(ws + WS_T1), (const bf16*)(ws + WS_GC), (bf16*)(ws + WS_MG)}; \
        pg8::gemm_phase<EpiConvOut, DenseOrder>(ring, entl, S, E, F.wave); }
    PHASE(4, P4_BODY);
#define P5_BODY { DenseOrder S; S.init((const bf16*)(ws + WS_MG), (const bf16*)(ws + WS_WOUT), M, D, D, D, D, 0, F.G, bx); \
        EpiWout E{F.in[0], (float*)(ws + WS_Z)}; \
        pg8::gemm_phase<EpiWout, DenseOrder>(ring, entl, S, E, F.wave); }
    PHASE(5, P5_BODY);
    PHASE(6, p6_ln1(F));
#define P7_BODY { DenseOrder S; S.init((const bf16*)(ws + WS_X1), (const bf16*)(ws + WS_RSH), M, 768, D, D, D, 0, F.G, bx); \
        EpiRSh E{(float*)(ws + WS_LOG), (bf16*)(ws + WS_HS)}; \
        pg8::gemm_phase<EpiRSh, DenseOrder>(ring, entl, S, E, F.wave); }
    PHASE(7, P7_BODY);
    if (IN(8)) { p8_route(F);
#ifdef ROUTE_DUP
        xcd_barrier(bar, F.wave); p8_route(F, 1);
#endif
        { DenseOrder S; S.init((const bf16*)(ws + WS_HS), (const bf16*)(ws + WS_SDN), M, D, EH, EH, EH, 0, F.G, bx);
          EpiSDown E{(bf16*)(ws + WS_YSH)};
          pg8::gemm_phase<EpiSDown, DenseOrder>(ring, entl, S, E, F.wave); } } SEAM(8);
#define P9_BODY { const int tt = expert_table(F); \
        ExpertOrder<true> S; S.A = ws + WS_X18; S.Bt = ws + WS_EGU; S.ldaB = D; S.ldbB = D; S.nt = D / 128; S.bstride = (size_t)512 * D; S.scaleA = E8_X; S.scaleB = E8_W; \
        S.tstart = (const LAS int*)(F.lds + TAB_OFF); S.cntl = S.tstart + 260; S.list = (const int*)(ws + WS_LIST); S.nN = 2; S.nwg = tt * 2; S.G = F.G; S.c = bx; \
        EpiEGU E{ws + WS_HE}; \
        pg8::gemm_phase<EpiEGU, ExpertOrder<true>>(ring, entl, S, E, F.wave); }
    PHASE(9, P9_BODY);
#define P10_BODY { const int tt = expert_table(F); \
        { ExpertOrder<false> S; S.A = ws + WS_HE; S.Bt = ws + WS_EDN; S.ldaB = EH; S.ldbB = EH; S.nt = EH / 128; S.bstride = (size_t)D * EH; S.scaleA = E8_H; S.scaleB = E8_W; \
          S.tstart = (const LAS int*)(F.lds + TAB_OFF); S.cntl = S.tstart + 260; S.list = (const int*)(ws + WS_LIST); S.nN = 4; S.nwg = tt * 4; S.G = F.G; S.c = bx; \
          EpiEDown E{ws + WS_Y}; \
          pg8::gemm_phase<EpiEDown, ExpertOrder<false>>(ring, entl, S, E, F.wave); } }
    PHASE(10, P10_BODY);
    PHASE(11, p11_combine(F));
#undef IN
#undef SEAM
}

extern "C" void kernel_launch(void* const* d_in, const int* in_sizes, int n_in, void* d_out, int out_size, void* d_ws, size_t ws_size, hipStream_t stream) {
    static int grid = 0;
    if (grid == 0) {
        if (n_in != 21 || in_sizes[0] != M * D || out_size != M * D || ws_size < WS_END) { fprintf(stderr, "kernel_launch: unexpected shapes (n_in %d, in0 %d, out %d, ws %zu)\n", n_in, n_in > 0 ? in_sizes[0] : -1, out_size, ws_size); grid = -1; return; }
        int dev = 0, cus = 0;
        if (hipGetDevice(&dev) != hipSuccess || hipDeviceGetAttribute(&cus, hipDeviceAttributeMultiprocessorCount, dev) != hipSuccess) { grid = -1; return; }
        if (hipFuncSetAttribute((const void*)mk_fwd, hipFuncAttributeMaxDynamicSharedMemorySize, LDS_BYTES) != hipSuccess) { fprintf(stderr, "kernel_launch: hipFuncSetAttribute failed\n"); grid = -1; return; }
        (void)hipGetLastError();
        grid = cus;
    }
    if (grid < 0) return;
    (void)hipMemsetAsync((char*)d_ws + WS_CTL, 0, CTL_ZERO_BYTES, stream);
    Args a{};
    for (int i = 0; i < 21; ++i) a.in[i] = (const float*)d_in[i];
    a.out = (float*)d_out; a.ws = (unsigned char*)d_ws;
    constexpr int NL = MK_N_LAUNCHES;
    for (int li = 0; li < NL; ++li) {
        a.ph_lo = (NL == 1) ? 0 : li; a.ph_hi = (NL == 1) ? N_PHASES : li + 1;
        hipLaunchKernelGGL(mk_fwd, dim3(grid), dim3(NTHR), LDS_BYTES, stream, a);
#ifdef DBG_CHECK
        if (a.ph_hi == DBG_CHECK) { dbg_run(d_in, (float*)d_out, (unsigned char*)d_ws, stream, DBG_CHECK); return; }
#endif
    }
}
```

```cpp
#define MK_N_LAUNCHES 1

#include <hip/hip_runtime.h>
#include <cstdio>
#include <cstdint>

namespace pg8 {
#define PG8_LAS __attribute__((address_space(3)))
typedef unsigned short bf16_t;
typedef short bf16x8 __attribute__((ext_vector_type(8)));
typedef float f32x4 __attribute__((ext_vector_type(4)));
typedef float f32x2 __attribute__((ext_vector_type(2)));
typedef unsigned u32x4 __attribute__((ext_vector_type(4)));
typedef unsigned u32x2 __attribute__((ext_vector_type(2)));
typedef int i32x4 __attribute__((ext_vector_type(4)));
typedef int i32x8 __attribute__((ext_vector_type(8)));
constexpr int BM = 256, BK = 64, HALF = 128, HTB = HALF * BK * 2  , STAGE_BYTES = 8 * HTB, NXCD = 8, WGM = 8;

__host__ __device__ __forceinline__ int lds_byte(int r, int c) { const int st = (r >> 4) * 2 + (c >> 5), rr = r & 15, cc = c & 31, ob = rr * 64 + cc * 2; return st * 1024 + (ob ^ (((ob >> 9) & 1) << 5)); }
__host__ __device__ __forceinline__ void stage_rc(int b, int& R, int& C) { const int st = b / 1024, sb = b % 1024, swz = sb ^ (((sb >> 9) & 1) << 5); R = (st >> 1) * 16 + swz / 64; C = (st & 1) * 32 + (swz % 64) / 2; }
__host__ __device__ __forceinline__ int perm32(int rho) { const int n = rho >> 4, i = rho & 15; return 8 * (i >> 2) + 4 * n + (i & 3); }

struct Unit { int pm, pn, e, r0, nrow; };

typedef __bf16 bf16x2_t __attribute__((ext_vector_type(2)));
__device__ __forceinline__ unsigned cvt_pk_bf16(float lo, float hi) { f32x2 v = {lo, hi}; bf16x2_t b = __builtin_convertvector(v, bf16x2_t); return __builtin_bit_cast(unsigned, b); }
__device__ __forceinline__ u32x4 pack8(const f32x4 a, const f32x4 b) { u32x4 w; w.x = cvt_pk_bf16(a[0], a[1]); w.y = cvt_pk_bf16(a[2], a[3]); w.z = cvt_pk_bf16(b[0], b[1]); w.w = cvt_pk_bf16(b[2], b[3]); return w; }
__device__ __forceinline__ float bf_lo(unsigned w) { return __uint_as_float(w << 16); }
__device__ __forceinline__ float bf_hi(unsigned w) { return __uint_as_float(w & 0xffff0000u); }
__device__ __forceinline__ void unpack8(const u32x4 w, f32x4& a, f32x4& b) { a = (f32x4){bf_lo(w.x), bf_hi(w.x), bf_lo(w.y), bf_hi(w.y)}; b = (f32x4){bf_lo(w.z), bf_hi(w.z), bf_lo(w.w), bf_hi(w.w)}; }
__device__ __forceinline__ float sigmoidf_(float x) { return __builtin_amdgcn_rcpf(1.0f + __expf(-x)); }
__device__ __forceinline__ f32x4 sigmoid4(const f32x4 x) { return (f32x4){sigmoidf_(x[0]), sigmoidf_(x[1]), sigmoidf_(x[2]), sigmoidf_(x[3])}; }

template <class Epi, class Sched>
__device__ __forceinline__ void gemm_phase(PG8_LAS unsigned char* lds, PG8_LAS unsigned char* ent, const Sched& S, const Epi& E, int wid_) {
    int lane_; asm volatile("v_mbcnt_lo_u32_b32 %0, -1, 0\n\tv_mbcnt_hi_u32_b32 %0, -1, %0" : "=v"(lane_));
    const int wid = __builtin_amdgcn_readfirstlane(wid_), lane = lane_, tid = wid * 64 + lane, wr = wid >> 2, wc = wid & 3, fr = lane & 15, fq = lane >> 4;
    int nt_ = S.nt; asm volatile("" : "+s"(nt_));
    const int nt = nt_;
    int sR[2], sC[2]; unsigned voffB[2];
#pragma unroll
    for (int i = 0; i < 2; ++i) { int R, C; stage_rc(tid * 16 + i * 8192, R, C); const int Rb = Epi::PERM ? ((R & ~31) + perm32(R & 31)) : R;
        sR[i] = R; sC[i] = C; voffB[i] = (unsigned)(Rb * S.ldbB + C * 2); }
    const size_t kstep = (size_t)(BK * 2);
    const size_t hstepB = (size_t)HALF * S.ldbB;
    const unsigned ldsw = (unsigned)wid * 1024u;
    const int aoff = lds_byte(wr * 64 + fr, fq * 8), boff = lds_byte(wc * 32 + fr, fq * 8);
    PG8_LAS unsigned char* abase = lds + aoff; PG8_LAS unsigned char* bbase = lds + 4 * HTB + boff;
    asm volatile("" : "+v"(abase), "+v"(bbase));
#define PG8_SA(b, h) (((b) * 2 + (h)) * HTB)
#define PG8_SB(b, h) ((4 + (b) * 2 + (h)) * HTB)
#define PG8_STAGE(bufoff, gbase, voff) do { _Pragma("unroll") for (int _i = 0; _i < 2; ++_i) \
        __builtin_amdgcn_global_load_lds((const unsigned*)((const char*)(gbase) + (voff)[_i]), (PG8_LAS unsigned*)(lds + (bufoff) + ldsw + _i * 8192), 16, 0, 0); } while (0)
#define PG8_STAGE_A(bufoff, gbase, nrow_, e_, h) do { _Pragma("unroll") for (int _i = 0; _i < 2; ++_i) \
        __builtin_amdgcn_global_load_lds((const unsigned*)((const char*)(gbase) + S.a_voff((nrow_), (e_), (h) * 128 + sR[_i], sC[_i])), (PG8_LAS unsigned*)(lds + (bufoff) + ldsw + _i * 8192), 16, 0, 0); } while (0)
#define PG8_LD8(p) __builtin_shufflevector(*(const PG8_LAS i32x4*)(p), *(const PG8_LAS i32x4*)((p) + 1024), 0, 1, 2, 3, 4, 5, 6, 7)
#define PG8_LDA(dst, b, h) do { if constexpr (Sched::FP8) { _Pragma("unroll") for (int m = 0; m < 4; ++m) dst##8[m] = PG8_LD8(abase + PG8_SA(b, h) + m * 2048); } \
        else { _Pragma("unroll") for (int m = 0; m < 4; ++m) _Pragma("unroll") for (int k = 0; k < 2; ++k) dst[m][k] = *(const PG8_LAS bf16x8*)(abase + PG8_SA(b, h) + m * 2048 + k * 1024); } } while (0)
#define PG8_LDB(dst, b, h) do { if constexpr (Sched::FP8) { _Pragma("unroll") for (int n = 0; n < 2; ++n) dst##8[n] = PG8_LD8(bbase + PG8_SA(b, h) + n * 2048); } \
        else { _Pragma("unroll") for (int n = 0; n < 2; ++n) _Pragma("unroll") for (int k = 0; k < 2; ++k) dst[n][k] = *(const PG8_LAS bf16x8*)(bbase + PG8_SA(b, h) + n * 2048 + k * 1024); } } while (0)
#define PG8_MMA(ai, bj, At, Bt) do { __builtin_amdgcn_s_setprio(1); \
        if constexpr (Sched::FP8) { _Pragma("unroll") for (int m = 0; m < 4; ++m) _Pragma("unroll") for (int n = 0; n < 2; ++n) \
            asm volatile("v_mfma_scale_f32_16x16x128_f8f6f4 %0, %1, %2, %0, %3, %4 op_sel_hi:[0,0,0]" : "+v"(acc[ai][bj][m][n]) : "v"(Bt##8[n]), "v"(At##8[m]), "v"(scB), "v"(scA)); } \
        else { _Pragma("unroll") for (int m = 0; m < 4; ++m) _Pragma("unroll") for (int n = 0; n < 2; ++n) _Pragma("unroll") for (int k = 0; k < 2; ++k) \
            acc[ai][bj][m][n] = __builtin_amdgcn_mfma_f32_16x16x32_bf16(Bt[n][k], At[m][k], acc[ai][bj][m][n], 0, 0, 0); } \
        __builtin_amdgcn_s_setprio(0); } while (0)
#define PG8_WAIT_V(n) asm volatile("s_waitcnt vmcnt(" #n ")" ::: "memory")
#define PG8_WAIT_L(n) asm volatile("s_waitcnt lgkmcnt(" #n ")" ::: "memory")
#define PG8_BAR __builtin_amdgcn_s_barrier()
#define PG8_SCHED __builtin_amdgcn_sched_barrier(0)
    Unit cur, nxt; int ui = 0;
    if (!S.next(0, cur)) return;
    f32x4 acc[2][2][4][2];
#pragma unroll
    for (int a = 0; a < 2; ++a)
#pragma unroll
        for (int b = 0; b < 2; ++b)
#pragma unroll
            for (int m = 0; m < 4; ++m)
#pragma unroll
                for (int n = 0; n < 2; ++n) acc[a][b][m][n] = (f32x4){0.f, 0.f, 0.f, 0.f};
    const int scA = S.scaleA, scB = S.scaleB;
    bf16x8 At[4][2], B0[2][2], B1[2][2]; i32x8 At8[4], B08[2], B18[2];
    const char* cA = S.a_ptr(cur); const char* cB = S.b_ptr(cur);
    if constexpr (Sched::META) {
        S.meta_issue(cur, ent, wid, lane); if (S.next(1, nxt)) S.meta_issue(nxt, ent + 2048, wid, lane);
        PG8_WAIT_V(0); PG8_BAR;
    }
    PG8_STAGE(PG8_SB(0, 0), cB, voffB); PG8_STAGE(PG8_SB(0, 1), cB + hstepB, voffB); PG8_STAGE_A(PG8_SA(0, 0), cA, cur.nrow, ent, 0); PG8_STAGE_A(PG8_SA(0, 1), cA, cur.nrow, ent, 1);
    if (wr == 1) PG8_BAR;
    PG8_WAIT_V(2); PG8_BAR;
    PG8_STAGE(PG8_SB(1, 0), cB + kstep, voffB); PG8_STAGE_A(PG8_SA(1, 0), cA + kstep, cur.nrow, ent, 0); PG8_STAGE(PG8_SB(1, 1), cB + hstepB + kstep, voffB);
    PG8_WAIT_V(6); PG8_BAR;
    for (;;) {
        const bool has_next = S.next(ui + 1, nxt);
        const char* nA = cA; const char* nB = cB; int nnrow = cur.nrow; PG8_LAS unsigned char* const cent = ent + (ui & 3) * 2048; PG8_LAS unsigned char* nent = cent;
        if (has_next) { nA = S.a_ptr(nxt); nB = S.b_ptr(nxt); nnrow = nxt.nrow; nent = ent + ((ui + 1) & 3) * 2048; }
        if constexpr (Sched::META) { Unit u2; if (S.next(ui + 2, u2)) S.meta_issue(u2, ent + ((ui + 2) & 3) * 2048, wid, lane); }
        for (int t = 0; t < nt; t += 2) {
            const bool last = (t == nt - 2);
            const char* a1 = cA + (size_t)(t + 1) * kstep;
            const char* a2 = last ? nA : cA + (size_t)(t + 2) * kstep; const char* b2 = last ? nB : cB + (size_t)(t + 2) * kstep;
            const char* a3 = a2 + kstep; const char* b3 = b2 + kstep;
            const int xnrow = last ? nnrow : cur.nrow; PG8_LAS unsigned char* const xent = last ? nent : cent;
            PG8_LDB(B0, 0, 0); PG8_LDB(B1, 0, 1); PG8_SCHED; PG8_LDA(At, 0, 0); PG8_STAGE_A(PG8_SA(1, 1), a1, cur.nrow, cent, 1);
            PG8_WAIT_V(8); PG8_WAIT_L(0); PG8_BAR; PG8_MMA(0, 0, At, B0); PG8_MMA(0, 1, At, B1); PG8_BAR; PG8_SCHED;
            PG8_LDA(At, 0, 1); PG8_STAGE(PG8_SB(0, 0), b2, voffB); PG8_STAGE(PG8_SB(0, 1), b2 + hstepB, voffB); PG8_STAGE_A(PG8_SA(0, 0), a2, xnrow, xent, 0);
            PG8_WAIT_V(8); PG8_WAIT_L(0); PG8_BAR; PG8_MMA(1, 0, At, B0); PG8_MMA(1, 1, At, B1); PG8_BAR; PG8_SCHED;
            PG8_LDB(B0, 1, 0); PG8_LDB(B1, 1, 1); PG8_SCHED; PG8_LDA(At, 1, 0); PG8_STAGE_A(PG8_SA(0, 1), a2, xnrow, xent, 1);
            PG8_WAIT_V(8); PG8_WAIT_L(0); PG8_BAR; PG8_MMA(0, 0, At, B0); PG8_MMA(0, 1, At, B1); PG8_BAR; PG8_SCHED;
            PG8_LDA(At, 1, 1); PG8_STAGE(PG8_SB(1, 0), b3, voffB); PG8_STAGE(PG8_SB(1, 1), b3 + hstepB, voffB); PG8_STAGE_A(PG8_SA(1, 0), a3, xnrow, xent, 0);
            PG8_WAIT_V(8); PG8_WAIT_L(0); PG8_BAR; PG8_MMA(1, 0, At, B0); PG8_MMA(1, 1, At, B1); PG8_BAR; PG8_SCHED;
        }
        if (wr == 0) PG8_BAR;
        if constexpr (Sched::FP8) asm volatile("s_nop 15\n\ts_nop 15" ::: "memory");
        E(acc, cur, wr, wc, fr, fq, cent);
        if (!has_next) break;
#pragma unroll
        for (int a = 0; a < 2; ++a)
#pragma unroll
            for (int b = 0; b < 2; ++b)
#pragma unroll
                for (int m = 0; m < 4; ++m)
#pragma unroll
                    for (int n = 0; n < 2; ++n) acc[a][b][m][n] = (f32x4){0.f, 0.f, 0.f, 0.f};
        cur = nxt; cA = nA; cB = nB; ++ui;
        if (wr == 1) PG8_BAR;
    }
    PG8_WAIT_V(0);
    PG8_BAR;
#undef PG8_SA
#undef PG8_SB
#undef PG8_STAGE
#undef PG8_STAGE_A
#undef PG8_LDA
#undef PG8_LDB
#undef PG8_MMA
#undef PG8_WAIT_V
#undef PG8_WAIT_L
#undef PG8_BAR
#undef PG8_SCHED
}
}

constexpr int NWAVES = 8, NTHR = NWAVES * 64;
constexpr int D = 1024, BATCH = 4, SEQ = 8192, M = BATCH * SEQ;
constexpr int PW = 512, CW = 512, CK = 31, INC = 3584;
constexpr int NE = 256, TOPK = 8, NG = 8, EH = 256;
constexpr int NEX = NE + 1;
constexpr int ECAP = M;
constexpr int MAXT = (M * TOPK) / 256 + NE + M / 256;
constexpr float XSCALE = 16.f, WSCALE = 128.f, HSCALE = 8.f, YSCALE = 64.f;
constexpr int E8_X = 0x7b7b7b7b, E8_W = 0x78787878, E8_H = 0x7c7c7c7c;
constexpr float LN_EPS = 1e-5f, ALPHA = 1.189207115002721f  , RSCALE = 2.5f;

constexpr size_t MiB = 1u << 20;
constexpr size_t WS_CTL = 0, CTL_ZERO_BYTES = 1 * MiB;
constexpr size_t WS_WIN = 1 * MiB;
constexpr size_t WS_POOL = 8 * MiB;
constexpr size_t WS_CVO = 8 * MiB + 512 * 1024;
constexpr size_t WS_WOUT = 10 * MiB;
constexpr size_t WS_RSH = 12 * MiB;
constexpr size_t WS_SDN = 14 * MiB;
constexpr size_t WS_EDN = 16 * MiB;
constexpr size_t WS_X18 = 96 * MiB;
constexpr size_t WS_X1 = 144 * MiB;
constexpr size_t WS_HS = 208 * MiB;
constexpr size_t WS_LIST = 224 * MiB;
constexpr size_t WS_HE = 289 * MiB;
constexpr size_t WS_EGU = 448 * MiB;
constexpr size_t WS_PH = 704 * MiB;
constexpr size_t WS_XB = WS_PH;
constexpr size_t WS_U = WS_PH + 64 * MiB, WS_V = WS_PH + 96 * MiB;
constexpr size_t WS_GP = WS_PH + 128 * MiB, WS_GC = WS_PH + 192 * MiB;
constexpr size_t WS_R = WS_PH + 256 * MiB, WS_C = WS_PH + 288 * MiB;
constexpr size_t WS_T1 = WS_XB;
constexpr size_t WS_MG = WS_U;
constexpr size_t WS_Z = WS_GP;
constexpr size_t WS_LOG = WS_HE + 15 * MiB;
constexpr size_t WS_END = 1024 * MiB;
constexpr size_t WS_Y = WS_EGU;
static_assert(WS_Y + (size_t)M * 9 * D <= WS_R, "Y slots end before R");
constexpr size_t WS_YSH = WS_R;
static_assert(WS_YSH + (size_t)M * D * 2 <= WS_END, "ws map");
static_assert(WS_HE + (size_t)MAXT * 256 * EH <= WS_EGU, "HE fits");
static_assert(WS_LIST + (size_t)NEX * ECAP * 8 <= WS_HE, "LIST fits");

constexpr int CW_CNT = 32768;
constexpr int CW_BAR = 4096;

constexpr int RING_OFF = 0, RING_BYTES = 131072;
constexpr int TAB_OFF = RING_BYTES;
constexpr int ENT_OFF = TAB_OFF + 4096;
constexpr int MISC_OFF = ENT_OFF + 8192;
constexpr int LDS_BYTES = 147456;
static_assert(MISC_OFF + 128 <= LDS_BYTES, "LDS map");

#define GAS __attribute__((address_space(1)))
#define LAS __attribute__((address_space(3)))
typedef unsigned short bf16;
typedef unsigned v4u __attribute__((ext_vector_type(4)));
typedef unsigned v2u __attribute__((ext_vector_type(2)));
typedef float f32x4 __attribute__((ext_vector_type(4)));
typedef GAS unsigned gu32;
#define RLX_AGENT __ATOMIC_RELAXED, __HIP_MEMORY_SCOPE_AGENT
#define LDS_WAIT() asm volatile("s_waitcnt lgkmcnt(0)" ::: "memory")
#define VM_WAIT() asm volatile("s_waitcnt vmcnt(0)" ::: "memory")
__device__ __forceinline__ unsigned f2bf(float f) { unsigned u = __builtin_bit_cast(unsigned, f); return (u + 0x7fffu + ((u >> 16) & 1u)) >> 16; }
__device__ __forceinline__ unsigned pk2(float lo, float hi) { return pg8::cvt_pk_bf16(lo, hi); }

#define XB_TMO      128
#define XB_XCNT(j)  (256  + 64 * (j))
#define XB_XSUB(j)  (1280 + 64 * (j))
#define XB_XGEN(j)  (2304 + 64 * (j))
#define XB_TOP      3328
#define XB_TOPGEN   3392
#define XCD_BAR_WORDS 3456
#define XB_SPIN_CAP (1u << 20)
__device__ __forceinline__ unsigned xb_ld(unsigned* p)              { return __hip_atomic_load(p, __ATOMIC_RELAXED, __HIP_MEMORY_SCOPE_AGENT); }
__device__ __forceinline__ unsigned xb_add(unsigned* p, unsigned v) { return __hip_atomic_fetch_add(p, v, __ATOMIC_RELAXED, __HIP_MEMORY_SCOPE_AGENT); }
__device__ __forceinline__ unsigned xb_xcc_id() { return (unsigned)__builtin_amdgcn_s_getreg((3 << 11) | 20) & 0xFu; }
#define XB_SPIN(cond, bar) do { unsigned _sp = 0; while (cond) { __builtin_amdgcn_s_sleep(1); \
    if ((++_sp & 255u) == 0u) { if (xb_ld(&(bar)[XB_TMO])) break; if (_sp > XB_SPIN_CAP) { atomicAdd(&(bar)[XB_TMO], 1u); break; } } } } while (0)
struct XcdBarrier { unsigned* bar; unsigned x; volatile LAS unsigned* st; };
__device__ __forceinline__ XcdBarrier xcd_barrier_post(unsigned* bar, volatile LAS unsigned* st) {
    XcdBarrier b; b.bar = bar; b.x = xb_xcc_id(); b.st = st;
    if (threadIdx.x == 0) (void)xb_add(&bar[XB_XCNT(b.x)], 1u);
    return b;
}
__device__ __forceinline__ void xcd_barrier_complete(unsigned* bar, unsigned x, unsigned& nloc, unsigned& nx) {
    const unsigned G = gridDim.x * gridDim.y * gridDim.z;
    unsigned sum, cnt, mine, sp = 0u;
    for (;;) {
        sum = 0u; cnt = 0u; mine = 0u;
#pragma unroll
        for (unsigned j = 0; j < 16; ++j) { const unsigned c = xb_ld(&bar[XB_XCNT(j)]); sum += c; cnt += (c > 0u) ? 1u : 0u; mine = (j == x) ? c : mine; }
        if (sum == G) break;
        __builtin_amdgcn_s_sleep(1);
        if ((++sp & 255u) == 0u) { if (xb_ld(&bar[XB_TMO])) break; if (sp > XB_SPIN_CAP) { atomicAdd(&bar[XB_TMO], 1u); break; } }
    }
    nloc = mine > 0u ? mine : 1u; nx = cnt > 0u ? cnt : 1u;
}
__device__ __forceinline__ int lane_id();
__device__ __forceinline__ void xcd_barrier(const XcdBarrier& b, int wave) {
    asm volatile("s_waitcnt vmcnt(0)" ::: "memory");
    __syncthreads();
    if (wave == 0 && lane_id() == 0) {
        unsigned* bar = b.bar;
        __builtin_amdgcn_s_waitcnt(0);
        unsigned nloc = b.st[0], nx = b.st[1];
        if (nloc == 0u) { xcd_barrier_complete(bar, b.x, nloc, nx); b.st[0] = nloc; b.st[1] = nx; }
        const unsigned old = xb_add(&bar[XB_XSUB(b.x)], 1u);
        const unsigned gen = old / nloc;
        if (old + 1u == (gen + 1u) * nloc) {
            __builtin_amdgcn_fence(__ATOMIC_RELEASE, "agent");
            asm volatile("s_waitcnt vmcnt(0)" ::: "memory");
            const unsigned og = xb_add(&bar[XB_TOP], 1u);
            const unsigned tg = og / nx;
            if (og + 1u == (tg + 1u) * nx) xb_add(&bar[XB_TOPGEN], 1u);
            else XB_SPIN(xb_ld(&bar[XB_TOPGEN]) == tg, bar);
            __builtin_amdgcn_fence(__ATOMIC_ACQUIRE, "agent");
            xb_add(&bar[XB_XGEN(b.x)], 1u);
            asm volatile("s_waitcnt vmcnt(0)" ::: "memory");
        } else {
            XB_SPIN(xb_ld(&bar[XB_XGEN(b.x)]) == gen, bar);
            __builtin_amdgcn_fence(__ATOMIC_ACQUIRE, "agent");
            asm volatile("s_waitcnt vmcnt(0)" ::: "memory");
        }
    }
    __syncthreads();
}

struct Frame {
    LAS unsigned char* lds;
    volatile LAS unsigned* MISC;
    gu32* ctl;
    int wave;
    int vcu, G;
    const float* in[21]; float* out; unsigned char* ws;
};
__device__ __forceinline__ int lane_id() { int l; asm volatile("v_mbcnt_lo_u32_b32 %0, -1, 0\n\tv_mbcnt_hi_u32_b32 %0, -1, %0" : "=v"(l)); return l; }
__device__ __forceinline__ float wave_sum(float v) {
#pragma unroll
    for (int o = 1; o < 64; o <<= 1) v += __shfl_xor(v, o);
    return v;
}

__host__ __device__ __forceinline__ int xcd_chunk(int L, int nwg) {
    const int q = nwg / 8, r = nwg % 8, xcd = L % 8, off = L / 8;
    return (xcd < r ? xcd * (q + 1) : r * (q + 1) + (xcd - r) * q) + off;
}
struct DenseOrder {   static constexpr bool META = false, FP8 = false;
    const bf16* A; const bf16* Bt; int ldaB, ldbB, nt, acol_pn, brow_pn, bcol_pn; int scaleA, scaleB;
    int nM, nN, nwg, G, c;
    __device__ __forceinline__ void init(const bf16* A_, const bf16* Bt_, int Mr, int N, int K, int lda_, int ldb_, int acol_pn_, int G_, int c_) {
        A = A_; Bt = Bt_; ldaB = lda_ * 2; ldbB = ldb_ * 2; nt = K / 64; acol_pn = acol_pn_; nM = Mr / 256; nN = N / 256; nwg = nM * nN; G = G_; c = c_; scaleA = 0; scaleB = 0; brow_pn = 256; bcol_pn = 0; }
    __device__ __forceinline__ bool next(int i, pg8::Unit& u) const {
        const int L = i * G + c; if (L >= nwg) return false;
        const int wgid = xcd_chunk(L, nwg);
        const int nig = 8 * nN, gid = wgid / nig, fm = gid * 8, gsz = (nM - fm) < 8 ? (nM - fm) : 8;
        u.pm = fm + ((wgid % nig) % gsz); u.pn = (wgid % nig) / gsz; u.e = 0; u.r0 = 0; u.nrow = 256; return true;
    }
    __device__ __forceinline__ const char* a_ptr(const pg8::Unit& u) const { return (const char*)A + (size_t)u.pm * 256 * ldaB + u.pn * acol_pn * 2; }
    __device__ __forceinline__ const char* b_ptr(const pg8::Unit& u) const { return (const char*)Bt + (size_t)u.pn * brow_pn * ldbB + u.pn * bcol_pn * 2; }
    __device__ __forceinline__ unsigned a_voff(int, const LAS unsigned char*, int rl, int C) const { return (unsigned)(rl * ldaB + C * 2); }
};
template <bool GATHER> struct ExpertOrder {
    static constexpr bool META = true, FP8 = true;
    const unsigned char* A; const unsigned char* Bt; int ldaB, ldbB, nt; size_t bstride;
    int scaleA, scaleB;
    const LAS int* tstart; const LAS int* cntl; const int* list;
    int nN, nwg, G, c;
    __device__ __forceinline__ bool next(int i, pg8::Unit& u) const {
        const int L = i * G + c; if (L >= nwg) return false;
        const int wgid = xcd_chunk(L, nwg);
        const int t = wgid / nN; u.pn = wgid % nN; u.pm = t;
        int lo = 0, hi = NEX;
#pragma unroll
        for (int s = 0; s < 9; ++s) { const int mid = (lo + hi) >> 1; if (tstart[mid] <= t) lo = mid; else hi = mid; }
        u.e = lo; u.r0 = (t - tstart[lo]) * 256; u.nrow = cntl[lo] - u.r0; return true;
    }
    __device__ __forceinline__ const char* a_ptr(const pg8::Unit& u) const { return GATHER ? (const char*)A : (const char*)A + (size_t)u.pm * 256 * ldaB; }
    __device__ __forceinline__ const char* b_ptr(const pg8::Unit& u) const { return (const char*)Bt + (size_t)u.e * bstride + (size_t)u.pn * 256 * ldbB; }
    __device__ __forceinline__ void meta_issue(const pg8::Unit& u, LAS unsigned char* dst, int wid, int lane) const {
        const char* src = (const char*)(list + ((size_t)u.e * ECAP + u.r0) * 2) + wid * 256 + lane * 4;
        __builtin_amdgcn_global_load_lds((const unsigned*)src, (LAS unsigned*)(dst + wid * 256), 4, 0, 0);
    }
    __device__ __forceinline__ unsigned a_voff(int nrow, const LAS unsigned char* ent, int rl, int C) const {
        if (GATHER) { int slot = *(const volatile LAS int*)(ent + rl * 8); if (rl >= nrow) slot = 0; const int tok = slot < M * TOPK ? (slot >> 3) : slot - M * TOPK; return (unsigned)(tok * ldaB + C * 2); }
        return (unsigned)(rl * ldaB + C * 2);
    }
};

using pg8::f32x4; using pg8::u32x4; using pg8::pack8; using pg8::unpack8; using pg8::sigmoid4;
#define EPI_ROWS_BEGIN _Pragma("unroll") for (int ai = 0; ai < 2; ++ai) _Pragma("unroll") for (int m = 0; m < 4; ++m) { const int row = u.pm * 256 + ai * 128 + wr * 64 + m * 16 + fr;
#define EPI_ROWS_END }
#define UNROLL _Pragma("unroll")
typedef const pg8::f32x4 (&AccRef)[2][2][4][2];
__device__ __forceinline__ v2u pack8_fp8(f32x4 a, f32x4 b) {
    UNROLL for (int i = 0; i < 4; ++i) { a[i] = fminf(fmaxf(a[i], -448.f), 448.f); b[i] = fminf(fmaxf(b[i], -448.f), 448.f); }
    int p0 = __builtin_amdgcn_cvt_pk_fp8_f32(a[0], a[1], 0, false); p0 = __builtin_amdgcn_cvt_pk_fp8_f32(a[2], a[3], p0, true);
    int p1 = __builtin_amdgcn_cvt_pk_fp8_f32(b[0], b[1], 0, false); p1 = __builtin_amdgcn_cvt_pk_fp8_f32(b[2], b[3], p1, true);
    v2u r; r.x = (unsigned)p0; r.y = (unsigned)p1; return r; }
__device__ __forceinline__ f32x4 unpack4_fp8(unsigned w) { const auto lo = __builtin_amdgcn_cvt_pk_f32_fp8((int)w, false), hi = __builtin_amdgcn_cvt_pk_f32_fp8((int)w, true); return (f32x4){lo[0], lo[1], hi[0], hi[1]}; }
struct EpiProj { static constexpr bool PERM = true; bf16 *U, *V, *GP, *GC;
    __device__ __forceinline__ void operator()(AccRef acc, const pg8::Unit& u, int wr, int wc, int fr, int fq, const LAS unsigned char* ent) const {
        const int cb = wc * 32 + 8 * fq;
        if (u.pn < 2) {
            EPI_ROWS_BEGIN
                bf16* p = U + (size_t)row * PW + u.pn * 256 + cb;
                UNROLL for (int bj = 0; bj < 2; ++bj) *(u32x4*)(p + bj * 128) = pack8(acc[ai][bj][m][0], acc[ai][bj][m][1]);
            EPI_ROWS_END
        } else if (u.pn < 6) {
            const int j = u.pn - 2;
            EPI_ROWS_BEGIN
                bf16* p = V + (size_t)row * CW + j * 128 + cb;
                *(u32x4*)p = pack8(acc[ai][0][m][0] * sigmoid4(acc[ai][1][m][0]), acc[ai][0][m][1] * sigmoid4(acc[ai][1][m][1]));
            EPI_ROWS_END
        } else {
            bf16* Gt = (u.pn < 10) ? GP : GC; const int t = (u.pn - 6) & 3;
            EPI_ROWS_BEGIN
                bf16* p = Gt + (size_t)row * D + t * 256 + cb;
                UNROLL for (int bj = 0; bj < 2; ++bj) *(u32x4*)(p + bj * 128) = pack8(sigmoid4(acc[ai][bj][m][0]), sigmoid4(acc[ai][bj][m][1]));
            EPI_ROWS_END
        }
    }
};
struct EpiPool { static constexpr bool PERM = true; const float* scale; const bf16* GP; bf16* T1;
    __device__ __forceinline__ void operator()(AccRef acc, const pg8::Unit& u, int wr, int wc, int fr, int fq, const LAS unsigned char* ent) const {
        const int c0 = u.pn * 256 + wc * 32 + 8 * fq; const int row0 = u.pm * 256 + wr * 64 + fr;
        UNROLL for (int bj = 0; bj < 2; ++bj) {
            const f32x4 sc0 = *(const f32x4*)(scale + c0 + bj * 128), sc1 = *(const f32x4*)(scale + c0 + bj * 128 + 4);
            u32x4 g[2][4];
            UNROLL for (int ai = 0; ai < 2; ++ai) UNROLL for (int m = 0; m < 4; ++m) g[ai][m] = *(const u32x4*)(GP + (size_t)(row0 + ai * 128 + m * 16) * D + c0 + bj * 128);
            UNROLL for (int ai = 0; ai < 2; ++ai) UNROLL for (int m = 0; m < 4; ++m) { f32x4 g0, g1; unpack8(g[ai][m], g0, g1);
                *(u32x4*)(T1 + (size_t)(row0 + ai * 128 + m * 16) * D + c0 + bj * 128) = pack8(acc[ai][bj][m][0] * sc0 * g0, acc[ai][bj][m][1] * sc1 * g1); }
        }
    }
};
struct EpiConvOut { static constexpr bool PERM = true; const bf16* T1; const bf16* GC; bf16* MG;
    __device__ __forceinline__ void operator()(AccRef acc, const pg8::Unit& u, int wr, int wc, int fr, int fq, const LAS unsigned char* ent) const {
        const int c0 = u.pn * 256 + wc * 32 + 8 * fq; const int row0 = u.pm * 256 + wr * 64 + fr;
        UNROLL for (int bj = 0; bj < 2; ++bj)
            UNROLL for (int ai = 0; ai < 2; ++ai) {
                u32x4 g[4], t[4];
                UNROLL for (int m = 0; m < 4; ++m) { const size_t o = (size_t)(row0 + ai * 128 + m * 16) * D + c0 + bj * 128; g[m] = *(const u32x4*)(GC + o); t[m] = *(const u32x4*)(T1 + o); }
                UNROLL for (int m = 0; m < 4; ++m) { const size_t o = (size_t)(row0 + ai * 128 + m * 16) * D + c0 + bj * 128; f32x4 g0, g1, t0, t1; unpack8(g[m], g0, g1); unpack8(t[m], t0, t1);
                    *(u32x4*)(MG + o) = pack8(t0 + acc[ai][bj][m][0] * g0, t1 + acc[ai][bj][m][1] * g1); }
                asm volatile("" ::: "memory");
            }
    }
};
struct EpiWout { static constexpr bool PERM = true; const float* X; float* Z;
    __device__ __forceinline__ void operator()(AccRef acc, const pg8::Unit& u, int wr, int wc, int fr, int fq, const LAS unsigned char* ent) const {
        const int c0 = u.pn * 256 + wc * 32 + 8 * fq; const int row0 = u.pm * 256 + wr * 64 + fr;
        UNROLL for (int bj = 0; bj < 2; ++bj)
            UNROLL for (int ai = 0; ai < 2; ++ai) {
                f32x4 x0[4], x1[4];
                UNROLL for (int m = 0; m < 4; ++m) { const size_t o = (size_t)(row0 + ai * 128 + m * 16) * D + c0 + bj * 128; x0[m] = *(const f32x4*)(X + o); x1[m] = *(const f32x4*)(X + o + 4); }
                UNROLL for (int m = 0; m < 4; ++m) { const size_t o = (size_t)(row0 + ai * 128 + m * 16) * D + c0 + bj * 128;
                    *(f32x4*)(Z + o) = x0[m] * ALPHA + acc[ai][bj][m][0]; *(f32x4*)(Z + o + 4) = x1[m] * ALPHA + acc[ai][bj][m][1]; }
                asm volatile("" ::: "memory");
            }
    }
};
__device__ __forceinline__ f32x4 silu_mul4(const f32x4 g, const f32x4 v) { return g * sigmoid4(g) * v; }
struct EpiRSh { static constexpr bool PERM = true; float* LOG;
    __device__ __forceinline__ void operator()(AccRef acc, const pg8::Unit& u, int wr, int wc, int fr, int fq, const LAS unsigned char* ent) const {
        const int cb = wc * 32 + 8 * fq; float* L = LOG + (size_t)u.pn * M * NE;
        EPI_ROWS_BEGIN
            float* p = L + (size_t)row * NE + cb;
            UNROLL for (int bj = 0; bj < 2; ++bj) { *(f32x4*)(p + bj * 128) = acc[ai][bj][m][0]; *(f32x4*)(p + bj * 128 + 4) = acc[ai][bj][m][1]; }
        EPI_ROWS_END
    }
};
struct EpiEGU { static constexpr bool PERM = true; unsigned char* HE;
    __device__ __forceinline__ void operator()(AccRef acc, const pg8::Unit& u, int wr, int wc, int fr, int fq, const LAS unsigned char* ent) const {
        const int cb = wc * 32 + 8 * fq;
        EPI_ROWS_BEGIN
            unsigned char* p = HE + (size_t)row * EH + u.pn * 128 + cb;
            *(v2u*)p = pack8_fp8(silu_mul4(acc[ai][0][m][0], acc[ai][1][m][0]) * HSCALE, silu_mul4(acc[ai][0][m][1], acc[ai][1][m][1]) * HSCALE);
        EPI_ROWS_END
    }
};
struct EpiEDown { static constexpr bool PERM = true; unsigned char* Y;
    __device__ __forceinline__ void operator()(AccRef acc, const pg8::Unit& u, int wr, int wc, int fr, int fq, const LAS unsigned char* ent) const {
        const unsigned cbyte = (unsigned)(u.pn * 256 + wc * 32 + 8 * fq);
        UNROLL for (int ai = 0; ai < 2; ++ai)
            UNROLL for (int m = 0; m < 4; ++m) { const int rl = ai * 128 + wr * 64 + m * 16 + fr;
                if (rl < u.nrow) { const v2u e2 = *(const LAS v2u*)(ent + rl * 8); const float w = __uint_as_float(e2.y) * YSCALE;
                    const unsigned off = e2.x * (unsigned)D + cbyte;
                    UNROLL for (int bj = 0; bj < 2; ++bj) *(v2u*)(Y + off + bj * 128) = pack8_fp8(acc[ai][bj][m][0] * w, acc[ai][bj][m][1] * w); }
                asm volatile("" ::: "memory"); }
    }
};
__device__ __forceinline__ void p0_item(const float* W, int N, bf16* WT, int ldw, int k0, int n0, int drow0, LAS float* scr, int lane) {
#pragma unroll 8
    for (int i = 0; i < 32; ++i) { const int kk = 2 * i + (lane >> 5); scr[kk * 33 + (lane & 31)] = W[(size_t)(k0 + kk) * N + n0 + (lane & 31)]; }
    LDS_WAIT(); asm volatile("" ::: "memory");
    const int c = lane & 7;
#pragma unroll
    for (int j = 0; j < 4; ++j) { const int n = (lane >> 3) + 8 * j; const LAS float* s = scr + (8 * c) * 33 + n;
        v4u o; o.x = pk2(s[0 * 33], s[1 * 33]); o.y = pk2(s[2 * 33], s[3 * 33]); o.z = pk2(s[4 * 33], s[5 * 33]); o.w = pk2(s[6 * 33], s[7 * 33]);
        *(GAS v4u*)(WT + (size_t)(drow0 + n) * ldw + k0 + 8 * c) = o; }
    LDS_WAIT(); asm volatile("" ::: "memory");
}
__device__ __forceinline__ void p0_item_fp8(const float* W, int N, unsigned char* WT, int ldw, int k0, int n0, int drow0, LAS float* scr, int lane) {
#pragma unroll 8
    for (int i = 0; i < 64; ++i) { const int kk = 2 * i + (lane >> 5); scr[kk * 33 + (lane & 31)] = W[(size_t)(k0 + kk) * N + n0 + (lane & 31)]; }
    LDS_WAIT(); asm volatile("" ::: "memory");
    const int c = lane & 7;
#pragma unroll
    for (int j = 0; j < 4; ++j) { const int n = (lane >> 3) + 8 * j; const LAS float* s = scr + (16 * c) * 33 + n;
        f32x4 a, b, c2, d;
        a = (f32x4){s[0 * 33], s[1 * 33], s[2 * 33], s[3 * 33]} * WSCALE; b = (f32x4){s[4 * 33], s[5 * 33], s[6 * 33], s[7 * 33]} * WSCALE;
        c2 = (f32x4){s[8 * 33], s[9 * 33], s[10 * 33], s[11 * 33]} * WSCALE; d = (f32x4){s[12 * 33], s[13 * 33], s[14 * 33], s[15 * 33]} * WSCALE;
        const v2u lo = pack8_fp8(a, b), hi = pack8_fp8(c2, d); v4u o; o.x = lo.x; o.y = lo.y; o.z = hi.x; o.w = hi.y;
        *(GAS v4u*)(WT + (size_t)(drow0 + n) * ldw + k0 + 16 * c) = o; }
    LDS_WAIT(); asm volatile("" ::: "memory");
}
__device__ __forceinline__ int win_row(int n0) {
    if (n0 < 512) return n0;
    if (n0 < 1024) { const int q = n0 - 512; return 512 + (q >> 7) * 256 + (q & 127); }
    if (n0 < 1536) { const int q = n0 - 1024; return 512 + (q >> 7) * 256 + 128 + (q & 127); }
    return n0;
}
__device__ __forceinline__ int gu_row(int n0, int up) { return (n0 >> 7) * 256 + up * 128 + (n0 & 127); }
__device__ __forceinline__ void p0_prologue(Frame& F) {
    LAS float* scr = (LAS float*)(F.lds + RING_OFF + F.wave * 17408);
    const int lane = lane_id(), tid = F.wave * 64 + lane;
    const int gw = F.vcu * NWAVES + F.wave, NGW = F.G * NWAVES;
    unsigned char* ws = F.ws;
    constexpr int I_WIN = 16 * 112, I_POOL = 4 * 16, I_CVO = 8 * 32, I_WOUT = 16 * 32, I_RT = 16 * 8, I_SG = 64, I_SU = 64, I_SD = 64, I_EG = NE * 64, I_EU = NE * 64, I_ED = NE * 64;
    constexpr int NITEMS = I_WIN + I_POOL + I_CVO + I_WOUT + I_RT + I_SG + I_SU + I_SD + I_EG + I_EU + I_ED;
    for (int it = gw; it < NITEMS; it += NGW) {
        int r = it;
        if (r < I_EG) { const int e = r >> 6, rr = r & 63, kb = rr >> 3, nb = rr & 7;
            p0_item_fp8(F.in[13] + (size_t)e * D * EH, EH, ws + WS_EGU + (size_t)e * 512 * D, D, 128 * kb, 32 * nb, gu_row(32 * nb, 0), scr, lane); continue; } r -= I_EG;
        if (r < I_EU) { const int e = r >> 6, rr = r & 63, kb = rr >> 3, nb = rr & 7;
            p0_item_fp8(F.in[14] + (size_t)e * D * EH, EH, ws + WS_EGU + (size_t)e * 512 * D, D, 128 * kb, 32 * nb, gu_row(32 * nb, 1), scr, lane); continue; } r -= I_EU;
        if (r < I_ED) { const int e = r >> 6, rr = r & 63, kb = rr >> 5, nb = rr & 31;
            p0_item_fp8(F.in[15] + (size_t)e * EH * D, D, ws + WS_EDN + (size_t)e * D * EH, EH, 128 * kb, 32 * nb, 32 * nb, scr, lane); continue; } r -= I_ED;
        if (r < I_WIN) { const int kb = r / 112, nb = r % 112; p0_item(F.in[1], INC, (bf16*)(ws + WS_WIN), D, 64 * kb, 32 * nb, win_row(32 * nb), scr, lane); continue; } r -= I_WIN;
        if (r < I_POOL) { const int g = r >> 4, rr = r & 15, kb = rr >> 3, nb = rr & 7;
            p0_item(F.in[2] + (size_t)g * 128 * 256, 256, (bf16*)(ws + WS_POOL) + (size_t)g * 256 * 128, 128, 64 * kb, 32 * nb, 32 * nb, scr, lane); continue; } r -= I_POOL;
        if (r < I_CVO) { const int kb = r >> 5, nb = r & 31; p0_item(F.in[7], D, (bf16*)(ws + WS_CVO), CW, 64 * kb, 32 * nb, 32 * nb, scr, lane); continue; } r -= I_CVO;
        if (r < I_WOUT) { const int kb = r >> 5, nb = r & 31; p0_item(F.in[8], D, (bf16*)(ws + WS_WOUT), D, 64 * kb, 32 * nb, 32 * nb, scr, lane); continue; } r -= I_WOUT;
        if (r < I_RT) { const int kb = r >> 3, nb = r & 7; p0_item(F.in[11], NE, (bf16*)(ws + WS_RSH), D, 64 * kb, 32 * nb, 32 * nb, scr, lane); continue; } r -= I_RT;
        if (r < I_SG) { const int kb = r >> 3, nb = r & 7; p0_item_fp8(F.in[16], EH, ws + WS_EGU + (size_t)NE * 512 * D, D, 128 * kb, 32 * nb, gu_row(32 * nb, 0), scr, lane); continue; } r -= I_SG;
        if (r < I_SU) { const int kb = r >> 3, nb = r & 7; p0_item_fp8(F.in[17], EH, ws + WS_EGU + (size_t)NE * 512 * D, D, 128 * kb, 32 * nb, gu_row(32 * nb, 1), scr, lane); continue; } r -= I_SU;
        { const int kb = r >> 5, nb = r & 31; p0_item_fp8(F.in[18], D, ws + WS_EDN + (size_t)NE * D * EH, EH, 128 * kb, 32 * nb, 32 * nb, scr, lane); }
    }
    const GAS f32x4* x4 = (const GAS f32x4*)F.in[0]; GAS v4u* xb = (GAS v4u*)(ws + WS_XB);
    for (int i = (int)blockIdx.x * NTHR + tid; i < M * D / 8; i += F.G * NTHR) { const f32x4 a = x4[2 * i], b = x4[2 * i + 1];
        v4u o; o.x = pk2(a.x, a.y); o.y = pk2(a.z, a.w); o.z = pk2(b.x, b.y); o.w = pk2(b.z, b.w); xb[i] = o; }
}

__device__ __forceinline__ void ld8(const LAS unsigned char* p, float (&v)[8]) { const v4u w = *(const LAS v4u*)p;
    v[0] = pg8::bf_lo(w.x); v[1] = pg8::bf_hi(w.x); v[2] = pg8::bf_lo(w.y); v[3] = pg8::bf_hi(w.y); v[4] = pg8::bf_lo(w.z); v[5] = pg8::bf_hi(w.z); v[6] = pg8::bf_lo(w.w); v[7] = pg8::bf_hi(w.w); }
__device__ __forceinline__ void p2_mixer(Frame& F) {
    constexpr int TT = 32, VR = TT + CK - 1  , UR = TT + 15  , DW_BYTES = CK * CW * 4  ;
    LAS unsigned char* ldw = F.lds; LAS unsigned char* lrow = F.lds + DW_BYTES;
    const bf16* U = (const bf16*)(F.ws + WS_U); const bf16* V = (const bf16*)(F.ws + WS_V); bf16* Rb = (bf16*)(F.ws + WS_R); bf16* Cb = (bf16*)(F.ws + WS_C);
    const int lane = lane_id(), w = F.wave, tid = w * 64 + lane;
    for (int i = tid; i < CK * CW / 4; i += NTHR) *(LAS f32x4*)(ldw + 16 * i) = *(const GAS f32x4*)(F.in[4] + 4 * i);
    for (int i = tid; i < 128; i += NTHR) *(LAS v4u*)(lrow + 62 * 1024 + 16 * i) = (v4u){0u, 0u, 0u, 0u};
    float lg[8], lb[8];
#pragma unroll
    for (int k = 0; k < 8; ++k) { lg[k] = F.in[5][lane * 8 + k]; lb[k] = F.in[6][lane * 8 + k]; }
    const int W = 2 << (lane >> 4);
    for (int unit = F.vcu; unit < M / TT; unit += F.G) {
        const int t0 = unit * TT, s0 = t0 % SEQ;
        __syncthreads();
        for (int c = tid; c < VR * 64; c += NTHR) { const int row = c >> 6, q = c & 63; const int s = s0 - (CK - 1) + row;
            v4u val = (v4u){0u, 0u, 0u, 0u}; if (s >= 0) val = *(const GAS v4u*)(V + (size_t)(t0 - (CK - 1) + row) * CW + q * 8);
            *(LAS v4u*)(lrow + row * 1024 + q * 16) = val; }
        __syncthreads();
        {
            float acc[4][8], wr_[4][8];
#pragma unroll
            for (int q = 0; q < 4; ++q)
#pragma unroll
                for (int k = 0; k < 8; ++k) { acc[q][k] = 0.f; wr_[q][k] = 0.f; }
#pragma unroll 1
            for (int i4 = 0; i4 < 9; ++i4) {
#pragma unroll
                for (int ii = 0; ii < 4; ++ii) { const int i = 4 * i4 + ii;
                    f32x4 a = (f32x4){0.f, 0.f, 0.f, 0.f}, b = a;
                    if (i <= 30) { a = *(const LAS f32x4*)(ldw + i * 2048 + lane * 32); b = *(const LAS f32x4*)(ldw + i * 2048 + lane * 32 + 16); }
                    wr_[ii][0] = a.x; wr_[ii][1] = a.y; wr_[ii][2] = a.z; wr_[ii][3] = a.w; wr_[ii][4] = b.x; wr_[ii][5] = b.y; wr_[ii][6] = b.z; wr_[ii][7] = b.w;
                    float v[8]; ld8(lrow + (4 * w + i) * 1024 + lane * 16, v);
#pragma unroll
                    for (int q = 0; q < 4; ++q) {
#pragma unroll
                        for (int k = 0; k < 8; ++k) acc[q][k] = fmaf(v[k], wr_[(ii - q) & 3][k], acc[q][k]); }
                }
            }
#pragma unroll
            for (int q = 0; q < 4; ++q) {
                float s = 0.f;
#pragma unroll
                for (int k = 0; k < 8; ++k) s += acc[q][k];
                const float mean = wave_sum(s) * (1.f / CW); float s2 = 0.f;
#pragma unroll
                for (int k = 0; k < 8; ++k) { acc[q][k] -= mean; s2 += acc[q][k] * acc[q][k]; }
                const float rstd = 1.f / sqrtf(wave_sum(s2) * (1.f / CW) + LN_EPS);
                float y[8];
#pragma unroll
                for (int k = 0; k < 8; ++k) { const float z = acc[q][k] * rstd * lg[k] + lb[k]; y[k] = z * pg8::sigmoidf_(z); }
                v4u o; o.x = pk2(y[0], y[1]); o.y = pk2(y[2], y[3]); o.z = pk2(y[4], y[5]); o.w = pk2(y[6], y[7]);
                *(GAS v4u*)(Cb + (size_t)(t0 + 4 * w + q) * CW + lane * 8) = o;
            }
        }
        __syncthreads();
        for (int c = tid; c < UR * 64; c += NTHR) { const int row = c >> 6, q = c & 63; const int s = s0 - 15 + row;
            v4u val = (v4u){0u, 0u, 0u, 0u}; if (s >= 0) val = *(const GAS v4u*)(U + (size_t)(t0 - 15 + row) * PW + q * 8);
            *(LAS v4u*)(lrow + row * 1024 + q * 16) = val; }
        __syncthreads();
        {
            float acc[4][8], own[4][8];
#pragma unroll
            for (int q = 0; q < 4; ++q)
#pragma unroll
                for (int k = 0; k < 8; ++k) { acc[q][k] = 0.f; own[q][k] = 0.f; }
#pragma unroll
            for (int i = 0; i < 19; ++i) {
                float v[8]; ld8(lrow + (4 * w + i) * 1024 + lane * 16, v);
#pragma unroll
                for (int q = 0; q < 4; ++q) { const int d = q + 15 - i; if (d >= 0 && d <= 15) { const bool in = d < W;
#pragma unroll
                    for (int k = 0; k < 8; ++k) { acc[q][k] += in ? v[k] : 0.f; if (d == 0) own[q][k] = v[k]; } } }
            }
#pragma unroll
            for (int q = 0; q < 4; ++q) { const int s = s0 + 4 * w + q; const int cnt = (s + 1) < W ? (s + 1) : W; const float inv = 1.f / (float)cnt;
                float y[8];
#pragma unroll
                for (int k = 0; k < 8; ++k) y[k] = acc[q][k] * inv - own[q][k];
                v4u o; o.x = pk2(y[0], y[1]); o.y = pk2(y[2], y[3]); o.z = pk2(y[4], y[5]); o.w = pk2(y[6], y[7]);
                *(GAS v4u*)(Rb + (size_t)(t0 + 4 * w + q) * PW + lane * 8) = o; }
        }
    }
    __syncthreads();
}

__device__ __forceinline__ void p6_ln1(Frame& F) {
    const int lane = lane_id();
    const int gw = F.vcu * NWAVES + F.wave, NGW = F.G * NWAVES;
    const float* Z = (const float*)(F.ws + WS_Z); bf16* X1 = (bf16*)(F.ws + WS_X1); unsigned char* X18 = F.ws + WS_X18;
    f32x4 g[4], b[4];
#pragma unroll
    for (int j = 0; j < 4; ++j) { g[j] = *(const GAS f32x4*)(F.in[9] + 4 * lane + 256 * j); b[j] = *(const GAS f32x4*)(F.in[10] + 4 * lane + 256 * j); }
    for (int m = gw; m < M; m += NGW) {
        const GAS f32x4* zr = (const GAS f32x4*)(Z + (size_t)m * D) + lane;
        f32x4 v[4]; float s = 0.f;
#pragma unroll
        for (int j = 0; j < 4; ++j) { v[j] = zr[64 * j]; s += (v[j].x + v[j].y) + (v[j].z + v[j].w); }
        const float mean = wave_sum(s) * (1.f / D); float s2 = 0.f;
#pragma unroll
        for (int j = 0; j < 4; ++j) { v[j] = v[j] - mean; s2 += (v[j].x * v[j].x + v[j].y * v[j].y) + (v[j].z * v[j].z + v[j].w * v[j].w); }
        const float rstd = 1.f / sqrtf(wave_sum(s2) * (1.f / D) + LN_EPS);
        GAS v2u* o8 = (GAS v2u*)(X1 + (size_t)m * D) + lane;
#pragma unroll
        for (int j = 0; j < 4; ++j) { const f32x4 y = v[j] * rstd * g[j] + b[j]; v2u o; o.x = pk2(y.x, y.y); o.y = pk2(y.z, y.w); o8[64 * j] = o;
            const v2u q = pack8_fp8(y * XSCALE, y * XSCALE); *(GAS unsigned*)(X18 + (size_t)m * D + 4 * lane + 256 * j) = q.x; }
    }
}

#define DPP_U(v, ctrl, rmask) ((unsigned)__builtin_amdgcn_update_dpp((int)(v), (int)(v), (ctrl), (rmask), 0xf, false))
#define DPP_F(v, ctrl) __builtin_bit_cast(float, __builtin_amdgcn_update_dpp(__builtin_bit_cast(int, (v)), __builtin_bit_cast(int, (v)), (ctrl), 0xf, 0xf, false))
__device__ __forceinline__ unsigned wave_max_u32(unsigned v) {
    v = max(v, DPP_U(v, 0xB1, 0xf)); v = max(v, DPP_U(v, 0x4E, 0xf)); v = max(v, DPP_U(v, 0x141, 0xf)); v = max(v, DPP_U(v, 0x140, 0xf));
    v = max(v, DPP_U(v, 0x142, 0xa)); v = max(v, DPP_U(v, 0x143, 0xc));
    return (unsigned)__builtin_amdgcn_readlane((int)v, 63);
}
__device__ __forceinline__ void route_token(const f32x4 lg, const f32x4 bias, int lane, int& myidx, float& wgt) {
    const float sc0 = 1.f / (1.f + __expf(-lg.x)), sc1 = 1.f / (1.f + __expf(-lg.y)), sc2 = 1.f / (1.f + __expf(-lg.z)), sc3 = 1.f / (1.f + __expf(-lg.w));
    const float c0 = sc0 + bias.x, c1 = sc1 + bias.y, c2 = sc2 + bias.z, c3 = sc3 + bias.w;
    const float h01 = fmaxf(c0, c1), l01 = fminf(c0, c1), h23 = fmaxf(c2, c3), l23 = fminf(c2, c3);
    float m1 = fmaxf(h01, h23), m2 = fmaxf(fminf(h01, h23), fmaxf(l01, l23));
    { float b1 = DPP_F(m1, 0xB1), b2 = DPP_F(m2, 0xB1); float n1 = fmaxf(m1, b1), n2 = fmaxf(fminf(m1, b1), fmaxf(m2, b2)); m1 = n1; m2 = n2;
      b1 = DPP_F(m1, 0x4E); b2 = DPP_F(m2, 0x4E); n1 = fmaxf(m1, b1); n2 = fmaxf(fminf(m1, b1), fmaxf(m2, b2)); m1 = n1; m2 = n2;
      b1 = DPP_F(m1, 0x141); b2 = DPP_F(m2, 0x141); n1 = fmaxf(m1, b1); n2 = fmaxf(fminf(m1, b1), fmaxf(m2, b2)); m1 = n1; m2 = n2; }
    const float gs = m1 + m2; const int mygrp = lane >> 3; int rank = 0;
#pragma unroll
    for (int g = 0; g < NG; ++g) { const float og = __builtin_bit_cast(float, __builtin_amdgcn_readlane(__builtin_bit_cast(int, gs), g * 8)); rank += (og > gs || (og == gs && g < mygrp)) ? 1 : 0; }
    const unsigned e0 = 255u - 4u * (unsigned)lane;
    unsigned k0 = (__float_as_uint(c0 + 1.f) & ~255u) | e0, k1 = (__float_as_uint(c1 + 1.f) & ~255u) | (e0 - 1u), k2 = (__float_as_uint(c2 + 1.f) & ~255u) | (e0 - 2u), k3 = (__float_as_uint(c3 + 1.f) & ~255u) | (e0 - 3u);
    if (rank >= 4) { k0 = 0u; k1 = 0u; k2 = 0u; k3 = 0u; }
    float sumw = 0.f, mysc = 0.f; myidx = 0;
#pragma unroll
    for (int r = 0; r < TOPK; ++r) {
        const unsigned win = wave_max_u32(max(max(k0, k1), max(k2, k3)));
        const int gi = 255 - (int)(win & 255u), owner = gi >> 2, kk = gi & 3;
        const float s0 = __builtin_bit_cast(float, __builtin_amdgcn_readlane(__builtin_bit_cast(int, sc0), owner)), s1 = __builtin_bit_cast(float, __builtin_amdgcn_readlane(__builtin_bit_cast(int, sc1), owner));
        const float s2 = __builtin_bit_cast(float, __builtin_amdgcn_readlane(__builtin_bit_cast(int, sc2), owner)), s3 = __builtin_bit_cast(float, __builtin_amdgcn_readlane(__builtin_bit_cast(int, sc3), owner));
        const float bs = kk == 0 ? s0 : (kk == 1 ? s1 : (kk == 2 ? s2 : s3));
        if (lane == r) { myidx = gi; mysc = bs; }
        sumw += bs;
        if (k0 == win) k0 = 0u; if (k1 == win) k1 = 0u; if (k2 == win) k2 = 0u; if (k3 == win) k3 = 0u;
    }
    wgt = mysc / sumw * RSCALE;
}
__device__ __forceinline__ void p8_route(Frame& F, int dummy = 0) {
    const int lane = lane_id(), tid = F.wave * 64 + lane;
    const int gw = F.vcu * NWAVES + F.wave, NGW = F.G * NWAVES;
    const float* LOG = (const float*)(F.ws + WS_LOG); int* list = (int*)(F.ws + (dummy ? WS_HE + 96 * MiB : WS_LIST)); unsigned* cnt = (unsigned*)F.ctl + (dummy ? CW_CNT + 32768 : CW_CNT);
    LAS unsigned* lcnt = (LAS unsigned*)(F.lds + TAB_OFF); LAS unsigned* lbase = lcnt + NE;
    const f32x4 bias = *(const GAS f32x4*)(F.in[12] + 4 * lane);
    constexpr int NB = 4, NTW = 16;
    if (tid < NE) lcnt[tid] = 0u;
    __syncthreads();
    int idx[NTW]; float wg[NTW]; unsigned rk[NTW];
#pragma unroll
    for (int g = 0; g < NTW / NB; ++g) {
        f32x4 lg[NB];
#pragma unroll
        for (int b = 0; b < NB; ++b) { const int tok = gw * NTW + g * NB + b; const size_t o = (size_t)(tok < M ? tok : 0) * NE + 4 * lane; lg[b] = *(const GAS f32x4*)(LOG + o) + *(const GAS f32x4*)(LOG + (size_t)M * NE + o); }
#pragma unroll
        for (int b = 0; b < NB; ++b) { route_token(lg[b], bias, lane, idx[g * NB + b], wg[g * NB + b]);
            rk[g * NB + b] = 0u; if (lane < TOPK && gw * NTW + g * NB + b < M) rk[g * NB + b] = __hip_atomic_fetch_add(&lcnt[idx[g * NB + b]], 1u, __ATOMIC_RELAXED, __HIP_MEMORY_SCOPE_WORKGROUP); }
    }
    __syncthreads();
    if (tid < NE) { const unsigned c = lcnt[tid]; unsigned base = 0u; if (c) base = atomicAdd(&cnt[tid * 64], c); lbase[tid] = base; }
    __syncthreads();
    if (lane < NTW && gw * NTW + lane < M) { const int tok = gw * NTW + lane; v2u ent; ent.x = (unsigned)(M * TOPK + tok); ent.y = __float_as_uint(1.0f);
        *(GAS v2u*)(list + ((size_t)NE * ECAP + tok) * 2) = ent; }
    if (lane < TOPK) {
#pragma unroll
        for (int b = 0; b < NTW; ++b) { const int tok = gw * NTW + b;
            if (tok < M) { v2u ent; ent.x = (unsigned)(tok * TOPK + lane); ent.y = __float_as_uint(wg[b]); *(GAS v2u*)(list + ((size_t)idx[b] * ECAP + lbase[idx[b]] + rk[b]) * 2) = ent; } }
    }
    __syncthreads();
}

__device__ __forceinline__ int expert_table(Frame& F) {
    LAS int* tstart = (LAS int*)(F.lds + TAB_OFF); LAS int* cntl = tstart + 260; LAS int* wtot = tstart + 520;
    const unsigned* cnt = (const unsigned*)F.ctl + CW_CNT;
    const int lane = lane_id(), tid = F.wave * 64 + lane;
    __syncthreads();
    int c = 0, incl = 0;
    if (tid < NE) { c = (int)__hip_atomic_load(cnt + tid * 64, RLX_AGENT); incl = (c + 255) >> 8;
#pragma unroll
        for (int o = 1; o < 64; o <<= 1) { const int up = __shfl_up(incl, o); if (lane >= o) incl += up; }
        if (lane == 63) wtot[F.wave] = incl; cntl[tid] = c; }
    __syncthreads();
    if (tid < NE) { int base = 0;
#pragma unroll
        for (int k = 0; k < 4; ++k) if (k < F.wave) base += wtot[k];
        tstart[tid + 1] = base + incl; if (tid == 0) tstart[0] = 0;
        if (tid == NE - 1) { tstart[NEX] = base + incl + M / 256; cntl[NE] = M; } }
    __syncthreads();
    return tstart[NEX];
}

__device__ __forceinline__ void p11_combine(Frame& F) {
    const int lane = lane_id();
    const int gw = F.vcu * NWAVES + F.wave, NGW = F.G * NWAVES;
    const unsigned char* Y = F.ws + WS_Y; const bf16* X1 = (const bf16*)(F.ws + WS_X1);
    for (int tok = gw; tok < M; tok += NGW) {
        f32x4 a[4];
#pragma unroll
        for (int j = 0; j < 2; ++j) { f32x4 x0, x1; unpack8(*(const GAS v4u*)(X1 + (size_t)tok * D + lane * 16 + 8 * j), x0, x1); a[2 * j] = x0 * ALPHA; a[2 * j + 1] = x1 * ALPHA; }
#if !(defined(DBG_COMBINE) && (DBG_COMBINE & 1))
        f32x4 r[4] = {(f32x4){0.f, 0.f, 0.f, 0.f}, (f32x4){0.f, 0.f, 0.f, 0.f}, (f32x4){0.f, 0.f, 0.f, 0.f}, (f32x4){0.f, 0.f, 0.f, 0.f}};
#pragma unroll
        for (int k = 0; k <= TOPK; ++k) { const v4u q = *(const GAS v4u*)(Y + (k < TOPK ? (size_t)tok * TOPK + k : (size_t)M * TOPK + tok) * D + lane * 16);
            r[0] += unpack4_fp8(q.x); r[1] += unpack4_fp8(q.y); r[2] += unpack4_fp8(q.z); r[3] += unpack4_fp8(q.w); }
#pragma unroll
        for (int j = 0; j < 4; ++j) a[j] += r[j] * (1.f / YSCALE);
#endif
        float s = 0.f;
#pragma unroll
        for (int j = 0; j < 4; ++j) s += (a[j].x + a[j].y) + (a[j].z + a[j].w);
        const float mean = wave_sum(s) * (1.f / D); float s2 = 0.f;
#pragma unroll
        for (int j = 0; j < 4; ++j) { a[j] = a[j] - mean; s2 += (a[j].x * a[j].x + a[j].y * a[j].y) + (a[j].z * a[j].z + a[j].w * a[j].w); }
        const float rstd = 1.f / sqrtf(wave_sum(s2) * (1.f / D) + LN_EPS);
#pragma unroll
        for (int j = 0; j < 4; ++j) { const int col = lane * 16 + 4 * j;
            const f32x4 g = *(const GAS f32x4*)(F.in[19] + col), b = *(const GAS f32x4*)(F.in[20] + col);
            *(GAS f32x4*)(F.out + (size_t)tok * D + col) = a[j] * rstd * g + b; }
    }
}
#ifdef DBG_CHECK
constexpr int NT = 512;
constexpr size_t DBG_OFF = 448 * MiB;
__device__ __forceinline__ float dsig(float x) { return 1.f / (1.f + expf(-x)); }
__device__ __forceinline__ float bf2f(unsigned short h) { return __uint_as_float((unsigned)h << 16); }
__global__ void dbg_proj(const float* x, const float* w_in, float* PN) {
    for (int i = blockIdx.x * blockDim.x + threadIdx.x; i < NT * INC; i += gridDim.x * blockDim.x) { const int tok = i / INC, col = i % INC; float a = 0.f;
        for (int k = 0; k < D; ++k) a = fmaf(x[(size_t)tok * D + k], w_in[(size_t)k * INC + col], a); PN[i] = a; }
}
__global__ void dbg_mix1(const float* PN, const float* dw, float* RN, float* CVN) {
    for (int i = blockIdx.x * blockDim.x + threadIdx.x; i < NT * 512; i += gridDim.x * blockDim.x) { const int tok = i / 512, ch = i % 512; const int g = ch / 128, W = 2 << g;
        float s = 0.f; int cnt = 0; for (int j = 0; j < W; ++j) if (tok - j >= 0) { s += PN[(size_t)(tok - j) * INC + ch]; ++cnt; }
        RN[i] = s / (float)cnt - PN[(size_t)tok * INC + ch];
        float c = 0.f; for (int j = 0; j < CK; ++j) { const int t = tok - (CK - 1) + j; if (t >= 0) c += PN[(size_t)t * INC + 512 + ch] * dsig(PN[(size_t)t * INC + 1024 + ch]) * dw[j * 512 + ch]; }
        CVN[i] = c; }
}
__global__ void dbg_ln(const float* IN, int n, const float* g, const float* b, float* OUT, int act) {
    const int tok = blockIdx.x * blockDim.x + threadIdx.x; if (tok >= NT) return;
    float m = 0.f; for (int k = 0; k < n; ++k) m += IN[(size_t)tok * n + k]; m /= n; float v = 0.f; for (int k = 0; k < n; ++k) { const float d = IN[(size_t)tok * n + k] - m; v += d * d; } v /= n;
    const float r = 1.f / sqrtf(v + LN_EPS); for (int k = 0; k < n; ++k) { float y = (IN[(size_t)tok * n + k] - m) * r * g[k] + b[k]; if (act) y = y * dsig(y); OUT[(size_t)tok * n + k] = y; }
}
__global__ void dbg_mix3(const float* PN, const float* RN, const float* CN, const float* pool_w, const float* scale, const float* cwo, float* MGN) {
    for (int i = blockIdx.x * blockDim.x + threadIdx.x; i < NT * D; i += gridDim.x * blockDim.x) { const int tok = i / D, d = i % D, g = d / 256, dd = d % 256;
        float yp = 0.f; for (int c = 0; c < 128; ++c) yp = fmaf(RN[(size_t)tok * 512 + g * 128 + c], pool_w[((size_t)g * 128 + c) * 256 + dd], yp); yp *= scale[d];
        float yc = 0.f; for (int c = 0; c < 512; ++c) yc = fmaf(CN[(size_t)tok * 512 + c], cwo[(size_t)c * D + d], yc);
        MGN[i] = dsig(PN[(size_t)tok * INC + 1536 + d]) * yp + dsig(PN[(size_t)tok * INC + 2560 + d]) * yc; }
}
__global__ void dbg_mix4(const float* MGN, const float* w_out, const float* x, float* ZN) {
    for (int i = blockIdx.x * blockDim.x + threadIdx.x; i < NT * D; i += gridDim.x * blockDim.x) { const int tok = i / D, e = i % D; float a = 0.f;
        for (int d = 0; d < D; ++d) a = fmaf(MGN[(size_t)tok * D + d], w_out[(size_t)d * D + e], a); ZN[i] = ALPHA * x[(size_t)tok * D + e] + a; }
}
__global__ void dbg_cmp(int k, const void* buf, int kind, int ld, int n, const float* NV, int nld, int ncol0, int fn, const float* PN, float* acc) {
    float e2 = 0.f, r2 = 0.f;
    for (int i = blockIdx.x * blockDim.x + threadIdx.x; i < NT * n; i += gridDim.x * blockDim.x) { const int tok = i / n, c = i % n;
        const float a = kind ? ((const float*)buf)[(size_t)tok * ld + c] : bf2f(((const unsigned short*)buf)[(size_t)tok * ld + c]);
        float b = NV[(size_t)tok * nld + ncol0 + c];
        if (fn == 1) b = dsig(b);
        if (fn == 2) b = b * dsig(PN[(size_t)tok * INC + 1024 + c]);
        e2 += (a - b) * (a - b); r2 += b * b; }
    atomicAdd(acc + 2 * k, e2); atomicAdd(acc + 2 * k + 1, r2);
}
__global__ void dbg_cmp_tile(int k, const void* buf, int ld, int r0, int c0, const float* NV, int nld, int ncol0, float* acc) {
    float e2 = 0.f, r2 = 0.f;
    for (int i = blockIdx.x * blockDim.x + threadIdx.x; i < 256 * 256; i += gridDim.x * blockDim.x) { const int tok = r0 + i / 256, c = c0 + i % 256;
        const float a = bf2f(((const unsigned short*)buf)[(size_t)tok * ld + c]); const float b = dsig(NV[(size_t)tok * nld + ncol0 + c]);
        e2 += (a - b) * (a - b); r2 += b * b; }
    atomicAdd(acc + 2 * k, e2); atomicAdd(acc + 2 * k + 1, r2);
}
__global__ void dbg_cmp_wt(int k, const unsigned short* WT, const float* W, int n0, float* acc) {
    float e2 = 0.f, r2 = 0.f;
    for (int i = blockIdx.x * blockDim.x + threadIdx.x; i < 256 * 1024; i += gridDim.x * blockDim.x) { const int n = n0 + i / 1024, kk = i % 1024;
        const float a = bf2f(WT[(size_t)n * 1024 + kk]); const float b = W[(size_t)kk * INC + n];
        e2 += (a - b) * (a - b); r2 += b * b; }
    atomicAdd(acc + 2 * k, e2); atomicAdd(acc + 2 * k + 1, r2);
}
__global__ void dbg_code(const float* acc, int nchk, float* out, int n) {
    int code = 0; for (int k = nchk - 1; k >= 0; --k) if (!(acc[2 * k] <= 1e-3f * acc[2 * k + 1])) code = k + 1;
#ifdef DBG_TILES
    code = 0; for (int k = 0; k < 4; ++k) if (!(acc[2 * (16 + k)] <= 1e-3f * acc[2 * (16 + k) + 1])) code |= 1 << k;
#endif
#ifdef DBG_SHOW
    const float val = sqrtf(1000.f * acc[2 * DBG_SHOW] / acc[2 * DBG_SHOW + 1]);
    for (int i = blockIdx.x * blockDim.x + threadIdx.x; i < n; i += gridDim.x * blockDim.x) out[i] = val;
#else
    for (int i = blockIdx.x * blockDim.x + threadIdx.x; i < n; i += gridDim.x * blockDim.x) out[i] = (float)code;
#endif
}
static void dbg_run(void* const* d_in, float* d_out, unsigned char* ws, hipStream_t st, int stop) {
    float* PN = d_out; float* RN = PN + (size_t)NT * INC; float* CVN = RN + NT * 512; float* CN = CVN + NT * 512; float* MGN = CN + NT * 512; float* ZN = MGN + (size_t)NT * D; float* X1N = ZN + (size_t)NT * D; float* acc = X1N + (size_t)NT * D;
    const float* x = (const float*)d_in[0];
    hipMemsetAsync(acc, 0, 64 * 4, st);
    dbg_proj<<<2048, 256, 0, st>>>(x, (const float*)d_in[1], PN);
    dbg_mix1<<<1024, 256, 0, st>>>(PN, (const float*)d_in[4], RN, CVN);
    dbg_ln<<<NT / 64, 64, 0, st>>>(CVN, 512, (const float*)d_in[5], (const float*)d_in[6], CN, 1);
    dbg_mix3<<<2048, 256, 0, st>>>(PN, RN, CN, (const float*)d_in[2], (const float*)d_in[3], (const float*)d_in[7], MGN);
    dbg_mix4<<<2048, 256, 0, st>>>(MGN, (const float*)d_in[8], x, ZN);
    dbg_ln<<<NT / 64, 64, 0, st>>>(ZN, D, (const float*)d_in[9], (const float*)d_in[10], X1N, 0);
    if (stop <= 4) {
    dbg_cmp<<<256, 256, 0, st>>>(0, ws + WS_U, 0, 512, 512, PN, INC, 0, 0, PN, acc);
    dbg_cmp<<<256, 256, 0, st>>>(1, ws + WS_V, 0, 512, 512, PN, INC, 512, 2, PN, acc);
    dbg_cmp<<<256, 256, 0, st>>>(2, ws + WS_GP, 0, D, D, PN, INC, 1536, 1, PN, acc);
    dbg_cmp<<<256, 256, 0, st>>>(3, ws + WS_GC, 0, D, D, PN, INC, 2560, 1, PN, acc);
    }
    dbg_cmp<<<256, 256, 0, st>>>(4, ws + WS_R, 0, 512, 512, RN, 512, 0, 0, PN, acc);
    dbg_cmp<<<256, 256, 0, st>>>(5, ws + WS_C, 0, 512, 512, CN, 512, 0, 0, PN, acc);
    if (stop >= 7) {
    dbg_cmp<<<256, 256, 0, st>>>(6, ws + WS_MG, 0, D, D, MGN, D, 0, 0, PN, acc);
    dbg_cmp<<<256, 256, 0, st>>>(7, ws + WS_Z, 1, D, D, ZN, D, 0, 0, PN, acc);
    dbg_cmp<<<256, 256, 0, st>>>(8, ws + WS_X1, 0, D, D, X1N, D, 0, 0, PN, acc);
    }
#ifdef DBG_WT
    dbg_cmp_wt<<<256, 256, 0, st>>>(DBG_SHOW, (const unsigned short*)(ws + WS_WIN), (const float*)d_in[1], DBG_WT, acc);
#endif
#ifdef DBG_TILES
    for (int t = 0; t < 4; ++t) dbg_cmp_tile<<<64, 256, 0, st>>>(16 + t, ws + ((DBG_TILES & 2) ? WS_GC : WS_GP), D, (DBG_TILES & 1) * 256, t * 256, PN, INC, ((DBG_TILES & 2) ? 2560 : 1536), acc);
#endif
    hipMemcpyAsync(ws + WS_CTL + 65536, acc, 64 * 4, hipMemcpyDeviceToDevice, st);
    dbg_code<<<1024, 256, 0, st>>>((const float*)(ws + WS_CTL + 65536), 9, d_out, M * D);
}
#endif

#ifndef MK_N_LAUNCHES
#define MK_N_LAUNCHES 1
#endif
constexpr int N_PHASES = 12;
struct Args { const float* in[21]; float* out; unsigned char* ws; int ph_lo, ph_hi; };
__global__ void __launch_bounds__(NTHR, 2) mk_fwd(Args args) {
    extern __shared__ __attribute__((aligned(16))) unsigned char lds[];
    Frame F;
    F.lds = (LAS unsigned char*)lds;
    F.MISC = (volatile LAS unsigned*)(F.lds + MISC_OFF);
    F.wave = __builtin_amdgcn_readfirstlane((int)threadIdx.x >> 6);
    F.G = gridDim.x; { const int bx = blockIdx.x; F.vcu = (F.G % 8 == 0) ? (bx % 8) * (F.G / 8) + bx / 8 : bx; }
    F.ws = args.ws; F.ctl = (gu32*)(args.ws + WS_CTL); F.out = args.out;
#pragma unroll
    for (int i = 0; i < 21; ++i) F.in[i] = args.in[i];
    for (int u = threadIdx.x; u < (LDS_BYTES - TAB_OFF) / 4; u += NTHR) ((LAS unsigned*)(F.lds + TAB_OFF))[u] = 0u;
    __syncthreads();
    const int lo = args.ph_lo, hi = args.ph_hi;
    const bool multi = (hi - lo) > 1;
    XcdBarrier bar; bar.bar = (unsigned*)(F.ctl + CW_BAR); bar.x = 0; bar.st = nullptr;
    if (multi) bar = xcd_barrier_post((unsigned*)(F.ctl + CW_BAR), F.MISC + 8);
#ifndef PH_MASK
#define PH_MASK 0xFFF
#endif
#define IN(k) ((((PH_MASK) >> (k)) & 1) && lo <= (k) && (k) < hi)
#define SEAM(k) do { if (IN(k) && IN((k) + 1)) xcd_barrier(bar, F.wave); } while (0)
    unsigned char* ws = args.ws;
    LAS unsigned char* ring = F.lds + RING_OFF; LAS unsigned char* entl = F.lds + ENT_OFF;
    const int bx = (int)blockIdx.x;

#ifndef DUP_MASK
#define DUP_MASK 0
#endif
#define DUP(k) ((((DUP_MASK) >> (k)) & 1) != 0)
#define PHASE(k, BODY) do { if (IN(k)) { BODY; if (DUP(k)) { xcd_barrier(bar, F.wave); BODY; } } SEAM(k); } while (0)
    PHASE(0, p0_prologue(F));
#define P1_BODY { DenseOrder S; S.init((const bf16*)(ws + WS_XB), (const bf16*)(ws + WS_WIN), M, INC, D, D, D, 0, F.G, bx); \
        EpiProj E{(bf16*)(ws + WS_U), (bf16*)(ws + WS_V), (bf16*)(ws + WS_GP), (bf16*)(ws + WS_GC)}; \
        pg8::gemm_phase<EpiProj, DenseOrder>(ring, entl, S, E, F.wave); }
    PHASE(1, P1_BODY);
    PHASE(2, p2_mixer(F));
#define P3_BODY { DenseOrder S; S.init((const bf16*)(ws + WS_R), (const bf16*)(ws + WS_POOL), M, D, 128, PW, 128, 128, F.G, bx); \
        EpiPool E{F.in[3], (const bf16*)(ws + WS_GP), (bf16*)(ws + WS_T1)}; \
        pg8::gemm_phase<EpiPool, DenseOrder>(ring, entl, S, E, F.wave); }
    PHASE(3, P3_BODY);
#define P4_BODY { DenseOrder S; S.init((const bf16*)(ws + WS_C), (const bf16*)(ws + WS_CVO), M, D, CW, CW, CW, 0, F.G, bx); \
        EpiConvOut E{(const bf16*)(ws + WS_T1), (const bf16*)(ws + WS_GC), (bf16*)(ws + WS_MG)}; \
        pg8::gemm_phase<EpiConvOut, DenseOrder>(ring, entl, S, E, F.wave); }
    PHASE(4, P4_BODY);
#define P5_BODY { DenseOrder S; S.init((const bf16*)(ws + WS_MG), (const bf16*)(ws + WS_WOUT), M, D, D, D, D, 0, F.G, bx); \
        EpiWout E{F.in[0], (float*)(ws + WS_Z)}; \
        pg8::gemm_phase<EpiWout, DenseOrder>(ring, entl, S, E, F.wave); }
    PHASE(5, P5_BODY);
    PHASE(6, p6_ln1(F));
#define P7_BODY { DenseOrder S; S.init((const bf16*)(ws + WS_X1), (const bf16*)(ws + WS_RSH), M, 512, 512, D, D, 512, F.G, bx); S.brow_pn = 0; S.bcol_pn = 512;     \
        EpiRSh E{(float*)(ws + WS_LOG)}; \
        pg8::gemm_phase<EpiRSh, DenseOrder>(ring, entl, S, E, F.wave); }
    PHASE(7, P7_BODY);
    if (IN(8)) { p8_route(F); } SEAM(8);
#define P9_BODY { const int tt = expert_table(F); \
        ExpertOrder<true> S; S.A = ws + WS_X18; S.Bt = ws + WS_EGU; S.ldaB = D; S.ldbB = D; S.nt = D / 128; S.bstride = (size_t)512 * D; S.scaleA = E8_X; S.scaleB = E8_W; \
        S.tstart = (const LAS int*)(F.lds + TAB_OFF); S.cntl = S.tstart + 260; S.list = (const int*)(ws + WS_LIST); S.nN = 2; S.nwg = tt * 2; S.G = F.G; S.c = bx; \
        EpiEGU E{ws + WS_HE}; \
        pg8::gemm_phase<EpiEGU, ExpertOrder<true>>(ring, entl, S, E, F.wave); }
    PHASE(9, P9_BODY);
#define P10_BODY { const int tt = expert_table(F); \
        { ExpertOrder<false> S; S.A = ws + WS_HE; S.Bt = ws + WS_EDN; S.ldaB = EH; S.ldbB = EH; S.nt = EH / 128; S.bstride = (size_t)D * EH; S.scaleA = E8_H; S.scaleB = E8_W; \
          S.tstart = (const LAS int*)(F.lds + TAB_OFF); S.cntl = S.tstart + 260; S.list = (const int*)(ws + WS_LIST); S.nN = 4; S.nwg = tt * 4; S.G = F.G; S.c = bx; \
          EpiEDown E{ws + WS_Y}; \
          pg8::gemm_phase<EpiEDown, ExpertOrder<false>>(ring, entl, S, E, F.wave); } }
    PHASE(10, P10_BODY);
    PHASE(11, p11_combine(F));
#undef IN
#undef SEAM
}

extern "C" void kernel_launch(void* const* d_in, const int* in_sizes, int n_in, void* d_out, int out_size, void* d_ws, size_t ws_size, hipStream_t stream) {
    static int grid = 0;
    if (grid == 0) {
        if (n_in != 21 || in_sizes[0] != M * D || out_size != M * D || ws_size < WS_END) { fprintf(stderr, "kernel_launch: unexpected shapes (n_in %d, in0 %d, out %d, ws %zu)\n", n_in, n_in > 0 ? in_sizes[0] : -1, out_size, ws_size); grid = -1; return; }
        int dev = 0, cus = 0;
        if (hipGetDevice(&dev) != hipSuccess || hipDeviceGetAttribute(&cus, hipDeviceAttributeMultiprocessorCount, dev) != hipSuccess) { grid = -1; return; }
        if (hipFuncSetAttribute((const void*)mk_fwd, hipFuncAttributeMaxDynamicSharedMemorySize, LDS_BYTES) != hipSuccess) { fprintf(stderr, "kernel_launch: hipFuncSetAttribute failed\n"); grid = -1; return; }
        (void)hipGetLastError();
        grid = cus;
    }
    if (grid < 0) return;
    (void)hipMemsetAsync((char*)d_ws + WS_CTL, 0, CTL_ZERO_BYTES, stream);
    Args a{};
    for (int i = 0; i < 21; ++i) a.in[i] = (const float*)d_in[i];
    a.out = (float*)d_out; a.ws = (unsigned char*)d_ws;
    constexpr int NL = MK_N_LAUNCHES;
    for (int li = 0; li < NL; ++li) {
        a.ph_lo = (NL == 1) ? 0 : li; a.ph_hi = (NL == 1) ? N_PHASES : li + 1;
        hipLaunchKernelGGL(mk_fwd, dim3(grid), dim3(NTHR), LDS_BYTES, stream, a);
#ifdef DBG_CHECK
        if (a.ph_hi == DBG_CHECK) { dbg_run(d_in, (float*)d_out, (unsigned char*)d_ws, stream, DBG_CHECK); return; }
#endif
    }
}
```
